# Optimizing an MI355X kernel written in HIP

```python
import jax
import jax.numpy as jnp
from jax import lax
import numpy as np

D_MODEL = 1024
BATCH = 32
SEQ = 2048
DEPTH = 1

CTX_LEN = 256
GRID_W = 64

POOL_WINDOWS = (2, 4, 8, 16)
POOL_GROUPS = len(POOL_WINDOWS)
POOL_GROUP_DIM = 128
POOL_WIDTH = POOL_GROUPS * POOL_GROUP_DIM

GLA_HEADS = 4
GLA_DK = D_MODEL // 2
GLA_DV = D_MODEL
GLA_HK = GLA_DK // GLA_HEADS
GLA_HV = GLA_DV // GLA_HEADS
GLA_GATE_RANK = 16
GLA_GATE_NORMALIZER = 16.0
GLA_CHUNK = 64

N_BRANCHES = 2
IN_WIDTHS = (POOL_WIDTH, GLA_DK, GLA_DK, GLA_DV, GLA_DV, N_BRANCHES * D_MODEL, 2 * GLA_GATE_RANK)
IN_SPLITS = tuple(int(s) for s in np.cumsum(IN_WIDTHS)[:-1])
D_IN = int(sum(IN_WIDTHS))

N_GROUPS = 4
EXPERTS_PER_GROUP = 8
N_EXPERTS = N_GROUPS * EXPERTS_PER_GROUP
TOP_K_IN_GROUP = 2
D_EXPERT = D_MODEL // 2

MOD_CHUNKS = 6
EPS = 1e-6

kernel_name = 'hybrid_pool_gla_hmoe_dit_block'


def _rmsnorm(x, g):
    xf = x.astype(jnp.float32)
    y = xf * lax.rsqrt(jnp.mean(xf * xf, axis=-1, keepdims=True) + EPS)
    return (y * g.astype(jnp.float32)).astype(x.dtype)


def _adaln(cond, w_mod, b_mod):
    return jnp.split(jnp.matmul(jax.nn.silu(cond), w_mod) + b_mod, MOD_CHUNKS, axis=-1)


def _heads(t, hd):
    b, l, _ = t.shape
    return t.reshape(b, l, GLA_HEADS, hd).transpose(0, 2, 1, 3)


def _flip(t):
    return jnp.flip(t, axis=2)


def _project(h, w_in, a2_f, ab_f, a2_b, ab_b):
    p = jnp.einsum('bld,de->ble', h, w_in)
    u, q, k, v, g, gates, lr = jnp.split(p, IN_SPLITS, axis=-1)
    lr_f, lr_b = jnp.split(lr, 2, axis=-1)
    la_f = jax.nn.log_sigmoid(jnp.matmul(lr_f, a2_f).astype(jnp.float32) + ab_f.astype(jnp.float32)) / GLA_GATE_NORMALIZER
    la_b = jax.nn.log_sigmoid(jnp.matmul(lr_b, a2_b).astype(jnp.float32) + ab_b.astype(jnp.float32)) / GLA_GATE_NORMALIZER
    return (u, _heads(q, GLA_HK) * (GLA_HK ** -0.5), _heads(k, GLA_HK), _heads(v, GLA_HV),
            _heads(la_f, GLA_HK), _heads(la_b, GLA_HK), g, gates)


def _centred_pool_minus_self(u):
    n, l, _ = u.shape
    uf = u.astype(jnp.float32)
    cs = jnp.concatenate([jnp.zeros((n, 1, POOL_WIDTH), jnp.float32), jnp.cumsum(uf, axis=1)], axis=1)
    t = np.arange(l)
    means = []
    for gi, w in enumerate(POOL_WINDOWS):
        lo = np.clip(t - w // 2, 0, l)
        hi = np.clip(t + w // 2, 0, l)
        cg = cs[..., gi * POOL_GROUP_DIM:(gi + 1) * POOL_GROUP_DIM]
        cnt = jnp.asarray((hi - lo)[:, None], jnp.float32)
        means.append((cg[:, hi] - cg[:, lo]) / cnt)
    return (jnp.concatenate(means, axis=-1) - uf).astype(u.dtype)


def _gla_chunked(q, k, v, log_a, s0):
    b, h, l, _ = q.shape
    dv = v.shape[-1]
    n = l // GLA_CHUNK

    def chunks(t):
        return t.astype(jnp.float32).reshape(b, h, n, GLA_CHUNK, t.shape[-1])

    qc, kc, vc, la = chunks(q), chunks(k), chunks(v), chunks(log_a)
    cum = jnp.cumsum(la, axis=3)
    last = cum[:, :, :, -1:, :]
    q_dec = qc * jnp.exp(cum)
    k_inv = kc * jnp.exp(-cum)
    k_rem = kc * jnp.exp(last - cum)
    lower = np.tril(np.ones((GLA_CHUNK, GLA_CHUNK), dtype=bool))
    scores = jnp.where(lower, jnp.einsum('bhnid,bhnjd->bhnij', q_dec, k_inv), 0.0)
    o_intra = jnp.einsum('bhnij,bhnjv->bhniv', scores, vc)
    decay = jnp.exp(last[:, :, :, 0, :])

    def step(state, inp):
        q_n, k_n, v_n, d_n = inp
        o_n = jnp.einsum('bhid,bhdv->bhiv', q_n, state)
        state = d_n[..., None] * state + jnp.einsum('bhid,bhiv->bhdv', k_n, v_n)
        return state, o_n

    xs = tuple(jnp.moveaxis(t, 2, 0) for t in (q_dec, k_rem, vc, decay))
    s_final, o_inter = lax.scan(step, s0, xs)
    o = o_intra + jnp.moveaxis(o_inter, 0, 2)
    return o.reshape(b, h, l, dv).astype(v.dtype), s_final


def _gla_final_state(k, v, log_a):
    cum = jnp.cumsum(log_a, axis=2)
    k_rem = k.astype(jnp.float32) * jnp.exp(cum[:, :, -1:, :] - cum)
    return jnp.einsum('bhtd,bhtv->bhdv', k_rem, v.astype(jnp.float32))


def _gla_bidirectional(q, k, v, la_f, la_b, s0_f, s0_b):
    o_f, _ = _gla_chunked(q, k, v, la_f, s0_f)
    o_b, _ = _gla_chunked(_flip(q), _flip(k), _flip(v), _flip(la_b), s0_b)
    return o_f + _flip(o_b)


def _mixer_out(pooled, o, g, gates, pool_w, pool_scale, gla_onorm_g, w_pool_br, w_gla_br, w_o):
    b, l, _ = pooled.shape
    y_pool = jnp.einsum('blgc,gce->blge', pooled.reshape(b, l, POOL_GROUPS, POOL_GROUP_DIM), pool_w)
    y_pool = jnp.matmul(y_pool.reshape(b, l, POOL_WIDTH) * pool_scale, w_pool_br)
    o = _rmsnorm(o, gla_onorm_g).transpose(0, 2, 1, 3).reshape(b, l, GLA_DV)
    y_gla = jnp.matmul(o * jax.nn.silu(g), w_gla_br)
    gate_pool, gate_gla = jnp.split(jax.nn.sigmoid(gates), N_BRANCHES, axis=-1)
    return jnp.matmul(gate_pool * y_pool + gate_gla * y_gla, w_o)


def _hier_moe(h, rg_w, rg_b, re_w, re_b, w1, w3, w2):
    b, l, d = h.shape
    t = h.reshape(b * l, d)
    grp_logits = (jnp.matmul(t, rg_w) + rg_b).astype(jnp.float32)
    grp_top, grp_idx = lax.top_k(grp_logits, 1)
    p_grp = jnp.exp(grp_top - jax.nn.logsumexp(grp_logits, axis=-1, keepdims=True))
    exp_logits = (jnp.matmul(t, re_w) + re_b).astype(jnp.float32).reshape(-1, N_GROUPS, EXPERTS_PER_GROUP)
    in_grp = jnp.einsum('tg,tge->te', jax.nn.one_hot(grp_idx[:, 0], N_GROUPS, dtype=jnp.float32), exp_logits)
    top_v, top_i = lax.top_k(in_grp, TOP_K_IN_GROUP)
    w = jax.nn.softmax(top_v, axis=-1) * p_grp
    expert_idx = grp_idx * EXPERTS_PER_GROUP + top_i
    combine = jnp.einsum('tk,tke->te', w, jax.nn.one_hot(expert_idx, N_EXPERTS, dtype=jnp.float32)).astype(h.dtype)
    out = jnp.zeros_like(t)
    for e in range(N_EXPERTS):
        hid = jax.nn.silu(jnp.matmul(t, w1[e])) * jnp.matmul(t, w3[e])
        out = out + combine[:, e:e + 1] * jnp.matmul(hid, w2[e])
    return out.reshape(b, l, d)


def setup_inputs(seed: int = 0) -> dict:
    key = jax.random.key(seed)
    ks = jax.random.split(key, 32)
    d = D_MODEL

    def nrm(k, shape, scale):
        return jax.random.normal(k, shape, jnp.float32) * scale

    return {
        'x': nrm(ks[0], (BATCH, SEQ, d), 1.0),
        'c': nrm(ks[1], (BATCH, d), 1.0),
        'ctx': nrm(ks[2], (BATCH, CTX_LEN, d), 1.0),
        'c_ctx': nrm(ks[3], (d,), 1.0),
        'w_mod': nrm(ks[4], (DEPTH, d, MOD_CHUNKS * d), 0.5 * d ** -0.5),
        'b_mod': nrm(ks[5], (DEPTH, MOD_CHUNKS * d), 0.02),
        'norm1_g': 1.0 + nrm(ks[6], (DEPTH, d), 0.05),
        'norm2_g': 1.0 + nrm(ks[7], (DEPTH, d), 0.05),
        'w_in': nrm(ks[8], (DEPTH, d, D_IN), d ** -0.5),
        'gla_a2_f': nrm(ks[9], (DEPTH, GLA_GATE_RANK, GLA_DK), GLA_GATE_RANK ** -0.5),
        'gla_ab_f': nrm(ks[10], (DEPTH, GLA_DK), 0.5),
        'gla_a2_b': nrm(ks[11], (DEPTH, GLA_GATE_RANK, GLA_DK), GLA_GATE_RANK ** -0.5),
        'gla_ab_b': nrm(ks[12], (DEPTH, GLA_DK), 0.5),
        'gla_onorm_g': 1.0 + nrm(ks[13], (DEPTH, GLA_HV), 0.05),
        'pool_w': nrm(ks[14], (DEPTH, POOL_GROUPS, POOL_GROUP_DIM, POOL_GROUP_DIM), POOL_GROUP_DIM ** -0.5),
        'pool_scale': 1.0 + nrm(ks[15], (DEPTH, POOL_WIDTH), 0.1),
        'w_pool_br': nrm(ks[16], (DEPTH, POOL_WIDTH, d), POOL_WIDTH ** -0.5),
        'w_gla_br': nrm(ks[17], (DEPTH, GLA_DV, d), GLA_DV ** -0.5),
        'w_o': nrm(ks[18], (DEPTH, d, d), d ** -0.5),
        'router_grp_w': nrm(ks[19], (DEPTH, d, N_GROUPS), d ** -0.5),
        'router_grp_b': nrm(ks[20], (DEPTH, N_GROUPS), 0.01),
        'router_exp_w': nrm(ks[21], (DEPTH, d, N_EXPERTS), d ** -0.5),
        'router_exp_b': nrm(ks[22], (DEPTH, N_EXPERTS), 0.01),
        'moe_w1': nrm(ks[23], (DEPTH, N_EXPERTS, d, D_EXPERT), d ** -0.5),
        'moe_w3': nrm(ks[24], (DEPTH, N_EXPERTS, d, D_EXPERT), d ** -0.5),
        'moe_w2': nrm(ks[25], (DEPTH, N_EXPERTS, D_EXPERT, d), D_EXPERT ** -0.5),
        'final_norm_g': 1.0 + nrm(ks[26], (d,), 0.05),
    }


def reference(x, c, ctx, c_ctx, w_mod, b_mod, norm1_g, norm2_g, w_in, gla_a2_f, gla_ab_f, gla_a2_b, gla_ab_b,
              gla_onorm_g, pool_w, pool_scale, w_pool_br, w_gla_br, w_o, router_grp_w, router_grp_b,
              router_exp_w, router_exp_b, moe_w1, moe_w3, moe_w2, final_norm_g):
    b, seq, d = x.shape
    rows = seq // GRID_W
    for i in range(DEPTH):
        proj_params = (w_in[i], gla_a2_f[i], gla_ab_f[i], gla_a2_b[i], gla_ab_b[i])
        mix_params = (pool_w[i], pool_scale[i], gla_onorm_g[i], w_pool_br[i], w_gla_br[i], w_o[i])
        moe_params = (router_grp_w[i], router_grp_b[i], router_exp_w[i], router_exp_b[i],
                      moe_w1[i], moe_w3[i], moe_w2[i])
        sh1, sc1, g1, sh2, sc2, g2 = [m[:, None, :] for m in _adaln(c, w_mod[i], b_mod[i])]
        csh1, csc1, cg1, csh2, csc2, cg2 = _adaln(c_ctx, w_mod[i], b_mod[i])

        hc = _rmsnorm(ctx, norm1_g[i]) * (1 + csc1) + csh1
        uc, qc, kc, vc, lfc, lbc, gc, gtc = _project(hc, *proj_params)
        st_f = _gla_final_state(kc, vc, lfc)
        st_b = _gla_final_state(_flip(kc), _flip(vc), _flip(lbc))

        hx = _rmsnorm(x, norm1_g[i]) * (1 + sc1) + sh1
        ux, qx, kx, vx, lfx, lbx, gx, gtx = _project(hx, *proj_params)
        pooled_x = _centred_pool_minus_self(ux.reshape(b * rows, GRID_W, POOL_WIDTH)).reshape(b, seq, POOL_WIDTH)
        ox = _gla_bidirectional(qx, kx, vx, lfx, lbx, st_f, st_b)
        x = x + g1 * _mixer_out(pooled_x, ox, gx, gtx, *mix_params)
        x = x + g2 * _hier_moe(_rmsnorm(x, norm2_g[i]) * (1 + sc2) + sh2, *moe_params)

        if i + 1 < DEPTH:
            zero_state = jnp.zeros_like(st_f)
            oc = _gla_bidirectional(qc, kc, vc, lfc, lbc, zero_state, zero_state)
            ctx = ctx + cg1 * _mixer_out(_centred_pool_minus_self(uc), oc, gc, gtc, *mix_params)
            ctx = ctx + cg2 * _hier_moe(_rmsnorm(ctx, norm2_g[i]) * (1 + csc2) + csh2, *moe_params)
    return _rmsnorm(x, final_norm_g)
```

```cpp
#include <hip/hip_runtime.h>
#include <cstdio>
#include <cstdint>

#ifndef MK_N_LAUNCHES
#define MK_N_LAUNCHES 13
#endif

#define LAS __attribute__((address_space(3)))
#define GAS __attribute__((address_space(1)))
typedef unsigned short bf16_t;
typedef short bf16x8 __attribute__((ext_vector_type(8)));
typedef float f32x4 __attribute__((ext_vector_type(4)));
typedef float f32x2 __attribute__((ext_vector_type(2)));
typedef unsigned u32x4 __attribute__((ext_vector_type(4)));
typedef unsigned u32x2 __attribute__((ext_vector_type(2)));

constexpr int D = 1024, BATCH = 32, SEQ = 2048, T = BATCH * SEQ, CTXL = 256, TC = BATCH * CTXL;
constexpr int DIN = 5664, NPAD = 5888;
constexpr int NE = 32, DE = 512;
constexpr int MAXTILES = 544, NPMAX = MAXTILES * 256;
constexpr float EPS = 1e-6f;
constexpr int NWAVES = 8, NTHR = 512;
constexpr int PER_PHASE = 13;
constexpr int N_LAUNCHES = MK_N_LAUNCHES;

constexpr size_t MiB = 1u << 20;
constexpr size_t WS_CTL = 0, CTL_ZERO_BYTES = 1 * MiB;
constexpr size_t WS_MOD = 1 * MiB;
constexpr size_t WS_EID = 2 * MiB;
constexpr size_t WS_EW = WS_EID + 512 * 1024;
constexpr size_t WS_POS = 3 * MiB;
constexpr size_t WS_IDX = WS_POS + 512 * 1024;
constexpr size_t WS_TILEE = 4 * MiB + 512 * 1024;
constexpr size_t WS_LR = 5 * MiB;
constexpr size_t WS_WIN = 14 * MiB;
constexpr size_t WS_WP = 26 * MiB;
constexpr size_t WS_WGLA = 27 * MiB;
constexpr size_t WS_WO = 29 * MiB;
constexpr size_t WS_W13 = 32 * MiB;
constexpr size_t WS_W2 = 96 * MiB;
constexpr size_t WS_HX = 128 * MiB;
constexpr size_t WS_PU = 272 * MiB;
constexpr size_t WS_PQKV = 336 * MiB;
constexpr size_t WS_PO = 336 * MiB;
constexpr size_t WS_Z = 400 * MiB;
constexpr size_t WS_HID = 272 * MiB;
constexpr size_t WS_PG = 592 * MiB;
constexpr size_t WS_PGATES = 720 * MiB;
constexpr size_t WS_Y = 592 * MiB;
constexpr size_t WS_PKVC = 976 * MiB;
constexpr size_t WS_END = 1000 * MiB;
static_assert(WS_HID + (size_t)NPMAX * 512 * 2 <= WS_PG && WS_Y + (size_t)NPMAX * 1024 * 2 <= WS_PKVC, "ws map");
constexpr int CW_CNT = 64;
constexpr int CW_CUR = 128;
constexpr int CW_NT = 192;
constexpr int CW_BAR = 4096;

constexpr int LDS_BYTES = 163840;
constexpr int MISC_OFF = LDS_BYTES - 256;

__device__ __forceinline__ unsigned cvt_pk_bf16(float lo, float hi) { unsigned r; asm volatile("v_cvt_pk_bf16_f32 %0, %1, %2" : "=v"(r) : "v"(lo), "v"(hi)); return r; }
__device__ __forceinline__ float bf_lo(unsigned w) { return __uint_as_float(w << 16); }
__device__ __forceinline__ float bf_hi(unsigned w) { return __uint_as_float(w & 0xffff0000u); }
__device__ __forceinline__ float bf2f(bf16_t h) { return __uint_as_float(((unsigned)h) << 16); }
__device__ __forceinline__ float wave_sum(float v) {
#pragma unroll
    for (int o = 1; o < 64; o <<= 1) v += __shfl_xor(v, o);
    return v;
}
__device__ __forceinline__ float sigmoidf_(float x) { return 1.f / (1.f + __expf(-x)); }
#define LDS_WAIT() asm volatile("s_waitcnt lgkmcnt(0)" ::: "memory")

#define XB_TMO      128
#define XB_XCNT(j)  (256  + 64 * (j))
#define XB_XSUB(j)  (1280 + 64 * (j))
#define XB_XGEN(j)  (2304 + 64 * (j))
#define XB_TOP      3328
#define XB_TOPGEN   3392
#define XCD_BAR_WORDS 3456
#define XB_SPIN_CAP (1u << 18)
__device__ __forceinline__ unsigned xb_ld(unsigned* p)              { return __hip_atomic_load(p, __ATOMIC_RELAXED, __HIP_MEMORY_SCOPE_AGENT); }
__device__ __forceinline__ unsigned xb_add(unsigned* p, unsigned v) { return __hip_atomic_fetch_add(p, v, __ATOMIC_RELAXED, __HIP_MEMORY_SCOPE_AGENT); }
__device__ __forceinline__ unsigned xb_xcc_id() { return (unsigned)__builtin_amdgcn_s_getreg((3 << 11) | 20) & 0xFu; }
#define XB_SPIN(cond, bar) do { unsigned _sp = 0; while (cond) { __builtin_amdgcn_s_sleep(1); \
    if ((++_sp & 255u) == 0u) { if (xb_ld(&(bar)[XB_TMO])) break; if (_sp > XB_SPIN_CAP) { atomicAdd(&(bar)[XB_TMO], 1u); break; } } } } while (0)
struct XcdBarrier { unsigned* bar; unsigned x; volatile LAS unsigned* st; };
__device__ __forceinline__ XcdBarrier xcd_barrier_post(unsigned* bar, volatile LAS unsigned* st) {
    XcdBarrier b; b.bar = bar; b.x = xb_xcc_id(); b.st = st;
    if (threadIdx.x == 0) (void)xb_add(&bar[XB_XCNT(b.x)], 1u);
    return b;
}
__device__ __forceinline__ void xcd_barrier_complete(unsigned* bar, unsigned x, unsigned& nloc, unsigned& nx) {
    const unsigned G = gridDim.x * gridDim.y * gridDim.z;
    unsigned sum, cnt, mine, sp = 0u;
    for (;;) {
        sum = 0u; cnt = 0u; mine = 0u;
#pragma unroll
        for (unsigned j = 0; j < 16; ++j) { const unsigned c = xb_ld(&bar[XB_XCNT(j)]); sum += c; cnt += (c > 0u) ? 1u : 0u; mine = (j == x) ? c : mine; }
        if (sum == G) break;
        __builtin_amdgcn_s_sleep(1);
        if ((++sp & 255u) == 0u) { if (xb_ld(&bar[XB_TMO])) break; if (sp > XB_SPIN_CAP) { atomicAdd(&bar[XB_TMO], 1u); break; } }
    }
    nloc = mine > 0u ? mine : 1u; nx = cnt > 0u ? cnt : 1u;
}
__device__ __forceinline__ void xcd_barrier(const XcdBarrier& b) {
    asm volatile("s_waitcnt vmcnt(0)" ::: "memory");
    __syncthreads();
    if (threadIdx.x == 0) {
        unsigned* bar = b.bar;
        __builtin_amdgcn_s_waitcnt(0);
        unsigned nloc = b.st[0], nx = b.st[1];
        if (nloc == 0u) { xcd_barrier_complete(bar, b.x, nloc, nx); b.st[0] = nloc; b.st[1] = nx; }
        const unsigned old = xb_add(&bar[XB_XSUB(b.x)], 1u);
        const unsigned gen = old / nloc;
        if (old + 1u == (gen + 1u) * nloc) {
            __builtin_amdgcn_fence(__ATOMIC_RELEASE, "agent");
            asm volatile("s_waitcnt vmcnt(0)" ::: "memory");
            const unsigned og = xb_add(&bar[XB_TOP], 1u);
            const unsigned tg = og / nx;
            if (og + 1u == (tg + 1u) * nx) xb_add(&bar[XB_TOPGEN], 1u);
            else XB_SPIN(xb_ld(&bar[XB_TOPGEN]) == tg, bar);
            __builtin_amdgcn_fence(__ATOMIC_ACQUIRE, "agent");
            xb_add(&bar[XB_XGEN(b.x)], 1u);
            asm volatile("s_waitcnt vmcnt(0)" ::: "memory");
        } else {
            XB_SPIN(xb_ld(&bar[XB_XGEN(b.x)]) == gen, bar);
            __builtin_amdgcn_fence(__ATOMIC_ACQUIRE, "agent");
            asm volatile("s_waitcnt vmcnt(0)" ::: "memory");
        }
    }
    __syncthreads();
}

namespace pg8 {
constexpr int BM = 256, BK = 64, HALF = 128, HTB = HALF * BK * 2, STAGE_BYTES = 8 * HTB, NXCD = 8, WGM = 8;
__host__ __device__ __forceinline__ int lds_byte(int r, int c) { const int st = (r >> 4) * 2 + (c >> 5), rr = r & 15, cc = c & 31, ob = rr * 64 + cc * 2; return st * 1024 + (ob ^ (((ob >> 9) & 1) << 5)); }
__host__ __device__ __forceinline__ void stage_rc(int b, int& R, int& C) { const int st = b / 1024, sb = b % 1024, swz = sb ^ (((sb >> 9) & 1) << 5); R = (st >> 1) * 16 + swz / 64; C = (st & 1) * 32 + (swz % 64) / 2; }
__host__ __device__ __forceinline__ int perm32(int rho) { const int n = rho >> 4, i = rho & 15; return 8 * (i >> 2) + 4 * n + (i & 3); }

struct Unit { const char* A; const char* B; unsigned va[2][2]; int pm, pn, aux; };

__device__ __forceinline__ void static_tile(int L, int nM, int nN, int& pm, int& pn) {
    const int nwg = nM * nN; int wgid = L; { const int q = nwg / NXCD, r = nwg % NXCD, xcd = wgid % NXCD, off = wgid / NXCD; wgid = (xcd < r ? xcd * (q + 1) : r * (q + 1) + (xcd - r) * q) + off; }
    const int nig = WGM * nN, gid = wgid / nig, fm = gid * WGM, gsz = (nM - fm) < WGM ? (nM - fm) : WGM;
    pm = fm + ((wgid % nig) % gsz); pn = (wgid % nig) / gsz;
}

template <class Epi, class Sched, bool ALIGN_EPI = true>
__device__ __forceinline__ void gemm_phase(LAS unsigned char* lds, const int K, const Sched& S, const Epi& E) {
    const int tid = threadIdx.x, wid = __builtin_amdgcn_readfirstlane(tid >> 6), lane = tid & 63, wr = wid >> 2, wc = wid & 3, fr = lane & 15, fq = lane >> 4;
    const int nt = K / BK;
    unsigned vb[2];
#pragma unroll
    for (int i = 0; i < 2; ++i) { int R, C; stage_rc(tid * 16 + i * 8192, R, C); const int Rb = Epi::PERM ? ((R & ~31) + perm32(R & 31)) : R; vb[i] = (unsigned)(Rb * K + C) * 2u; }
    const size_t kstep = (size_t)(BK * 2);
    const size_t hstep = (size_t)HALF * K * 2;
    const unsigned ldsw = (unsigned)wid * 1024u;
    const int aoff = lds_byte(wr * 64 + fr, fq * 8), boff = lds_byte(wc * 32 + fr, fq * 8);
#define PG8_SA(b, h) (((b) * 2 + (h)) * HTB)
#define PG8_SB(b, h) ((4 + (b) * 2 + (h)) * HTB)
#define PG8_STAGEA(bufoff, gbase, VA, h) do { _Pragma("unroll") for (int _i = 0; _i < 2; ++_i) \
        __builtin_amdgcn_global_load_lds((const unsigned*)((const char*)(gbase) + (VA)[h][_i]), (LAS unsigned*)(lds + (bufoff) + ldsw + _i * 8192), 16, 0, 0); } while (0)
#define PG8_STAGEB(bufoff, gbase) do { _Pragma("unroll") for (int _i = 0; _i < 2; ++_i) \
        __builtin_amdgcn_global_load_lds((const unsigned*)((const char*)(gbase) + vb[_i]), (LAS unsigned*)(lds + (bufoff) + ldsw + _i * 8192), 16, 0, 0); } while (0)
#define PG8_LDA(dst, b, h) do { _Pragma("unroll") for (int m = 0; m < 4; ++m) _Pragma("unroll") for (int k = 0; k < 2; ++k) dst[m][k] = *(const LAS bf16x8*)(lds + PG8_SA(b, h) + aoff + m * 2048 + k * 1024); } while (0)
#define PG8_LDB(dst, b, h) do { _Pragma("unroll") for (int n = 0; n < 2; ++n) _Pragma("unroll") for (int k = 0; k < 2; ++k) dst[n][k] = *(const LAS bf16x8*)(lds + PG8_SB(b, h) + boff + n * 2048 + k * 1024); } while (0)
#define PG8_MMA(ai, bj, At, Bt) do { __builtin_amdgcn_s_setprio(1); _Pragma("unroll") for (int m = 0; m < 4; ++m) _Pragma("unroll") for (int n = 0; n < 2; ++n) _Pragma("unroll") for (int k = 0; k < 2; ++k) \
        acc[ai][bj][m][n] = __builtin_amdgcn_mfma_f32_16x16x32_bf16(Bt[n][k], At[m][k], acc[ai][bj][m][n], 0, 0, 0); __builtin_amdgcn_s_setprio(0); } while (0)
#define PG8_WAIT_V(n) asm volatile("s_waitcnt vmcnt(" #n ")" ::: "memory")
#define PG8_WAIT_L(n) asm volatile("s_waitcnt lgkmcnt(" #n ")" ::: "memory")
#define PG8_BAR __builtin_amdgcn_s_barrier()
#define PG8_SCHED __builtin_amdgcn_sched_barrier(0)
    Unit cur, nxt; int ui = 0;
    if (!S.next(0, cur)) return;
    f32x4 acc[2][2][4][2];
#pragma unroll
    for (int a = 0; a < 2; ++a)
#pragma unroll
        for (int b = 0; b < 2; ++b)
#pragma unroll
            for (int m = 0; m < 4; ++m)
#pragma unroll
                for (int n = 0; n < 2; ++n) acc[a][b][m][n] = (f32x4){0.f, 0.f, 0.f, 0.f};
    bf16x8 At[4][2], B0[2][2], B1[2][2];
    const char* cA = cur.A; const char* cB = cur.B;
    PG8_STAGEB(PG8_SB(0, 0), cB); PG8_STAGEB(PG8_SB(0, 1), cB + hstep); PG8_STAGEA(PG8_SA(0, 0), cA, cur.va, 0); PG8_STAGEA(PG8_SA(0, 1), cA, cur.va, 1);
    if (wr == 1) PG8_BAR;
    PG8_WAIT_V(2); PG8_BAR;
    PG8_STAGEB(PG8_SB(1, 0), cB + kstep); PG8_STAGEA(PG8_SA(1, 0), cA + kstep, cur.va, 0); PG8_STAGEB(PG8_SB(1, 1), cB + hstep + kstep);
    PG8_WAIT_V(6); PG8_BAR;
    for (;;) {
        const bool has_next = S.next(ui + 1, nxt);
        if (!has_next) { nxt.A = cA; nxt.B = cB; nxt.va[0][0] = cur.va[0][0]; nxt.va[0][1] = cur.va[0][1]; nxt.va[1][0] = cur.va[1][0]; nxt.va[1][1] = cur.va[1][1]; }
        const char* nA = nxt.A; const char* nB = nxt.B;
        for (int t = 0; t < nt; t += 2) {
            const bool last = (t == nt - 2);
            const char* a1 = cA + (size_t)(t + 1) * kstep;
            const char* a2 = last ? nA : cA + (size_t)(t + 2) * kstep; const char* b2 = last ? nB : cB + (size_t)(t + 2) * kstep;
            const char* a3 = a2 + kstep; const char* b3 = b2 + kstep;
            unsigned v2[2][2];
            v2[0][0] = last ? nxt.va[0][0] : cur.va[0][0]; v2[0][1] = last ? nxt.va[0][1] : cur.va[0][1]; v2[1][0] = last ? nxt.va[1][0] : cur.va[1][0]; v2[1][1] = last ? nxt.va[1][1] : cur.va[1][1];
            PG8_LDB(B0, 0, 0); PG8_LDB(B1, 0, 1); PG8_SCHED; PG8_LDA(At, 0, 0); PG8_STAGEA(PG8_SA(1, 1), a1, cur.va, 1);
            PG8_WAIT_V(8); PG8_WAIT_L(0); PG8_BAR; PG8_MMA(0, 0, At, B0); PG8_MMA(0, 1, At, B1); PG8_BAR; PG8_SCHED;
            PG8_LDA(At, 0, 1); PG8_STAGEB(PG8_SB(0, 0), b2); PG8_STAGEB(PG8_SB(0, 1), b2 + hstep); PG8_STAGEA(PG8_SA(0, 0), a2, v2, 0);
            PG8_WAIT_V(8); PG8_WAIT_L(0); PG8_BAR; PG8_MMA(1, 0, At, B0); PG8_MMA(1, 1, At, B1); PG8_BAR; PG8_SCHED;
            PG8_LDB(B0, 1, 0); PG8_LDB(B1, 1, 1); PG8_SCHED; PG8_LDA(At, 1, 0); PG8_STAGEA(PG8_SA(0, 1), a2, v2, 1);
            PG8_WAIT_V(8); PG8_WAIT_L(0); PG8_BAR; PG8_MMA(0, 0, At, B0); PG8_MMA(0, 1, At, B1); PG8_BAR; PG8_SCHED;
            PG8_LDA(At, 1, 1); PG8_STAGEB(PG8_SB(1, 0), b3); PG8_STAGEB(PG8_SB(1, 1), b3 + hstep); PG8_STAGEA(PG8_SA(1, 0), a3, v2, 0);
            PG8_WAIT_V(8); PG8_WAIT_L(0); PG8_BAR; PG8_MMA(1, 0, At, B0); PG8_MMA(1, 1, At, B1); PG8_BAR; PG8_SCHED;
        }
        if constexpr (ALIGN_EPI) { if (wr == 0) PG8_BAR; }
        E(acc, cur, wr, wc, fr, fq);
        if (!has_next) break;
#pragma unroll
        for (int a = 0; a < 2; ++a)
#pragma unroll
            for (int b = 0; b < 2; ++b)
#pragma unroll
                for (int m = 0; m < 4; ++m)
#pragma unroll
                    for (int n = 0; n < 2; ++n) acc[a][b][m][n] = (f32x4){0.f, 0.f, 0.f, 0.f};
        cur = nxt; cA = nA; cB = nB; ++ui;
        if constexpr (ALIGN_EPI) { if (wr == 1) PG8_BAR; }
    }
    PG8_WAIT_V(0);
    if constexpr (!ALIGN_EPI) { if (wr == 0) PG8_BAR; }
    PG8_BAR;
#undef PG8_SA
#undef PG8_SB
#undef PG8_STAGEA
#undef PG8_STAGEB
#undef PG8_LDA
#undef PG8_LDB
#undef PG8_MMA
#undef PG8_WAIT_V
#undef PG8_WAIT_L
#undef PG8_BAR
#undef PG8_SCHED
}
__device__ __forceinline__ void contig_va(unsigned (&va)[2][2], unsigned lda) {
    const int tid = threadIdx.x;
#pragma unroll
    for (int i = 0; i < 2; ++i) { int R, C; stage_rc(tid * 16 + i * 8192, R, C); va[0][i] = (unsigned)R * lda + (unsigned)C * 2u; va[1][i] = (unsigned)(R + HALF) * lda + (unsigned)C * 2u; }
}
}

struct Frame {
    LAS unsigned char* lds;
    unsigned* ctl;
    int tid, lane, wave, vcu, G;
    const float* in[27];
    float* out;
    unsigned char* ws;
};
struct Args { const float* in[27]; float* out; unsigned char* ws; int ph_lo, ph_hi; };

__device__ __forceinline__ void p_adaln(Frame& F) {
    const int wg = blockIdx.x, tid = F.tid;
    if (wg >= 192) return;
    const float* c = F.in[1]; const float* cctx = F.in[3]; const float* wmod = F.in[4]; const float* bmod = F.in[5];
    float* mod = (float*)(F.ws + WS_MOD);
    LAS float* sc = (LAS float*)F.lds;
    for (int i = tid; i < 33 * 1024; i += NTHR) { const int r = i >> 10, k = i & 1023; const float v = (r < 32) ? c[r * 1024 + k] : cctx[k]; sc[k * 36 + r] = v / (1.f + expf(-v)); }
    __syncthreads();
    const int col = tid & 31, kq = tid >> 5, j = wg * 32 + col;
    float acc[33];
#pragma unroll
    for (int r = 0; r < 33; ++r) acc[r] = 0.f;
    for (int kk = 0; kk < 64; ++kk) {
        const int k = kq * 64 + kk; const float w = wmod[(size_t)k * 6144 + j];
        const LAS f32x4* sp = (const LAS f32x4*)(sc + k * 36);
#pragma unroll
        for (int q = 0; q < 8; ++q) { const f32x4 s4 = sp[q]; acc[4 * q] += s4[0] * w; acc[4 * q + 1] += s4[1] * w; acc[4 * q + 2] += s4[2] * w; acc[4 * q + 3] += s4[3] * w; }
        acc[32] += sc[k * 36 + 32] * w;
    }
    __syncthreads();
    LAS float* red = (LAS float*)F.lds;
#pragma unroll
    for (int r = 0; r < 33; ++r) red[(kq * 33 + r) * 32 + col] = acc[r];
    __syncthreads();
    for (int o = tid; o < 33 * 32; o += NTHR) { const int r = o >> 5, cc = o & 31; float s = 0.f;
#pragma unroll
        for (int q = 0; q < 16; ++q) s += red[(q * 33 + r) * 32 + cc];
        mod[r * 6144 + wg * 32 + cc] = s + bmod[wg * 32 + cc]; }
    __syncthreads();
}
__device__ __forceinline__ void transpose_item(const float* W, int ldw, int k0, int n0, bf16_t* WT, int ldk, int dst_row0, LAS float* scr, int lane) {
#pragma unroll 8
    for (int i = 0; i < 32; ++i) { const int kk = 2 * i + (lane >> 5); scr[kk * 33 + (lane & 31)] = W[(size_t)(k0 + kk) * ldw + n0 + (lane & 31)]; }
    LDS_WAIT(); asm volatile("" ::: "memory");
    const int c = lane & 7;
#pragma unroll
    for (int j = 0; j < 4; ++j) { const int n = (lane >> 3) + 8 * j; const LAS float* s = scr + (8 * c) * 33 + n;
        u32x4 o; o.x = cvt_pk_bf16(s[0 * 33], s[1 * 33]); o.y = cvt_pk_bf16(s[2 * 33], s[3 * 33]); o.z = cvt_pk_bf16(s[4 * 33], s[5 * 33]); o.w = cvt_pk_bf16(s[6 * 33], s[7 * 33]);
        *(u32x4*)(WT + (size_t)(dst_row0 + n) * ldk + k0 + 8 * c) = o; }
    LDS_WAIT(); asm volatile("" ::: "memory");
}
__device__ __forceinline__ void p_convert(Frame& F) {
    LAS float* scr = (LAS float*)(F.lds + F.wave * 16384);
    const int gw = F.vcu * NWAVES + F.wave, NGW = F.G * NWAVES, lane = F.lane;
    bf16_t* WIN = (bf16_t*)(F.ws + WS_WIN); bf16_t* WGLA = (bf16_t*)(F.ws + WS_WGLA); bf16_t* WO = (bf16_t*)(F.ws + WS_WO);
    bf16_t* W13 = (bf16_t*)(F.ws + WS_W13); bf16_t* W2 = (bf16_t*)(F.ws + WS_W2); bf16_t* WP = (bf16_t*)(F.ws + WS_WP);
    constexpr int I_IN = 16 * 177, I_SQ = 16 * 32, I_13 = 64 * 256, I_2 = 32 * 256;
    constexpr int NITEMS = I_IN + 2 * I_SQ + I_13 + I_2;
    for (int it = gw; it < NITEMS; it += NGW) {
        int r = it;
        if (r < I_IN) { const int kb = r / 177, nb = r % 177; transpose_item(F.in[8], DIN, 64 * kb, 32 * nb, WIN, 1024, 32 * nb, scr, lane); continue; } r -= I_IN;
        if (r < I_SQ) { const int kb = r / 32, nb = r % 32; transpose_item(F.in[17], 1024, 64 * kb, 32 * nb, WGLA, 1024, 32 * nb, scr, lane); continue; } r -= I_SQ;
        if (r < I_SQ) { const int kb = r / 32, nb = r % 32; transpose_item(F.in[18], 1024, 64 * kb, 32 * nb, WO, 1024, 32 * nb, scr, lane); continue; } r -= I_SQ;
        if (r < I_13) { const int mat = r / 256, e = mat >> 1, which = mat & 1, rr = r % 256, kb = rr / 16, nb = rr % 16, n0 = 32 * nb;
            const float* src = (which ? F.in[24] : F.in[23]) + (size_t)e * 1024 * 512;
            transpose_item(src, 512, 64 * kb, n0, W13 + (size_t)e * 1024 * 1024, 1024, (n0 / 128) * 256 + (n0 % 128) + which * 128, scr, lane); continue; } r -= I_13;
        { const int e = r / 256, rr = r % 256, kb = rr / 32, nb = rr % 32;
            transpose_item(F.in[25] + (size_t)e * 512 * 1024, 1024, 64 * kb, 32 * nb, W2 + (size_t)e * 1024 * 512, 512, 32 * nb, scr, lane); }
    }
    { const int gt = F.vcu * NTHR + F.tid, NGT = F.G * NTHR; u32x4 z = (u32x4){0u, 0u, 0u, 0u};
        for (int i = gt; i < 224 * 128; i += NGT) *(u32x4*)((char*)(WIN + (size_t)DIN * 1024) + (size_t)i * 16) = z; }
    { const float* pw = F.in[14]; const float* ps = F.in[15]; const float* wbr = F.in[16];
        const int gt = F.vcu * NTHR + F.tid, NGT = F.G * NTHR;
        for (int o = gt; o < 512 * 1024; o += NGT) { const int e = o & 1023, k = o >> 10, gi = k >> 7; const float* pr = pw + (size_t)k * 128; float s = 0.f;
            for (int j = 0; j < 128; ++j) s += pr[j] * ps[gi * 128 + j] * wbr[(size_t)(gi * 128 + j) * 1024 + e];
            WP[(size_t)e * 512 + k] = (bf16_t)(cvt_pk_bf16(s, 0.f) & 0xffffu); } }
}

__device__ __forceinline__ void norm_rows(const float* src, bf16_t* dst, int row0, int nrows, const float* gain, const float* scv, const float* shv, int lane) {
    f32x4 Av[4], Bv[4];
#pragma unroll
    for (int j = 0; j < 4; ++j) { const int c = 4 * lane + 256 * j; const f32x4 g = *(const f32x4*)(gain + c), s = *(const f32x4*)(scv + c); Av[j] = g * (s + 1.f); Bv[j] = *(const f32x4*)(shv + c); }
    for (int r = 0; r < nrows; ++r) {
        const float* xr = src + (size_t)(row0 + r) * D; f32x4 v[4]; float ss = 0.f;
#pragma unroll
        for (int j = 0; j < 4; ++j) { v[j] = *(const f32x4*)(xr + 4 * lane + 256 * j); ss += (v[j][0] * v[j][0] + v[j][1] * v[j][1]) + (v[j][2] * v[j][2] + v[j][3] * v[j][3]); }
        const float rstd = 1.f / sqrtf(wave_sum(ss) * (1.f / D) + EPS);
        bf16_t* orow = dst + (size_t)(row0 + r) * D;
#pragma unroll
        for (int j = 0; j < 4; ++j) { const f32x4 h = v[j] * rstd * Av[j] + Bv[j]; u32x2 w; w.x = cvt_pk_bf16(h[0], h[1]); w.y = cvt_pk_bf16(h[2], h[3]); *(u32x2*)(orow + 4 * lane + 256 * j) = w; }
    }
}
__device__ __forceinline__ void p_norm1(Frame& F) {
    const int gw = F.vcu * NWAVES + F.wave;
    const int NGW = F.G * NWAVES;
    const float* mod = (const float*)(F.ws + WS_MOD); bf16_t* HX = (bf16_t*)(F.ws + WS_HX);
    for (int w = gw; w < 2048; w += NGW) {
        const int b = w >> 6;
        norm_rows(F.in[0], HX, w * 32, 32, F.in[6], mod + b * 6144 + 1024, mod + b * 6144, F.lane);
        norm_rows(F.in[2], HX + (size_t)T * D, w * 4, 4, F.in[6], mod + 32 * 6144 + 1024, mod + 32 * 6144, F.lane);
    }
}

struct SchedG1 {
    const char* HX; const char* WIN; int G, c;
    __device__ __forceinline__ bool next(int i, pg8::Unit& u) const {
        const int L = i * G + c; constexpr int NL = 256 * 23, NC = 32 * 7;
        if (L >= NL + NC) return false;
        int pm, pn, ctx = 0;
        if (L < NL) pg8::static_tile(L, 256, 23, pm, pn);
        else { const int j = L - NL; pm = j & 31; const int q = j >> 5; pn = (q < 6) ? 4 + q : 22; ctx = 1; }
        u.pm = pm; u.pn = pn; u.aux = ctx;
        u.A = HX + ((size_t)(ctx ? T : 0) + (size_t)pm * 256) * (D * 2); u.B = WIN + (size_t)pn * 256 * (D * 2);
        pg8::contig_va(u.va, D * 2);
        return true;
    }
};
struct EpiG1 {
    static constexpr bool PERM = true;
    unsigned char* ws;
    __device__ __forceinline__ void operator()(const f32x4 (&acc)[2][2][4][2], const pg8::Unit& u, int wr, int wc, int fr, int fq) const {
        const int pn = u.pn, ctx = u.aux; const int row0 = u.pm * 256 + wr * 64 + fr;
        if (pn == 22) {
            if (wc != 0) return;
            float* LR = (float*)(ws + WS_LR) + (size_t)(ctx ? T : 0) * 32;
#pragma unroll
            for (int ai = 0; ai < 2; ++ai)
#pragma unroll
                for (int m = 0; m < 4; ++m) { float* rp = LR + (size_t)(row0 + ai * 128 + m * 16) * 32 + 8 * fq; *(f32x4*)rp = acc[ai][0][m][0]; *(f32x4*)(rp + 4) = acc[ai][0][m][1]; }
            return;
        }
        bf16_t* base; int ldc, colt; float sc = 1.f;
        if (ctx) { base = (bf16_t*)(ws + WS_PKVC); ldc = 1536; colt = (pn - 4) * 256; }
        else if (pn < 2) { base = (bf16_t*)(ws + WS_PU); ldc = 512; colt = pn * 256; }
        else if (pn < 10) { base = (bf16_t*)(ws + WS_PQKV); ldc = 2048; colt = (pn - 2) * 256; if (pn < 4) sc = 0.08838834764831845f; }
        else if (pn < 14) { base = (bf16_t*)(ws + WS_PG); ldc = 1024; colt = (pn - 10) * 256; }
        else { base = (bf16_t*)(ws + WS_PGATES); ldc = 2048; colt = (pn - 14) * 256; }
        const int col0 = colt + wc * 32 + 8 * fq;
#pragma unroll
        for (int ai = 0; ai < 2; ++ai)
#pragma unroll
            for (int m = 0; m < 4; ++m) { bf16_t* rowp = base + (size_t)(row0 + ai * 128 + m * 16) * ldc + col0;
#pragma unroll
                for (int bj = 0; bj < 2; ++bj) { const f32x4 v0 = acc[ai][bj][m][0] * sc, v1 = acc[ai][bj][m][1] * sc;
                    u32x4 w; w.x = cvt_pk_bf16(v0[0], v0[1]); w.y = cvt_pk_bf16(v0[2], v0[3]); w.z = cvt_pk_bf16(v1[0], v1[1]); w.w = cvt_pk_bf16(v1[2], v1[3]);
                    *(u32x4*)(rowp + bj * 128) = w; } }
    }
};

__device__ __forceinline__ void p_gla_naive(Frame& F) {
    const int tid = F.tid;
    const bf16_t* PQKV = (const bf16_t*)(F.ws + WS_PQKV); const bf16_t* PKVC = (const bf16_t*)(F.ws + WS_PKVC); const float* LR = (const float*)(F.ws + WS_LR);
    LAS float* a2L = (LAS float*)F.lds;
    LAS float* abL = a2L + 2048;
    LAS float* lrL = abL + 128;
    LAS float* alL = lrL + 256;
    LAS float* kL = alL + 2048;
    LAS float* qL = kL + 2048;
    LAS float* vL = qL + 2048;
    LAS float* oL = vL + 4096;
    for (int wgi = blockIdx.x; wgi < 256; wgi += F.G) {
        const int b = wgi >> 3, h = (wgi >> 1) & 3, dir = wgi & 1;
        bf16_t* OD = (bf16_t*)F.out + (size_t)dir * T * D;
        const float* a2 = dir ? F.in[11] : F.in[9]; const float* ab = dir ? F.in[12] : F.in[10];
        __syncthreads();
        for (int i = tid; i < 2048; i += NTHR) a2L[i] = a2[(i >> 7) * 512 + h * 128 + (i & 127)];
        if (tid < 128) abL[tid] = ab[h * 128 + tid];
        const int v = tid & 255, dh = tid >> 8;
        f32x2 S[32];
#pragma unroll
        for (int i = 0; i < 32; ++i) S[i] = (f32x2){0.f, 0.f};
        for (int blk = 0; blk < 144; ++blk) {
            const bool isctx = blk < 16; const int bi = isctx ? blk : blk - 16; const int N = isctx ? CTXL : SEQ;
            __syncthreads();
            if (tid < 256) { const int j = tid >> 4, r = tid & 15; const int n = dir ? (N - 1 - (bi * 16 + j)) : (bi * 16 + j);
                const size_t row = isctx ? (size_t)T + b * CTXL + n : (size_t)b * SEQ + n; lrL[j * 16 + r] = LR[row * 32 + dir * 16 + r]; }
            for (int q = 0; q < 4; ++q) { const int idx = tid + NTHR * q, j = idx >> 7, d = idx & 127; const int n = dir ? (N - 1 - (bi * 16 + j)) : (bi * 16 + j);
                if (isctx) { const size_t row = (size_t)b * CTXL + n; kL[idx] = bf2f(PKVC[row * 1536 + h * 128 + d]); }
                else { const size_t row = (size_t)b * SEQ + n; kL[idx] = bf2f(PQKV[row * 2048 + 512 + h * 128 + d]); qL[idx] = bf2f(PQKV[row * 2048 + h * 128 + d]); } }
            for (int q = 0; q < 8; ++q) { const int idx = tid + NTHR * q, j = idx >> 8, vv = idx & 255; const int n = dir ? (N - 1 - (bi * 16 + j)) : (bi * 16 + j);
                if (isctx) { const size_t row = (size_t)b * CTXL + n; vL[idx] = bf2f(PKVC[row * 1536 + 512 + h * 256 + vv]); }
                else { const size_t row = (size_t)b * SEQ + n; vL[idx] = bf2f(PQKV[row * 2048 + 1024 + h * 256 + vv]); } }
            __syncthreads();
            for (int q = 0; q < 4; ++q) { const int idx = tid + NTHR * q, j = idx >> 7, d = idx & 127; float z = abL[d];
#pragma unroll
                for (int r = 0; r < 16; ++r) z += lrL[j * 16 + r] * a2L[r * 128 + d];
                const float la = fminf(z, 0.f) - log1pf(expf(-fabsf(z)));
                alL[idx] = expf(la * (1.f / 16.f)); }
            __syncthreads();
            for (int j = 0; j < 16; ++j) {
                const float vv = vL[j * 256 + v]; f32x2 o2 = (f32x2){0.f, 0.f};
                const LAS f32x4* ap = (const LAS f32x4*)(alL + j * 128 + dh * 64); const LAS f32x4* kp = (const LAS f32x4*)(kL + j * 128 + dh * 64); const LAS f32x4* qp = (const LAS f32x4*)(qL + j * 128 + dh * 64);
                if (isctx) {
#pragma unroll
                    for (int i = 0; i < 16; ++i) { const f32x4 a4 = ap[i], k4 = kp[i];
                        S[2 * i] = (f32x2){a4[0], a4[1]} * S[2 * i] + (f32x2){k4[0], k4[1]} * vv; S[2 * i + 1] = (f32x2){a4[2], a4[3]} * S[2 * i + 1] + (f32x2){k4[2], k4[3]} * vv; }
                } else {
#pragma unroll
                    for (int i = 0; i < 16; ++i) { const f32x4 a4 = ap[i], k4 = kp[i], q4 = qp[i];
                        S[2 * i] = (f32x2){a4[0], a4[1]} * S[2 * i] + (f32x2){k4[0], k4[1]} * vv; S[2 * i + 1] = (f32x2){a4[2], a4[3]} * S[2 * i + 1] + (f32x2){k4[2], k4[3]} * vv;
                        o2 += (f32x2){q4[0], q4[1]} * S[2 * i] + (f32x2){q4[2], q4[3]} * S[2 * i + 1]; }
                    oL[(dh * 16 + j) * 256 + v] = o2[0] + o2[1];
                }
            }
            if (!isctx) {
                __syncthreads();
                for (int q = 0; q < 4; ++q) { const int idx = tid + NTHR * q, j = idx >> 7, vp = (idx & 127) * 2; const int n = dir ? (SEQ - 1 - (bi * 16 + j)) : (bi * 16 + j);
                    const float o0 = oL[j * 256 + vp] + oL[(16 + j) * 256 + vp], o1 = oL[j * 256 + vp + 1] + oL[(16 + j) * 256 + vp + 1];
                    *(unsigned*)(OD + ((size_t)b * SEQ + n) * D + h * 256 + vp) = cvt_pk_bf16(o0, o1); }
            }
        }
    }
    __syncthreads();
}

__device__ __forceinline__ void p_prep(Frame& F) {
    const int gw = F.vcu * NWAVES + F.wave, NGW = F.G * NWAVES, lane = F.lane;
    const bf16_t* OF = (const bf16_t*)F.out; const bf16_t* OB = OF + (size_t)T * D; const bf16_t* PG = (const bf16_t*)(F.ws + WS_PG);
    bf16_t* OG = (bf16_t*)(F.ws + WS_HX);
    const f32x4 gn = *(const f32x4*)(F.in[13] + 4 * lane);
    for (int w = gw; w < 2048; w += NGW)
        for (int r = 0; r < 32; ++r) {
            const size_t row = (size_t)w * 32 + r;
#pragma unroll
            for (int j = 0; j < 4; ++j) { const size_t off = row * D + 4 * lane + 256 * j;
                const u32x2 a = *(const u32x2*)(OF + off), bq = *(const u32x2*)(OB + off), gq = *(const u32x2*)(PG + off);
                f32x4 o; o[0] = bf_lo(a.x) + bf_lo(bq.x); o[1] = bf_hi(a.x) + bf_hi(bq.x); o[2] = bf_lo(a.y) + bf_lo(bq.y); o[3] = bf_hi(a.y) + bf_hi(bq.y);
                const float ss = wave_sum((o[0] * o[0] + o[1] * o[1]) + (o[2] * o[2] + o[3] * o[3]));
                const float rstd = 1.f / sqrtf(ss * (1.f / 256.f) + EPS);
                f32x4 g; g[0] = bf_lo(gq.x); g[1] = bf_hi(gq.x); g[2] = bf_lo(gq.y); g[3] = bf_hi(gq.y);
                f32x4 y;
#pragma unroll
                for (int e = 0; e < 4; ++e) y[e] = o[e] * rstd * gn[e] * (g[e] * sigmoidf_(g[e]));
                u32x2 wv; wv.x = cvt_pk_bf16(y[0], y[1]); wv.y = cvt_pk_bf16(y[2], y[3]); *(u32x2*)(OG + off) = wv; }
        }
    const bf16_t* PU = (const bf16_t*)(F.ws + WS_PU); bf16_t* PO = (bf16_t*)(F.ws + WS_PO);
    LAS unsigned* uL = (LAS unsigned*)F.lds;
    for (int tt = F.vcu; tt < T / 64; tt += F.G) {
        __syncthreads();
        for (int i = F.tid; i < 64 * 64; i += NTHR) *(LAS u32x4*)(uL + i * 4) = *(const u32x4*)(PU + (size_t)tt * 64 * 512 + (size_t)i * 8);
        __syncthreads();
        const int cp = F.tid & 255, half = F.tid >> 8, gi = cp >> 6, hw = 1 << gi;
        for (int p = half * 32; p < half * 32 + 32; ++p) {
            const int lo = (p - hw) < 0 ? 0 : (p - hw), hi = (p + hw) > 64 ? 64 : (p + hw);
            float s0 = 0.f, s1 = 0.f;
            for (int s = lo; s < hi; ++s) { const unsigned w = uL[s * 256 + cp]; s0 += bf_lo(w); s1 += bf_hi(w); }
            const unsigned self = uL[p * 256 + cp]; const float inv = 1.f / (float)(hi - lo);
            *(unsigned*)(PO + ((size_t)tt * 64 + p) * 512 + 2 * cp) = cvt_pk_bf16(s0 * inv - bf_lo(self), s1 * inv - bf_hi(self));
        }
    }
    __syncthreads();
}

struct SchedSq {
    const char* A; const char* B; unsigned lda; int K, G, c;
    __device__ __forceinline__ bool next(int i, pg8::Unit& u) const {
        const int L = i * G + c; if (L >= 1024) return false;
        int pm, pn; pg8::static_tile(L, 256, 4, pm, pn); u.pm = pm; u.pn = pn; u.aux = 0;
        u.A = A + (size_t)pm * 256 * lda; u.B = B + (size_t)pn * 256 * (K * 2); pg8::contig_va(u.va, lda); return true;
    }
};
__device__ __forceinline__ void unpack8(const u32x4 w, float (&f)[8]) { f[0] = bf_lo(w.x); f[1] = bf_hi(w.x); f[2] = bf_lo(w.y); f[3] = bf_hi(w.y); f[4] = bf_lo(w.z); f[5] = bf_hi(w.z); f[6] = bf_lo(w.w); f[7] = bf_hi(w.w); }
struct EpiPool {
    static constexpr bool PERM = true;
    const bf16_t* GATES; bf16_t* Z;
    __device__ __forceinline__ void operator()(const f32x4 (&acc)[2][2][4][2], const pg8::Unit& u, int wr, int wc, int fr, int fq) const {
        const int row0 = u.pm * 256 + wr * 64 + fr, col0 = u.pn * 256 + wc * 32 + 8 * fq;
#pragma unroll
        for (int ai = 0; ai < 2; ++ai)
#pragma unroll
            for (int m = 0; m < 4; ++m) { const size_t row = row0 + ai * 128 + m * 16;
#pragma unroll
                for (int bj = 0; bj < 2; ++bj) { const int col = col0 + bj * 128; float g[8]; unpack8(*(const u32x4*)(GATES + row * 2048 + col), g);
                    const f32x4 a0 = acc[ai][bj][m][0], a1 = acc[ai][bj][m][1]; float z[8];
#pragma unroll
                    for (int e = 0; e < 4; ++e) { z[e] = a0[e] * sigmoidf_(g[e]); z[4 + e] = a1[e] * sigmoidf_(g[4 + e]); }
                    u32x4 w; w.x = cvt_pk_bf16(z[0], z[1]); w.y = cvt_pk_bf16(z[2], z[3]); w.z = cvt_pk_bf16(z[4], z[5]); w.w = cvt_pk_bf16(z[6], z[7]);
                    *(u32x4*)(Z + row * 1024 + col) = w; } }
    }
};
struct EpiGla {
    static constexpr bool PERM = true;
    const bf16_t* GATES; bf16_t* Z;
    __device__ __forceinline__ void operator()(const f32x4 (&acc)[2][2][4][2], const pg8::Unit& u, int wr, int wc, int fr, int fq) const {
        const int row0 = u.pm * 256 + wr * 64 + fr, col0 = u.pn * 256 + wc * 32 + 8 * fq;
#pragma unroll
        for (int ai = 0; ai < 2; ++ai)
#pragma unroll
            for (int m = 0; m < 4; ++m) { const size_t row = row0 + ai * 128 + m * 16;
#pragma unroll
                for (int bj = 0; bj < 2; ++bj) { const int col = col0 + bj * 128; float g[8], zp[8]; unpack8(*(const u32x4*)(GATES + row * 2048 + 1024 + col), g); unpack8(*(const u32x4*)(Z + row * 1024 + col), zp);
                    const f32x4 a0 = acc[ai][bj][m][0], a1 = acc[ai][bj][m][1]; float z[8];
#pragma unroll
                    for (int e = 0; e < 4; ++e) { z[e] = zp[e] + a0[e] * sigmoidf_(g[e]); z[4 + e] = zp[4 + e] + a1[e] * sigmoidf_(g[4 + e]); }
                    u32x4 w; w.x = cvt_pk_bf16(z[0], z[1]); w.y = cvt_pk_bf16(z[2], z[3]); w.z = cvt_pk_bf16(z[4], z[5]); w.w = cvt_pk_bf16(z[6], z[7]);
                    *(u32x4*)(Z + row * 1024 + col) = w; } }
    }
};
struct EpiWo {
    static constexpr bool PERM = false;
    const float* X; const float* MOD; float* X1;
    __device__ __forceinline__ void operator()(const f32x4 (&acc)[2][2][4][2], const pg8::Unit& u, int wr, int wc, int fr, int fq) const {
        const int row0 = u.pm * 256 + wr * 64 + fr, col0 = u.pn * 256 + wc * 32 + 4 * fq; const int b = u.pm >> 3;
        f32x4 gv[2][2];
#pragma unroll
        for (int bj = 0; bj < 2; ++bj)
#pragma unroll
            for (int n = 0; n < 2; ++n) gv[bj][n] = *(const f32x4*)(MOD + b * 6144 + 2048 + col0 + bj * 128 + n * 16);
#pragma unroll
        for (int ai = 0; ai < 2; ++ai)
#pragma unroll
            for (int m = 0; m < 4; ++m) { const size_t off = (size_t)(row0 + ai * 128 + m * 16) * D + col0;
#pragma unroll
                for (int bj = 0; bj < 2; ++bj)
#pragma unroll
                    for (int n = 0; n < 2; ++n) { const f32x4 xv = *(const f32x4*)(X + off + bj * 128 + n * 16); *(f32x4*)(X1 + off + bj * 128 + n * 16) = xv + gv[bj][n] * acc[ai][bj][m][n]; } }
    }
};

__device__ __forceinline__ void p_norm2_router(Frame& F) {
    const int tid = F.tid, lane = F.lane;
    LAS float* WR = (LAS float*)F.lds;
    LAS unsigned* hist = (LAS unsigned*)(F.lds + 36 * 1024 * 4);
    const float* rgw = F.in[19]; const float* rgb = F.in[20]; const float* rew = F.in[21]; const float* reb = F.in[22];
    for (int i = tid; i < 1024 * 4; i += NTHR) WR[(i & 3) * 1024 + (i >> 2)] = rgw[i];
    for (int i = tid; i < 1024 * 32; i += NTHR) WR[(4 + (i & 31)) * 1024 + (i >> 5)] = rew[i];
    if (tid < 32) hist[tid] = 0u;
    __syncthreads();
    const float* mod = (const float*)(F.ws + WS_MOD); const float* X1 = F.out; bf16_t* H2 = (bf16_t*)(F.ws + WS_HX);
    int* EID = (int*)(F.ws + WS_EID); float* EW = (float*)(F.ws + WS_EW);
    const int gw = F.vcu * NWAVES + F.wave, NGW = F.G * NWAVES;
    for (int w = gw; w < 2048; w += NGW) {
        const int b = w >> 6;
        f32x4 Av[4], Bv[4];
#pragma unroll
        for (int j = 0; j < 4; ++j) { const int c = 4 * lane + 256 * j; const f32x4 g = *(const f32x4*)(F.in[7] + c), s = *(const f32x4*)(mod + b * 6144 + 4 * 1024 + c); Av[j] = g * (s + 1.f); Bv[j] = *(const f32x4*)(mod + b * 6144 + 3 * 1024 + c); }
        for (int r = 0; r < 32; ++r) {
            const size_t row = (size_t)w * 32 + r; const float* xr = X1 + row * D; f32x4 v[4]; float ss = 0.f;
#pragma unroll
            for (int j = 0; j < 4; ++j) { v[j] = *(const f32x4*)(xr + 4 * lane + 256 * j); ss += (v[j][0] * v[j][0] + v[j][1] * v[j][1]) + (v[j][2] * v[j][2] + v[j][3] * v[j][3]); }
            const float rstd = 1.f / sqrtf(wave_sum(ss) * (1.f / D) + EPS);
            bf16_t* orow = H2 + row * D;
#pragma unroll
            for (int j = 0; j < 4; ++j) { v[j] = v[j] * rstd * Av[j] + Bv[j]; u32x2 wv; wv.x = cvt_pk_bf16(v[j][0], v[j][1]); wv.y = cvt_pk_bf16(v[j][2], v[j][3]); *(u32x2*)(orow + 4 * lane + 256 * j) = wv; }
            float gl[4];
#pragma unroll
            for (int o = 0; o < 4; ++o) { float s = 0.f;
#pragma unroll
                for (int j = 0; j < 4; ++j) { const f32x4 wv = *(const LAS f32x4*)(WR + o * 1024 + 4 * lane + 256 * j); s += (v[j][0] * wv[0] + v[j][1] * wv[1]) + (v[j][2] * wv[2] + v[j][3] * wv[3]); }
                gl[o] = wave_sum(s) + rgb[o]; }
            int gsel = 0; float gmax = gl[0];
#pragma unroll
            for (int o = 1; o < 4; ++o) if (gl[o] > gmax) { gmax = gl[o]; gsel = o; }
            const float pgrp = 1.f / (expf(gl[0] - gmax) + expf(gl[1] - gmax) + expf(gl[2] - gmax) + expf(gl[3] - gmax));
            gsel = __builtin_amdgcn_readfirstlane(gsel);
            float el[8];
#pragma unroll
            for (int o = 0; o < 8; ++o) { float s = 0.f; const LAS float* wp = WR + (4 + gsel * 8 + o) * 1024;
#pragma unroll
                for (int j = 0; j < 4; ++j) { const f32x4 wv = *(const LAS f32x4*)(wp + 4 * lane + 256 * j); s += (v[j][0] * wv[0] + v[j][1] * wv[1]) + (v[j][2] * wv[2] + v[j][3] * wv[3]); }
                el[o] = wave_sum(s) + reb[gsel * 8 + o]; }
            int i0 = 0; float m0 = el[0];
#pragma unroll
            for (int o = 1; o < 8; ++o) if (el[o] > m0) { m0 = el[o]; i0 = o; }
            int i1 = -1; float m1 = -3.0e38f;
#pragma unroll
            for (int o = 0; o < 8; ++o) if (o != i0 && el[o] > m1) { m1 = el[o]; i1 = o; }
            const float e1 = expf(m1 - m0), w0 = pgrp / (1.f + e1), w1 = pgrp * e1 / (1.f + e1);
            if (lane == 0) { const int x0 = gsel * 8 + i0, x1 = gsel * 8 + i1; EID[row * 2] = x0; EID[row * 2 + 1] = x1; EW[row * 2] = w0; EW[row * 2 + 1] = w1;
                atomicAdd((unsigned*)&hist[x0], 1u); atomicAdd((unsigned*)&hist[x1], 1u); }
        }
    }
    __syncthreads();
    if (tid < 32 && hist[tid]) __hip_atomic_fetch_add(F.ctl + CW_CNT + tid, hist[tid], __ATOMIC_RELAXED, __HIP_MEMORY_SCOPE_AGENT);
    __syncthreads();
}

__device__ __forceinline__ void p_index(Frame& F) {
    const int tid = F.tid;
    LAS unsigned* offL = (LAS unsigned*)F.lds;
    LAS unsigned* cntL = offL + 64;
    LAS unsigned* h2 = offL + 128;
    LAS unsigned* baseL = offL + 192;
    const int* EID = (const int*)(F.ws + WS_EID); int* POS = (int*)(F.ws + WS_POS); int* IDX = (int*)(F.ws + WS_IDX); int* TILEE = (int*)(F.ws + WS_TILEE);
    __syncthreads();
    if (tid == 0) { unsigned o = 0; for (int e = 0; e < 32; ++e) { const unsigned c = __hip_atomic_load(F.ctl + CW_CNT + e, __ATOMIC_RELAXED, __HIP_MEMORY_SCOPE_AGENT); cntL[e] = c; offL[e] = o; o += (c + 255u) & ~255u; } offL[32] = o; }
    __syncthreads();
    const unsigned ntiles = offL[32] >> 8;
    if (blockIdx.x == 0) {
        if (tid == 0) F.ctl[CW_NT] = ntiles;
        for (unsigned t = tid; t < ntiles; t += NTHR) { int e = 0; for (int q = 0; q < 32; ++q) if (t * 256u >= offL[q] && t * 256u < offL[q + 1]) e = q; TILEE[t] = e; }
    }
    for (int e = blockIdx.x; e < 32; e += F.G) for (unsigned p = offL[e] + cntL[e] + tid; p < offL[e + 1]; p += NTHR) IDX[p] = 0;
    for (int chunk = blockIdx.x; chunk < T / 256; chunk += F.G) {
        __syncthreads();
        if (tid < 32) h2[tid] = 0u;
        __syncthreads();
        const int token = chunk * 256 + (tid >> 1), k = tid & 1; const int e = EID[token * 2 + k];
        const unsigned rnk = atomicAdd((unsigned*)&h2[e], 1u);
        __syncthreads();
        if (tid < 32) baseL[tid] = h2[tid] ? __hip_atomic_fetch_add(F.ctl + CW_CUR + tid, h2[tid], __ATOMIC_RELAXED, __HIP_MEMORY_SCOPE_AGENT) : 0u;
        __syncthreads();
        const unsigned pos = offL[e] + baseL[e] + rnk;
        IDX[pos] = token; POS[token * 2 + k] = (int)pos;
    }
    __syncthreads();
}

struct SchedMoe1 {
    const char* H2; const char* W13; const int* IDX; const int* TILEE; int nunits, G, c;
    __device__ __forceinline__ bool next(int i, pg8::Unit& u) const {
        const int L = i * G + c; if (L >= nunits) return false;
        const int tile = L >> 2, pn = L & 3; const int e = __builtin_amdgcn_readfirstlane(TILEE[tile]);
        u.pm = tile; u.pn = pn; u.aux = e; u.A = H2; u.B = W13 + ((size_t)e * 1024 + (size_t)pn * 256) * 2048;
        const int tid = threadIdx.x;
#pragma unroll
        for (int k = 0; k < 2; ++k) { int R, C; pg8::stage_rc(tid * 16 + k * 8192, R, C);
            u.va[0][k] = (unsigned)IDX[tile * 256 + R] * 2048u + (unsigned)C * 2u; u.va[1][k] = (unsigned)IDX[tile * 256 + 128 + R] * 2048u + (unsigned)C * 2u; }
        return true;
    }
};
struct EpiMoe1 {
    static constexpr bool PERM = true;
    bf16_t* HID;
    __device__ __forceinline__ void operator()(const f32x4 (&acc)[2][2][4][2], const pg8::Unit& u, int wr, int wc, int fr, int fq) const {
        const int row0 = u.pm * 256 + wr * 64 + fr, col0 = u.pn * 128 + wc * 32 + 8 * fq;
#pragma unroll
        for (int ai = 0; ai < 2; ++ai)
#pragma unroll
            for (int m = 0; m < 4; ++m) { const size_t row = row0 + ai * 128 + m * 16; float hv[8];
#pragma unroll
                for (int n = 0; n < 2; ++n)
#pragma unroll
                    for (int e = 0; e < 4; ++e) { const float a = acc[ai][0][m][n][e], bq = acc[ai][1][m][n][e]; hv[4 * n + e] = a * sigmoidf_(a) * bq; }
                u32x4 w; w.x = cvt_pk_bf16(hv[0], hv[1]); w.y = cvt_pk_bf16(hv[2], hv[3]); w.z = cvt_pk_bf16(hv[4], hv[5]); w.w = cvt_pk_bf16(hv[6], hv[7]);
                *(u32x4*)(HID + row * 512 + col0) = w; }
    }
};
struct SchedMoe2 {
    const char* HID; const char* W2; const int* TILEE; int nunits, G, c;
    __device__ __forceinline__ bool next(int i, pg8::Unit& u) const {
        const int L = i * G + c; if (L >= nunits) return false;
        const int tile = L >> 2, pn = L & 3; const int e = __builtin_amdgcn_readfirstlane(TILEE[tile]);
        u.pm = tile; u.pn = pn; u.aux = e; u.A = HID + (size_t)tile * 256 * 1024; u.B = W2 + ((size_t)e * 1024 + (size_t)pn * 256) * 1024;
        pg8::contig_va(u.va, 1024); return true;
    }
};
struct EpiMoe2 {
    static constexpr bool PERM = true;
    bf16_t* Y;
    __device__ __forceinline__ void operator()(const f32x4 (&acc)[2][2][4][2], const pg8::Unit& u, int wr, int wc, int fr, int fq) const {
        const int row0 = u.pm * 256 + wr * 64 + fr, col0 = u.pn * 256 + wc * 32 + 8 * fq;
#pragma unroll
        for (int ai = 0; ai < 2; ++ai)
#pragma unroll
            for (int m = 0; m < 4; ++m) { bf16_t* rowp = Y + (size_t)(row0 + ai * 128 + m * 16) * 1024 + col0;
#pragma unroll
                for (int bj = 0; bj < 2; ++bj) { const f32x4 v0 = acc[ai][bj][m][0], v1 = acc[ai][bj][m][1];
                    u32x4 w; w.x = cvt_pk_bf16(v0[0], v0[1]); w.y = cvt_pk_bf16(v0[2], v0[3]); w.z = cvt_pk_bf16(v1[0], v1[1]); w.w = cvt_pk_bf16(v1[2], v1[3]);
                    *(u32x4*)(rowp + bj * 128) = w; } }
    }
};

__device__ __forceinline__ void p_final(Frame& F) {
    const int gw = F.vcu * NWAVES + F.wave, NGW = F.G * NWAVES, lane = F.lane;
    const float* mod = (const float*)(F.ws + WS_MOD); const bf16_t* Y = (const bf16_t*)(F.ws + WS_Y);
    const int* POS = (const int*)(F.ws + WS_POS); const float* EW = (const float*)(F.ws + WS_EW);
    for (int w = gw; w < 2048; w += NGW) {
        const int b = w >> 6; f32x4 g2[4], fg[4];
#pragma unroll
        for (int j = 0; j < 4; ++j) { g2[j] = *(const f32x4*)(mod + b * 6144 + 5 * 1024 + 4 * lane + 256 * j); fg[j] = *(const f32x4*)(F.in[26] + 4 * lane + 256 * j); }
        for (int r = 0; r < 32; ++r) {
            const size_t row = (size_t)w * 32 + r; float* xr = F.out + row * D;
            const int p0 = POS[row * 2], p1 = POS[row * 2 + 1]; const float w0 = EW[row * 2], w1 = EW[row * 2 + 1];
            f32x4 v[4]; float ss = 0.f;
#pragma unroll
            for (int j = 0; j < 4; ++j) { const int c = 4 * lane + 256 * j; const f32x4 xv = *(const f32x4*)(xr + c);
                const u32x2 a = *(const u32x2*)(Y + (size_t)p0 * 1024 + c), bq = *(const u32x2*)(Y + (size_t)p1 * 1024 + c);
                f32x4 mo; mo[0] = w0 * bf_lo(a.x) + w1 * bf_lo(bq.x); mo[1] = w0 * bf_hi(a.x) + w1 * bf_hi(bq.x); mo[2] = w0 * bf_lo(a.y) + w1 * bf_lo(bq.y); mo[3] = w0 * bf_hi(a.y) + w1 * bf_hi(bq.y);
                v[j] = xv + g2[j] * mo; ss += (v[j][0] * v[j][0] + v[j][1] * v[j][1]) + (v[j][2] * v[j][2] + v[j][3] * v[j][3]); }
            const float rstd = 1.f / sqrtf(wave_sum(ss) * (1.f / D) + EPS);
#pragma unroll
            for (int j = 0; j < 4; ++j) *(f32x4*)(xr + 4 * lane + 256 * j) = v[j] * rstd * fg[j];
        }
    }
}

__global__ void __launch_bounds__(NTHR, 2) fwd_kernel(Args args) {
    extern __shared__ __attribute__((aligned(16))) unsigned char lds_raw[];
    Frame F;
    F.lds = (LAS unsigned char*)lds_raw;
    F.tid = threadIdx.x; F.lane = F.tid & 63; F.wave = __builtin_amdgcn_readfirstlane(F.tid >> 6);
    F.G = gridDim.x; { const int bx = blockIdx.x; F.vcu = (F.G % 8 == 0) ? (bx % 8) * (F.G / 8) + bx / 8 : bx; }
    F.ws = args.ws; F.out = args.out; F.ctl = (unsigned*)(args.ws + WS_CTL);
#pragma unroll
    for (int i = 0; i < 27; ++i) F.in[i] = args.in[i];
    volatile LAS unsigned* MISC = (volatile LAS unsigned*)(F.lds + MISC_OFF);
    if (F.tid < 64) MISC[F.tid] = 0u;
    __syncthreads();
    XcdBarrier bar; bar.bar = F.ctl + CW_BAR; bar.x = 0; bar.st = nullptr;
    if (N_LAUNCHES != PER_PHASE) bar = xcd_barrier_post(F.ctl + CW_BAR, MISC + 8);
#define GRID_BAR() do { if (N_LAUNCHES != PER_PHASE) xcd_barrier(bar); } while (0)
    const int lo = args.ph_lo, hi = args.ph_hi;
#define IN(k) (lo <= (k) && (k) < hi)
#define BOTH(k) (IN(k) && IN((k) + 1))
    unsigned char* ws = F.ws;

    if (IN(0)) { p_adaln(F); p_convert(F); if (BOTH(0)) GRID_BAR(); }
    if (IN(1)) { p_norm1(F); if (BOTH(1)) GRID_BAR(); }
    if (IN(2)) {
        SchedG1 S{(const char*)(ws + WS_HX), (const char*)(ws + WS_WIN), F.G, (int)blockIdx.x}; EpiG1 E{ws};
        pg8::gemm_phase<EpiG1, SchedG1, true>(F.lds, 1024, S, E);
        if (BOTH(2)) GRID_BAR();
    }
    if (IN(3)) { p_gla_naive(F); if (BOTH(3)) GRID_BAR(); }
    if (IN(4)) { p_prep(F); if (BOTH(4)) GRID_BAR(); }
    if (IN(5)) {
        SchedSq S{(const char*)(ws + WS_PO), (const char*)(ws + WS_WP), 1024u, 512, F.G, (int)blockIdx.x}; EpiPool E{(const bf16_t*)(ws + WS_PGATES), (bf16_t*)(ws + WS_Z)};
        pg8::gemm_phase<EpiPool, SchedSq, true>(F.lds, 512, S, E);
        if (BOTH(5)) GRID_BAR();
    }
    if (IN(6)) {
        SchedSq S{(const char*)(ws + WS_HX), (const char*)(ws + WS_WGLA), 2048u, 1024, F.G, (int)blockIdx.x}; EpiGla E{(const bf16_t*)(ws + WS_PGATES), (bf16_t*)(ws + WS_Z)};
        pg8::gemm_phase<EpiGla, SchedSq, true>(F.lds, 1024, S, E);
        if (BOTH(6)) GRID_BAR();
    }
    if (IN(7)) {
        SchedSq S{(const char*)(ws + WS_Z), (const char*)(ws + WS_WO), 2048u, 1024, F.G, (int)blockIdx.x}; EpiWo E{F.in[0], (const float*)(ws + WS_MOD), F.out};
        pg8::gemm_phase<EpiWo, SchedSq, true>(F.lds, 1024, S, E);
        if (BOTH(7)) GRID_BAR();
    }
    if (IN(8)) { p_norm2_router(F); if (BOTH(8)) GRID_BAR(); }
    if (IN(9)) { p_index(F); if (BOTH(9)) GRID_BAR(); }
    if (IN(10)) {
        const int nt = (int)__hip_atomic_load(F.ctl + CW_NT, __ATOMIC_RELAXED, __HIP_MEMORY_SCOPE_AGENT);
        SchedMoe1 S{(const char*)(ws + WS_HX), (const char*)(ws + WS_W13), (const int*)(ws + WS_IDX), (const int*)(ws + WS_TILEE), nt * 4, F.G, F.vcu}; EpiMoe1 E{(bf16_t*)(ws + WS_HID)};
        pg8::gemm_phase<EpiMoe1, SchedMoe1, true>(F.lds, 1024, S, E);
        if (BOTH(10)) GRID_BAR();
    }
    if (IN(11)) {
        const int nt = (int)__hip_atomic_load(F.ctl + CW_NT, __ATOMIC_RELAXED, __HIP_MEMORY_SCOPE_AGENT);
        SchedMoe2 S{(const char*)(ws + WS_HID), (const char*)(ws + WS_W2), (const int*)(ws + WS_TILEE), nt * 4, F.G, F.vcu}; EpiMoe2 E{(bf16_t*)(ws + WS_Y)};
        pg8::gemm_phase<EpiMoe2, SchedMoe2, true>(F.lds, 512, S, E);
        if (BOTH(11)) GRID_BAR();
    }
    if (IN(12)) { p_final(F); }
#undef IN
#undef BOTH
#undef GRID_BAR
}

extern "C" void kernel_launch(void* const* d_in, const int* in_sizes, int n_in, void* d_out, int out_size, void* d_ws, size_t ws_size, hipStream_t stream) {
    static int grid = 0;
    if (grid == 0) {
        if (n_in != 27 || in_sizes[0] != T * D || out_size != T * D || ws_size < WS_END) { fprintf(stderr, "kernel_launch: unexpected shapes: n_in %d in0 %d out %d ws %zu (need %zu); nothing launched\n", n_in, n_in > 0 ? in_sizes[0] : -1, out_size, ws_size, (size_t)WS_END); grid = -1; return; }
        int dev = 0, cus = 0, per_cu = 0;
        if (hipGetDevice(&dev) != hipSuccess || hipDeviceGetAttribute(&cus, hipDeviceAttributeMultiprocessorCount, dev) != hipSuccess) { grid = -1; return; }
        if (hipFuncSetAttribute((const void*)fwd_kernel, hipFuncAttributeMaxDynamicSharedMemorySize, LDS_BYTES) != hipSuccess) { fprintf(stderr, "kernel_launch: hipFuncSetAttribute failed\n"); grid = -1; return; }
        if (hipOccupancyMaxActiveBlocksPerMultiprocessor(&per_cu, (const void*)fwd_kernel, NTHR, LDS_BYTES) != hipSuccess || per_cu < 1) fprintf(stderr, "kernel_launch: occupancy query reports %d\n", per_cu);
        (void)hipGetLastError();
        grid = cus;
    }
    if (grid < 0) return;
    if (hipMemsetAsync((char*)d_ws + WS_CTL, 0, CTL_ZERO_BYTES, stream) != hipSuccess) return;
    Args a{};
    for (int i = 0; i < 27; ++i) a.in[i] = (const float*)d_in[i];
    a.out = (float*)d_out; a.ws = (unsigned char*)d_ws;
    if (N_LAUNCHES == 1) { a.ph_lo = 0; a.ph_hi = PER_PHASE; hipLaunchKernelGGL(fwd_kernel, dim3(grid), dim3(NTHR), LDS_BYTES, stream, a); }
    else for (int p = 0; p < PER_PHASE; ++p) { a.ph_lo = p; a.ph_hi = p + 1; hipLaunchKernelGGL(fwd_kernel, dim3(grid), dim3(NTHR), LDS_BYTES, stream, a); }
}
```

```cpp
#include <hip/hip_runtime.h>
#include <cstdio>
#include <cstdint>

#ifndef MK_N_LAUNCHES
#define MK_N_LAUNCHES 1
#endif

#define LAS __attribute__((address_space(3)))
#define GAS __attribute__((address_space(1)))
typedef unsigned short bf16_t;
typedef short bf16x8 __attribute__((ext_vector_type(8)));
typedef float f32x4 __attribute__((ext_vector_type(4)));
typedef float f32x2 __attribute__((ext_vector_type(2)));
typedef unsigned u32x4 __attribute__((ext_vector_type(4)));
typedef unsigned u32x2 __attribute__((ext_vector_type(2)));

constexpr int D = 1024, BATCH = 32, SEQ = 2048, T = BATCH * SEQ, CTXL = 256, TC = BATCH * CTXL;
constexpr int DIN = 5664, NPAD = 5888;
constexpr int NE = 32, DE = 512;
constexpr int MAXTILES = 544, NPMAX = MAXTILES * 256;
constexpr float EPS = 1e-6f;
constexpr int NWAVES = 8, NTHR = 512;
constexpr int PER_PHASE = 13;
constexpr int N_LAUNCHES = MK_N_LAUNCHES;

constexpr size_t MiB = 1u << 20;
constexpr size_t WS_CTL = 0, CTL_ZERO_BYTES = 1 * MiB;
constexpr size_t WS_MOD = 1 * MiB;
constexpr size_t WS_EID = 2 * MiB;
constexpr size_t WS_EW = WS_EID + 512 * 1024;
constexpr size_t WS_POS = 3 * MiB;
constexpr size_t WS_IDX = WS_POS + 512 * 1024;
constexpr size_t WS_TILEE = 4 * MiB + 512 * 1024;
constexpr size_t WS_LR = 5 * MiB;
constexpr size_t WS_WIN = 14 * MiB;
constexpr size_t WS_WP = 26 * MiB;
constexpr size_t WS_WGLA = 27 * MiB;
constexpr size_t WS_WO = 29 * MiB;
constexpr size_t WS_W13 = 32 * MiB;
constexpr size_t WS_W2 = 96 * MiB;
constexpr size_t WS_HX = 128 * MiB;
constexpr size_t WS_PU = 272 * MiB;
constexpr size_t WS_PQKV = 336 * MiB;
constexpr size_t WS_PO = 336 * MiB;
constexpr size_t WS_Z = 400 * MiB;
constexpr size_t WS_HID = 272 * MiB;
constexpr size_t WS_PG = 592 * MiB;
constexpr size_t WS_PGATES = 720 * MiB;
constexpr size_t WS_Y = 592 * MiB;
constexpr size_t WS_PKVC = 976 * MiB;
constexpr size_t WS_END = 1000 * MiB;
static_assert(WS_HID + (size_t)NPMAX * 512 * 2 <= WS_PG && WS_Y + (size_t)NPMAX * 1024 * 2 <= WS_PKVC, "ws map");
constexpr int CW_CNT = 64;
constexpr int CW_CUR = 128;
constexpr int CW_NT = 192;
constexpr int CW_BAR = 4096;

constexpr int LDS_BYTES = 163840;
constexpr int MISC_OFF = LDS_BYTES - 256;

__device__ __forceinline__ unsigned cvt_pk_bf16(float lo, float hi) { unsigned r; asm volatile("v_cvt_pk_bf16_f32 %0, %1, %2" : "=v"(r) : "v"(lo), "v"(hi)); return r; }
__device__ __forceinline__ float bf_lo(unsigned w) { return __uint_as_float(w << 16); }
__device__ __forceinline__ float bf_hi(unsigned w) { return __uint_as_float(w & 0xffff0000u); }
__device__ __forceinline__ float bf2f(bf16_t h) { return __uint_as_float(((unsigned)h) << 16); }
__device__ __forceinline__ float wave_sum(float v) {
#pragma unroll
    for (int o = 1; o < 64; o <<= 1) v += __shfl_xor(v, o);
    return v;
}
__device__ __forceinline__ float sigmoidf_(float x) { return 1.f / (1.f + __expf(-x)); }
#define LDS_WAIT() asm volatile("s_waitcnt lgkmcnt(0)" ::: "memory")

#define XB_TMO      128
#define XB_XCNT(j)  (256  + 64 * (j))
#define XB_XSUB(j)  (1280 + 64 * (j))
#define XB_XGEN(j)  (2304 + 64 * (j))
#define XB_TOP      3328
#define XB_TOPGEN   3392
#define XCD_BAR_WORDS 3456
#define XB_SPIN_CAP (1u << 18)
__device__ __forceinline__ unsigned xb_ld(unsigned* p)              { return __hip_atomic_load(p, __ATOMIC_RELAXED, __HIP_MEMORY_SCOPE_AGENT); }
__device__ __forceinline__ unsigned xb_add(unsigned* p, unsigned v) { return __hip_atomic_fetch_add(p, v, __ATOMIC_RELAXED, __HIP_MEMORY_SCOPE_AGENT); }
__device__ __forceinline__ unsigned xb_xcc_id() { return (unsigned)__builtin_amdgcn_s_getreg((3 << 11) | 20) & 0xFu; }
#define XB_SPIN(cond, bar) do { unsigned _sp = 0; while (cond) { __builtin_amdgcn_s_sleep(1); \
    if ((++_sp & 255u) == 0u) { if (xb_ld(&(bar)[XB_TMO])) break; if (_sp > XB_SPIN_CAP) { atomicAdd(&(bar)[XB_TMO], 1u); break; } } } } while (0)
struct XcdBarrier { unsigned* bar; unsigned x; volatile LAS unsigned* st; };
__device__ __forceinline__ XcdBarrier xcd_barrier_post(unsigned* bar, volatile LAS unsigned* st) {
    XcdBarrier b; b.bar = bar; b.x = xb_xcc_id(); b.st = st;
    if (threadIdx.x == 0) (void)xb_add(&bar[XB_XCNT(b.x)], 1u);
    return b;
}
__device__ __forceinline__ void xcd_barrier_complete(unsigned* bar, unsigned x, unsigned& nloc, unsigned& nx) {
    const unsigned G = gridDim.x * gridDim.y * gridDim.z;
    unsigned sum, cnt, mine, sp = 0u;
    for (;;) {
        sum = 0u; cnt = 0u; mine = 0u;
#pragma unroll
        for (unsigned j = 0; j < 16; ++j) { const unsigned c = xb_ld(&bar[XB_XCNT(j)]); sum += c; cnt += (c > 0u) ? 1u : 0u; mine = (j == x) ? c : mine; }
        if (sum == G) break;
        __builtin_amdgcn_s_sleep(1);
        if ((++sp & 255u) == 0u) { if (xb_ld(&bar[XB_TMO])) break; if (sp > XB_SPIN_CAP) { atomicAdd(&bar[XB_TMO], 1u); break; } }
    }
    nloc = mine > 0u ? mine : 1u; nx = cnt > 0u ? cnt : 1u;
}
__device__ __forceinline__ void xcd_barrier(const XcdBarrier& b) {
    asm volatile("s_waitcnt vmcnt(0)" ::: "memory");
    __syncthreads();
    if (threadIdx.x == 0) {
        unsigned* bar = b.bar;
        __builtin_amdgcn_s_waitcnt(0);
        unsigned nloc = b.st[0], nx = b.st[1];
        if (nloc == 0u) { xcd_barrier_complete(bar, b.x, nloc, nx); b.st[0] = nloc; b.st[1] = nx; }
        const unsigned old = xb_add(&bar[XB_XSUB(b.x)], 1u);
        const unsigned gen = old / nloc;
        if (old + 1u == (gen + 1u) * nloc) {
            __builtin_amdgcn_fence(__ATOMIC_RELEASE, "agent");
            asm volatile("s_waitcnt vmcnt(0)" ::: "memory");
            const unsigned og = xb_add(&bar[XB_TOP], 1u);
            const unsigned tg = og / nx;
            if (og + 1u == (tg + 1u) * nx) xb_add(&bar[XB_TOPGEN], 1u);
            else XB_SPIN(xb_ld(&bar[XB_TOPGEN]) == tg, bar);
            __builtin_amdgcn_fence(__ATOMIC_ACQUIRE, "agent");
            xb_add(&bar[XB_XGEN(b.x)], 1u);
            asm volatile("s_waitcnt vmcnt(0)" ::: "memory");
        } else {
            XB_SPIN(xb_ld(&bar[XB_XGEN(b.x)]) == gen, bar);
            __builtin_amdgcn_fence(__ATOMIC_ACQUIRE, "agent");
            asm volatile("s_waitcnt vmcnt(0)" ::: "memory");
        }
    }
    __syncthreads();
}

namespace pg8 {
constexpr int BM = 256, BK = 64, HALF = 128, HTB = HALF * BK * 2, STAGE_BYTES = 8 * HTB, NXCD = 8, WGM = 8;
__host__ __device__ __forceinline__ int lds_byte(int r, int c) { const int st = (r >> 4) * 2 + (c >> 5), rr = r & 15, cc = c & 31, ob = rr * 64 + cc * 2; return st * 1024 + (ob ^ (((ob >> 9) & 1) << 5)); }
__host__ __device__ __forceinline__ void stage_rc(int b, int& R, int& C) { const int st = b / 1024, sb = b % 1024, swz = sb ^ (((sb >> 9) & 1) << 5); R = (st >> 1) * 16 + swz / 64; C = (st & 1) * 32 + (swz % 64) / 2; }
__host__ __device__ __forceinline__ int perm32(int rho) { const int n = rho >> 4, i = rho & 15; return 8 * (i >> 2) + 4 * n + (i & 3); }

struct Unit { const char* A; const char* B; unsigned va[2][2]; int pm, pn, aux; };

__device__ __forceinline__ void static_tile(int L, int nM, int nN, int& pm, int& pn) {
    const int nwg = nM * nN; int wgid = L; { const int q = nwg / NXCD, r = nwg % NXCD, xcd = wgid % NXCD, off = wgid / NXCD; wgid = (xcd < r ? xcd * (q + 1) : r * (q + 1) + (xcd - r) * q) + off; }
    const int nig = WGM * nN, gid = wgid / nig, fm = gid * WGM, gsz = (nM - fm) < WGM ? (nM - fm) : WGM;
    pm = fm + ((wgid % nig) % gsz); pn = (wgid % nig) / gsz;
}

template <class Epi, class Sched, bool ALIGN_EPI = true>
__device__ __forceinline__ void gemm_phase(LAS unsigned char* lds, const int K, const Sched& S, const Epi& E) {
    const int tid = threadIdx.x, wid = __builtin_amdgcn_readfirstlane(tid >> 6), lane = tid & 63, wr = wid >> 2, wc = wid & 3, fr = lane & 15, fq = lane >> 4;
    const int nt = K / BK;
    unsigned vb[2];
#pragma unroll
    for (int i = 0; i < 2; ++i) { int R, C; stage_rc(tid * 16 + i * 8192, R, C); const int Rb = Epi::PERM ? ((R & ~31) + perm32(R & 31)) : R; vb[i] = (unsigned)(Rb * K + C) * 2u; }
    const size_t kstep = (size_t)(BK * 2);
    const size_t hstep = (size_t)HALF * K * 2;
    const unsigned ldsw = (unsigned)wid * 1024u;
    const int aoff = lds_byte(wr * 64 + fr, fq * 8), boff = lds_byte(wc * 32 + fr, fq * 8);
#define PG8_SA(b, h) (((b) * 2 + (h)) * HTB)
#define PG8_SB(b, h) ((4 + (b) * 2 + (h)) * HTB)
#define PG8_STAGEA(bufoff, gbase, VA, h) do { _Pragma("unroll") for (int _i = 0; _i < 2; ++_i) \
        __builtin_amdgcn_global_load_lds((const unsigned*)((const char*)(gbase) + (VA)[h][_i]), (LAS unsigned*)(lds + (bufoff) + ldsw + _i * 8192), 16, 0, 0); } while (0)
#define PG8_STAGEB(bufoff, gbase) do { _Pragma("unroll") for (int _i = 0; _i < 2; ++_i) \
        __builtin_amdgcn_global_load_lds((const unsigned*)((const char*)(gbase) + vb[_i]), (LAS unsigned*)(lds + (bufoff) + ldsw + _i * 8192), 16, 0, 0); } while (0)
#define PG8_LDA(dst, b, h) do { _Pragma("unroll") for (int m = 0; m < 4; ++m) _Pragma("unroll") for (int k = 0; k < 2; ++k) dst[m][k] = *(const LAS bf16x8*)(lds + PG8_SA(b, h) + aoff + m * 2048 + k * 1024); } while (0)
#define PG8_LDB(dst, b, h) do { _Pragma("unroll") for (int n = 0; n < 2; ++n) _Pragma("unroll") for (int k = 0; k < 2; ++k) dst[n][k] = *(const LAS bf16x8*)(lds + PG8_SB(b, h) + boff + n * 2048 + k * 1024); } while (0)
#define PG8_MMA(ai, bj, At, Bt) do { __builtin_amdgcn_s_setprio(1); _Pragma("unroll") for (int m = 0; m < 4; ++m) _Pragma("unroll") for (int n = 0; n < 2; ++n) _Pragma("unroll") for (int k = 0; k < 2; ++k) \
        acc[ai][bj][m][n] = __builtin_amdgcn_mfma_f32_16x16x32_bf16(Bt[n][k], At[m][k], acc[ai][bj][m][n], 0, 0, 0); __builtin_amdgcn_s_setprio(0); } while (0)
#define PG8_WAIT_V(n) asm volatile("s_waitcnt vmcnt(" #n ")" ::: "memory")
#define PG8_WAIT_L(n) asm volatile("s_waitcnt lgkmcnt(" #n ")" ::: "memory")
#define PG8_BAR __builtin_amdgcn_s_barrier()
#define PG8_SCHED __builtin_amdgcn_sched_barrier(0)
    Unit cur, nxt; int ui = 0;
    if (!S.next(0, cur)) return;
    f32x4 acc[2][2][4][2];
#pragma unroll
    for (int a = 0; a < 2; ++a)
#pragma unroll
        for (int b = 0; b < 2; ++b)
#pragma unroll
            for (int m = 0; m < 4; ++m)
#pragma unroll
                for (int n = 0; n < 2; ++n) acc[a][b][m][n] = (f32x4){0.f, 0.f, 0.f, 0.f};
    bf16x8 At[4][2], B0[2][2], B1[2][2];
    const char* cA = cur.A; const char* cB = cur.B;
    PG8_STAGEB(PG8_SB(0, 0), cB); PG8_STAGEB(PG8_SB(0, 1), cB + hstep); PG8_STAGEA(PG8_SA(0, 0), cA, cur.va, 0); PG8_STAGEA(PG8_SA(0, 1), cA, cur.va, 1);
    if (wr == 1) PG8_BAR;
    PG8_WAIT_V(2); PG8_BAR;
    PG8_STAGEB(PG8_SB(1, 0), cB + kstep); PG8_STAGEA(PG8_SA(1, 0), cA + kstep, cur.va, 0); PG8_STAGEB(PG8_SB(1, 1), cB + hstep + kstep);
    PG8_WAIT_V(6); PG8_BAR;
    for (;;) {
        const bool has_next = S.next(ui + 1, nxt);
        if (!has_next) { nxt.A = cA; nxt.B = cB; nxt.va[0][0] = cur.va[0][0]; nxt.va[0][1] = cur.va[0][1]; nxt.va[1][0] = cur.va[1][0]; nxt.va[1][1] = cur.va[1][1]; }
        const char* nA = nxt.A; const char* nB = nxt.B;
        for (int t = 0; t < nt; t += 2) {
            const bool last = (t == nt - 2);
            const char* a1 = cA + (size_t)(t + 1) * kstep;
            const char* a2 = last ? nA : cA + (size_t)(t + 2) * kstep; const char* b2 = last ? nB : cB + (size_t)(t + 2) * kstep;
            const char* a3 = a2 + kstep; const char* b3 = b2 + kstep;
            unsigned v2[2][2];
            v2[0][0] = last ? nxt.va[0][0] : cur.va[0][0]; v2[0][1] = last ? nxt.va[0][1] : cur.va[0][1]; v2[1][0] = last ? nxt.va[1][0] : cur.va[1][0]; v2[1][1] = last ? nxt.va[1][1] : cur.va[1][1];
            PG8_LDB(B0, 0, 0); PG8_LDB(B1, 0, 1); PG8_SCHED; PG8_LDA(At, 0, 0); PG8_STAGEA(PG8_SA(1, 1), a1, cur.va, 1);
            PG8_WAIT_V(8); PG8_WAIT_L(0); PG8_BAR; PG8_MMA(0, 0, At, B0); PG8_MMA(0, 1, At, B1); PG8_BAR; PG8_SCHED;
            PG8_LDA(At, 0, 1); PG8_STAGEB(PG8_SB(0, 0), b2); PG8_STAGEB(PG8_SB(0, 1), b2 + hstep); PG8_STAGEA(PG8_SA(0, 0), a2, v2, 0);
            PG8_WAIT_V(8); PG8_WAIT_L(0); PG8_BAR; PG8_MMA(1, 0, At, B0); PG8_MMA(1, 1, At, B1); PG8_BAR; PG8_SCHED;
            PG8_LDB(B0, 1, 0); PG8_LDB(B1, 1, 1); PG8_SCHED; PG8_LDA(At, 1, 0); PG8_STAGEA(PG8_SA(0, 1), a2, v2, 1);
            PG8_WAIT_V(8); PG8_WAIT_L(0); PG8_BAR; PG8_MMA(0, 0, At, B0); PG8_MMA(0, 1, At, B1); PG8_BAR; PG8_SCHED;
            PG8_LDA(At, 1, 1); PG8_STAGEB(PG8_SB(1, 0), b3); PG8_STAGEB(PG8_SB(1, 1), b3 + hstep); PG8_STAGEA(PG8_SA(1, 0), a3, v2, 0);
            PG8_WAIT_V(8); PG8_WAIT_L(0); PG8_BAR; PG8_MMA(1, 0, At, B0); PG8_MMA(1, 1, At, B1); PG8_BAR; PG8_SCHED;
        }
        if constexpr (ALIGN_EPI) { if (wr == 0) PG8_BAR; }
        E(acc, cur, wr, wc, fr, fq);
        if (!has_next) break;
#pragma unroll
        for (int a = 0; a < 2; ++a)
#pragma unroll
            for (int b = 0; b < 2; ++b)
#pragma unroll
                for (int m = 0; m < 4; ++m)
#pragma unroll
                    for (int n = 0; n < 2; ++n) acc[a][b][m][n] = (f32x4){0.f, 0.f, 0.f, 0.f};
        cur = nxt; cA = nA; cB = nB; ++ui;
        if constexpr (ALIGN_EPI) { if (wr == 1) PG8_BAR; }
    }
    PG8_WAIT_V(0);
    if constexpr (!ALIGN_EPI) { if (wr == 0) PG8_BAR; }
    PG8_BAR;
#undef PG8_SA
#undef PG8_SB
#undef PG8_STAGEA
#undef PG8_STAGEB
#undef PG8_LDA
#undef PG8_LDB
#undef PG8_MMA
#undef PG8_WAIT_V
#undef PG8_WAIT_L
#undef PG8_BAR
#undef PG8_SCHED
}
__device__ __forceinline__ void contig_va(unsigned (&va)[2][2], unsigned lda) {
    const int tid = threadIdx.x;
#pragma unroll
    for (int i = 0; i < 2; ++i) { int R, C; stage_rc(tid * 16 + i * 8192, R, C); va[0][i] = (unsigned)R * lda + (unsigned)C * 2u; va[1][i] = (unsigned)(R + HALF) * lda + (unsigned)C * 2u; }
}
}

struct Frame {
    LAS unsigned char* lds;
    unsigned* ctl;
    int tid, lane, wave, vcu, G;
    const float* in[27];
    float* out;
    unsigned char* ws;
};
struct Args { const float* in[27]; float* out; unsigned char* ws; int ph_lo, ph_hi; };

__device__ __forceinline__ void p_adaln(Frame& F) {
    const int wg = blockIdx.x, tid = F.tid;
    if (wg >= 192) return;
    const float* c = F.in[1]; const float* cctx = F.in[3]; const float* wmod = F.in[4]; const float* bmod = F.in[5];
    float* mod = (float*)(F.ws + WS_MOD);
    LAS float* sc = (LAS float*)F.lds;
    for (int i = tid; i < 33 * 1024; i += NTHR) { const int r = i >> 10, k = i & 1023; const float v = (r < 32) ? c[r * 1024 + k] : cctx[k]; sc[k * 36 + r] = v / (1.f + expf(-v)); }
    __syncthreads();
    const int col = tid & 31, kq = tid >> 5, j = wg * 32 + col;
    float acc[33];
#pragma unroll
    for (int r = 0; r < 33; ++r) acc[r] = 0.f;
    for (int kk = 0; kk < 64; ++kk) {
        const int k = kq * 64 + kk; const float w = wmod[(size_t)k * 6144 + j];
        const LAS f32x4* sp = (const LAS f32x4*)(sc + k * 36);
#pragma unroll
        for (int q = 0; q < 8; ++q) { const f32x4 s4 = sp[q]; acc[4 * q] += s4[0] * w; acc[4 * q + 1] += s4[1] * w; acc[4 * q + 2] += s4[2] * w; acc[4 * q + 3] += s4[3] * w; }
        acc[32] += sc[k * 36 + 32] * w;
    }
    __syncthreads();
    LAS float* red = (LAS float*)F.lds;
#pragma unroll
    for (int r = 0; r < 33; ++r) red[(kq * 33 + r) * 32 + col] = acc[r];
    __syncthreads();
    for (int o = tid; o < 33 * 32; o += NTHR) { const int r = o >> 5, cc = o & 31; float s = 0.f;
#pragma unroll
        for (int q = 0; q < 16; ++q) s += red[(q * 33 + r) * 32 + cc];
        mod[r * 6144 + wg * 32 + cc] = s + bmod[wg * 32 + cc]; }
    __syncthreads();
}
__device__ __forceinline__ void transpose_item(const float* W, int ldw, int k0, int n0, bf16_t* WT, int ldk, int dst_row0, LAS float* scr, int lane) {
#pragma unroll 8
    for (int i = 0; i < 32; ++i) { const int kk = 2 * i + (lane >> 5); scr[kk * 33 + (lane & 31)] = W[(size_t)(k0 + kk) * ldw + n0 + (lane & 31)]; }
    LDS_WAIT(); asm volatile("" ::: "memory");
    const int c = lane & 7;
#pragma unroll
    for (int j = 0; j < 4; ++j) { const int n = (lane >> 3) + 8 * j; const LAS float* s = scr + (8 * c) * 33 + n;
        u32x4 o; o.x = cvt_pk_bf16(s[0 * 33], s[1 * 33]); o.y = cvt_pk_bf16(s[2 * 33], s[3 * 33]); o.z = cvt_pk_bf16(s[4 * 33], s[5 * 33]); o.w = cvt_pk_bf16(s[6 * 33], s[7 * 33]);
        *(u32x4*)(WT + (size_t)(dst_row0 + n) * ldk + k0 + 8 * c) = o; }
    LDS_WAIT(); asm volatile("" ::: "memory");
}
__device__ __forceinline__ void p_convert(Frame& F) {
    LAS float* scr = (LAS float*)(F.lds + F.wave * 16384);
    const int gw = F.vcu * NWAVES + F.wave, NGW = F.G * NWAVES, lane = F.lane;
    bf16_t* WIN = (bf16_t*)(F.ws + WS_WIN); bf16_t* WGLA = (bf16_t*)(F.ws + WS_WGLA); bf16_t* WO = (bf16_t*)(F.ws + WS_WO);
    bf16_t* W13 = (bf16_t*)(F.ws + WS_W13); bf16_t* W2 = (bf16_t*)(F.ws + WS_W2); bf16_t* WP = (bf16_t*)(F.ws + WS_WP);
    constexpr int I_IN = 16 * 177, I_SQ = 16 * 32, I_13 = 64 * 256, I_2 = 32 * 256;
    constexpr int NITEMS = I_IN + 2 * I_SQ + I_13 + I_2;
    for (int it = gw; it < NITEMS; it += NGW) {
        int r = it;
        if (r < I_IN) { const int kb = r / 177, nb = r % 177; transpose_item(F.in[8], DIN, 64 * kb, 32 * nb, WIN, 1024, 32 * nb, scr, lane); continue; } r -= I_IN;
        if (r < I_SQ) { const int kb = r / 32, nb = r % 32; transpose_item(F.in[17], 1024, 64 * kb, 32 * nb, WGLA, 1024, 32 * nb, scr, lane); continue; } r -= I_SQ;
        if (r < I_SQ) { const int kb = r / 32, nb = r % 32; transpose_item(F.in[18], 1024, 64 * kb, 32 * nb, WO, 1024, 32 * nb, scr, lane); continue; } r -= I_SQ;
        if (r < I_13) { const int mat = r / 256, e = mat >> 1, which = mat & 1, rr = r % 256, kb = rr / 16, nb = rr % 16, n0 = 32 * nb;
            const float* src = (which ? F.in[24] : F.in[23]) + (size_t)e * 1024 * 512;
            transpose_item(src, 512, 64 * kb, n0, W13 + (size_t)e * 1024 * 1024, 1024, (n0 / 128) * 256 + (n0 % 128) + which * 128, scr, lane); continue; } r -= I_13;
        { const int e = r / 256, rr = r % 256, kb = rr / 32, nb = rr % 32;
            transpose_item(F.in[25] + (size_t)e * 512 * 1024, 1024, 64 * kb, 32 * nb, W2 + (size_t)e * 1024 * 512, 512, 32 * nb, scr, lane); }
    }
    { const int gt = F.vcu * NTHR + F.tid, NGT = F.G * NTHR; u32x4 z = (u32x4){0u, 0u, 0u, 0u};
        for (int i = gt; i < 224 * 128; i += NGT) *(u32x4*)((char*)(WIN + (size_t)DIN * 1024) + (size_t)i * 16) = z; }
    { const float* pw = F.in[14]; const float* ps = F.in[15]; const float* wbr = F.in[16];
        const int gt = F.vcu * NTHR + F.tid, NGT = F.G * NTHR;
        for (int o = gt; o < 512 * 1024; o += NGT) { const int e = o & 1023, k = o >> 10, gi = k >> 7; const float* pr = pw + (size_t)k * 128; float s = 0.f;
            for (int j = 0; j < 128; ++j) s += pr[j] * ps[gi * 128 + j] * wbr[(size_t)(gi * 128 + j) * 1024 + e];
            WP[(size_t)e * 512 + k] = (bf16_t)(cvt_pk_bf16(s, 0.f) & 0xffffu); } }
}

__device__ __forceinline__ void norm_rows(const float* src, bf16_t* dst, int row0, int nrows, const float* gain, const float* scv, const float* shv, int lane) {
    f32x4 Av[4], Bv[4];
#pragma unroll
    for (int j = 0; j < 4; ++j) { const int c = 4 * lane + 256 * j; const f32x4 g = *(const f32x4*)(gain + c), s = *(const f32x4*)(scv + c); Av[j] = g * (s + 1.f); Bv[j] = *(const f32x4*)(shv + c); }
    for (int r = 0; r < nrows; ++r) {
        const float* xr = src + (size_t)(row0 + r) * D; f32x4 v[4]; float ss = 0.f;
#pragma unroll
        for (int j = 0; j < 4; ++j) { v[j] = *(const f32x4*)(xr + 4 * lane + 256 * j); ss += (v[j][0] * v[j][0] + v[j][1] * v[j][1]) + (v[j][2] * v[j][2] + v[j][3] * v[j][3]); }
        const float rstd = 1.f / sqrtf(wave_sum(ss) * (1.f / D) + EPS);
        bf16_t* orow = dst + (size_t)(row0 + r) * D;
#pragma unroll
        for (int j = 0; j < 4; ++j) { const f32x4 h = v[j] * rstd * Av[j] + Bv[j]; u32x2 w; w.x = cvt_pk_bf16(h[0], h[1]); w.y = cvt_pk_bf16(h[2], h[3]); *(u32x2*)(orow + 4 * lane + 256 * j) = w; }
    }
}
__device__ __forceinline__ void p_norm1(Frame& F) {
    const int gw = F.vcu * NWAVES + F.wave;
    const int NGW = F.G * NWAVES;
    const float* mod = (const float*)(F.ws + WS_MOD); bf16_t* HX = (bf16_t*)(F.ws + WS_HX);
    for (int w = gw; w < 2048; w += NGW) {
        const int b = w >> 6;
        norm_rows(F.in[0], HX, w * 32, 32, F.in[6], mod + b * 6144 + 1024, mod + b * 6144, F.lane);
        norm_rows(F.in[2], HX + (size_t)T * D, w * 4, 4, F.in[6], mod + 32 * 6144 + 1024, mod + 32 * 6144, F.lane);
    }
}

struct SchedG1 {
    const char* HX; const char* WIN; int G, c;
    __device__ __forceinline__ bool next(int i, pg8::Unit& u) const {
        const int L = i * G + c; constexpr int NL = 256 * 23, NC = 32 * 7;
        if (L >= NL + NC) return false;
        int pm, pn, ctx = 0;
        if (L < NL) pg8::static_tile(L, 256, 23, pm, pn);
        else { const int j = L - NL; pm = j & 31; const int q = j >> 5; pn = (q < 6) ? 4 + q : 22; ctx = 1; }
        u.pm = pm; u.pn = pn; u.aux = ctx;
        u.A = HX + ((size_t)(ctx ? T : 0) + (size_t)pm * 256) * (D * 2); u.B = WIN + (size_t)pn * 256 * (D * 2);
        pg8::contig_va(u.va, D * 2);
        return true;
    }
};
struct EpiG1 {
    static constexpr bool PERM = true;
    unsigned char* ws;
    __device__ __forceinline__ void operator()(const f32x4 (&acc)[2][2][4][2], const pg8::Unit& u, int wr, int wc, int fr, int fq) const {
        const int pn = u.pn, ctx = u.aux; const int row0 = u.pm * 256 + wr * 64 + fr;
        if (pn == 22) {
            if (wc != 0) return;
            float* LR = (float*)(ws + WS_LR) + (size_t)(ctx ? T : 0) * 32;
#pragma unroll
            for (int ai = 0; ai < 2; ++ai)
#pragma unroll
                for (int m = 0; m < 4; ++m) { float* rp = LR + (size_t)(row0 + ai * 128 + m * 16) * 32 + 8 * fq; *(f32x4*)rp = acc[ai][0][m][0]; *(f32x4*)(rp + 4) = acc[ai][0][m][1]; }
            return;
        }
        bf16_t* base; int ldc, colt; float sc = 1.f;
        if (ctx) { base = (bf16_t*)(ws + WS_PKVC); ldc = 1536; colt = (pn - 4) * 256; }
        else if (pn < 2) { base = (bf16_t*)(ws + WS_PU); ldc = 512; colt = pn * 256; }
        else if (pn < 10) { base = (bf16_t*)(ws + WS_PQKV); ldc = 2048; colt = (pn - 2) * 256; if (pn < 4) sc = 0.08838834764831845f; }
        else if (pn < 14) { base = (bf16_t*)(ws + WS_PG); ldc = 1024; colt = (pn - 10) * 256; }
        else { base = (bf16_t*)(ws + WS_PGATES); ldc = 2048; colt = (pn - 14) * 256; }
        const int col0 = colt + wc * 32 + 8 * fq;
#pragma unroll
        for (int ai = 0; ai < 2; ++ai)
#pragma unroll
            for (int m = 0; m < 4; ++m) { bf16_t* rowp = base + (size_t)(row0 + ai * 128 + m * 16) * ldc + col0;
#pragma unroll
                for (int bj = 0; bj < 2; ++bj) { const f32x4 v0 = acc[ai][bj][m][0] * sc, v1 = acc[ai][bj][m][1] * sc;
                    u32x4 w; w.x = cvt_pk_bf16(v0[0], v0[1]); w.y = cvt_pk_bf16(v0[2], v0[3]); w.z = cvt_pk_bf16(v1[0], v1[1]); w.w = cvt_pk_bf16(v1[2], v1[3]);
                    *(u32x4*)(rowp + bj * 128) = w; } }
    }
};

__device__ __forceinline__ void p_gla_naive(Frame& F) {
    const int tid = F.tid;
    const bf16_t* PQKV = (const bf16_t*)(F.ws + WS_PQKV); const bf16_t* PKVC = (const bf16_t*)(F.ws + WS_PKVC); const float* LR = (const float*)(F.ws + WS_LR);
    LAS float* a2L = (LAS float*)F.lds;
    LAS float* abL = a2L + 2048;
    LAS float* lrL = abL + 128;
    LAS float* alL = lrL + 256;
    LAS float* kL = alL + 2048;
    LAS float* qL = kL + 2048;
    LAS float* vL = qL + 2048;
    LAS float* oL = vL + 4096;
    for (int wgi = blockIdx.x; wgi < 256; wgi += F.G) {
        const int b = wgi >> 3, h = (wgi >> 1) & 3, dir = wgi & 1;
        bf16_t* OD = (bf16_t*)F.out + (size_t)dir * T * D;
        const float* a2 = dir ? F.in[11] : F.in[9]; const float* ab = dir ? F.in[12] : F.in[10];
        __syncthreads();
        for (int i = tid; i < 2048; i += NTHR) a2L[i] = a2[(i >> 7) * 512 + h * 128 + (i & 127)];
        if (tid < 128) abL[tid] = ab[h * 128 + tid];
        const int v = tid & 255, dh = tid >> 8;
        f32x2 S[32];
#pragma unroll
        for (int i = 0; i < 32; ++i) S[i] = (f32x2){0.f, 0.f};
        for (int blk = 0; blk < 144; ++blk) {
            const bool isctx = blk < 16; const int bi = isctx ? blk : blk - 16; const int N = isctx ? CTXL : SEQ;
            __syncthreads();
            if (tid < 256) { const int j = tid >> 4, r = tid & 15; const int n = dir ? (N - 1 - (bi * 16 + j)) : (bi * 16 + j);
                const size_t row = isctx ? (size_t)T + b * CTXL + n : (size_t)b * SEQ + n; lrL[j * 16 + r] = LR[row * 32 + dir * 16 + r]; }
            for (int q = 0; q < 4; ++q) { const int idx = tid + NTHR * q, j = idx >> 7, d = idx & 127; const int n = dir ? (N - 1 - (bi * 16 + j)) : (bi * 16 + j);
                if (isctx) { const size_t row = (size_t)b * CTXL + n; kL[idx] = bf2f(PKVC[row * 1536 + h * 128 + d]); }
                else { const size_t row = (size_t)b * SEQ + n; kL[idx] = bf2f(PQKV[row * 2048 + 512 + h * 128 + d]); qL[idx] = bf2f(PQKV[row * 2048 + h * 128 + d]); } }
            for (int q = 0; q < 8; ++q) { const int idx = tid + NTHR * q, j = idx >> 8, vv = idx & 255; const int n = dir ? (N - 1 - (bi * 16 + j)) : (bi * 16 + j);
                if (isctx) { const size_t row = (size_t)b * CTXL + n; vL[idx] = bf2f(PKVC[row * 1536 + 512 + h * 256 + vv]); }
                else { const size_t row = (size_t)b * SEQ + n; vL[idx] = bf2f(PQKV[row * 2048 + 1024 + h * 256 + vv]); } }
            __syncthreads();
            for (int q = 0; q < 4; ++q) { const int idx = tid + NTHR * q, j = idx >> 7, d = idx & 127; float z = abL[d];
#pragma unroll
                for (int r = 0; r < 16; ++r) z += lrL[j * 16 + r] * a2L[r * 128 + d];
                const float la = fminf(z, 0.f) - log1pf(expf(-fabsf(z)));
                alL[idx] = expf(la * (1.f / 16.f)); }
            __syncthreads();
            for (int j = 0; j < 16; ++j) {
                const float vv = vL[j * 256 + v]; f32x2 o2 = (f32x2){0.f, 0.f};
                const LAS f32x4* ap = (const LAS f32x4*)(alL + j * 128 + dh * 64); const LAS f32x4* kp = (const LAS f32x4*)(kL + j * 128 + dh * 64); const LAS f32x4* qp = (const LAS f32x4*)(qL + j * 128 + dh * 64);
                if (isctx) {
#pragma unroll
                    for (int i = 0; i < 16; ++i) { const f32x4 a4 = ap[i], k4 = kp[i];
                        S[2 * i] = (f32x2){a4[0], a4[1]} * S[2 * i] + (f32x2){k4[0], k4[1]} * vv; S[2 * i + 1] = (f32x2){a4[2], a4[3]} * S[2 * i + 1] + (f32x2){k4[2], k4[3]} * vv; }
                } else {
#pragma unroll
                    for (int i = 0; i < 16; ++i) { const f32x4 a4 = ap[i], k4 = kp[i], q4 = qp[i];
                        S[2 * i] = (f32x2){a4[0], a4[1]} * S[2 * i] + (f32x2){k4[0], k4[1]} * vv; S[2 * i + 1] = (f32x2){a4[2], a4[3]} * S[2 * i + 1] + (f32x2){k4[2], k4[3]} * vv;
                        o2 += (f32x2){q4[0], q4[1]} * S[2 * i] + (f32x2){q4[2], q4[3]} * S[2 * i + 1]; }
                    oL[(dh * 16 + j) * 256 + v] = o2[0] + o2[1];
                }
            }
            if (!isctx) {
                __syncthreads();
                for (int q = 0; q < 4; ++q) { const int idx = tid + NTHR * q, j = idx >> 7, vp = (idx & 127) * 2; const int n = dir ? (SEQ - 1 - (bi * 16 + j)) : (bi * 16 + j);
                    const float o0 = oL[j * 256 + vp] + oL[(16 + j) * 256 + vp], o1 = oL[j * 256 + vp + 1] + oL[(16 + j) * 256 + vp + 1];
                    *(unsigned*)(OD + ((size_t)b * SEQ + n) * D + h * 256 + vp) = cvt_pk_bf16(o0, o1); }
            }
        }
    }
    __syncthreads();
}

__device__ __forceinline__ void p_prep(Frame& F) {
    const int gw = F.vcu * NWAVES + F.wave, NGW = F.G * NWAVES, lane = F.lane;
    const bf16_t* OF = (const bf16_t*)F.out; const bf16_t* OB = OF + (size_t)T * D; const bf16_t* PG = (const bf16_t*)(F.ws + WS_PG);
    bf16_t* OG = (bf16_t*)(F.ws + WS_HX);
    const f32x4 gn = *(const f32x4*)(F.in[13] + 4 * lane);
    for (int w = gw; w < 2048; w += NGW)
        for (int r = 0; r < 32; ++r) {
            const size_t row = (size_t)w * 32 + r;
#pragma unroll
            for (int j = 0; j < 4; ++j) { const size_t off = row * D + 4 * lane + 256 * j;
                const u32x2 a = *(const u32x2*)(OF + off), bq = *(const u32x2*)(OB + off), gq = *(const u32x2*)(PG + off);
                f32x4 o; o[0] = bf_lo(a.x) + bf_lo(bq.x); o[1] = bf_hi(a.x) + bf_hi(bq.x); o[2] = bf_lo(a.y) + bf_lo(bq.y); o[3] = bf_hi(a.y) + bf_hi(bq.y);
                const float ss = wave_sum((o[0] * o[0] + o[1] * o[1]) + (o[2] * o[2] + o[3] * o[3]));
                const float rstd = 1.f / sqrtf(ss * (1.f / 256.f) + EPS);
                f32x4 g; g[0] = bf_lo(gq.x); g[1] = bf_hi(gq.x); g[2] = bf_lo(gq.y); g[3] = bf_hi(gq.y);
                f32x4 y;
#pragma unroll
                for (int e = 0; e < 4; ++e) y[e] = o[e] * rstd * gn[e] * (g[e] * sigmoidf_(g[e]));
                u32x2 wv; wv.x = cvt_pk_bf16(y[0], y[1]); wv.y = cvt_pk_bf16(y[2], y[3]); *(u32x2*)(OG + off) = wv; }
        }
    const bf16_t* PU = (const bf16_t*)(F.ws + WS_PU); bf16_t* PO = (bf16_t*)(F.ws + WS_PO);
    LAS unsigned* uL = (LAS unsigned*)F.lds;
    for (int tt = F.vcu; tt < T / 64; tt += F.G) {
        __syncthreads();
        for (int i = F.tid; i < 64 * 64; i += NTHR) *(LAS u32x4*)(uL + i * 4) = *(const u32x4*)(PU + (size_t)tt * 64 * 512 + (size_t)i * 8);
        __syncthreads();
        const int cp = F.tid & 255, half = F.tid >> 8, gi = cp >> 6, hw = 1 << gi;
        for (int p = half * 32; p < half * 32 + 32; ++p) {
            const int lo = (p - hw) < 0 ? 0 : (p - hw), hi = (p + hw) > 64 ? 64 : (p + hw);
            float s0 = 0.f, s1 = 0.f;
            for (int s = lo; s < hi; ++s) { const unsigned w = uL[s * 256 + cp]; s0 += bf_lo(w); s1 += bf_hi(w); }
            const unsigned self = uL[p * 256 + cp]; const float inv = 1.f / (float)(hi - lo);
            *(unsigned*)(PO + ((size_t)tt * 64 + p) * 512 + 2 * cp) = cvt_pk_bf16(s0 * inv - bf_lo(self), s1 * inv - bf_hi(self));
        }
    }
    __syncthreads();
}

struct SchedSq {
    const char* A; const char* B; unsigned lda; int K, G, c;
    __device__ __forceinline__ bool next(int i, pg8::Unit& u) const {
        const int L = i * G + c; if (L >= 1024) return false;
        int pm, pn; pg8::static_tile(L, 256, 4, pm, pn); u.pm = pm; u.pn = pn; u.aux = 0;
        u.A = A + (size_t)pm * 256 * lda; u.B = B + (size_t)pn * 256 * (K * 2); pg8::contig_va(u.va, lda); return true;
    }
};
__device__ __forceinline__ void unpack8(const u32x4 w, float (&f)[8]) { f[0] = bf_lo(w.x); f[1] = bf_hi(w.x); f[2] = bf_lo(w.y); f[3] = bf_hi(w.y); f[4] = bf_lo(w.z); f[5] = bf_hi(w.z); f[6] = bf_lo(w.w); f[7] = bf_hi(w.w); }
struct EpiPool {
    static constexpr bool PERM = true;
    const bf16_t* GATES; bf16_t* Z;
    __device__ __forceinline__ void operator()(const f32x4 (&acc)[2][2][4][2], const pg8::Unit& u, int wr, int wc, int fr, int fq) const {
        const int row0 = u.pm * 256 + wr * 64 + fr, col0 = u.pn * 256 + wc * 32 + 8 * fq;
#pragma unroll
        for (int ai = 0; ai < 2; ++ai)
#pragma unroll
            for (int m = 0; m < 4; ++m) { const size_t row = row0 + ai * 128 + m * 16;
#pragma unroll
                for (int bj = 0; bj < 2; ++bj) { const int col = col0 + bj * 128; float g[8]; unpack8(*(const u32x4*)(GATES + row * 2048 + col), g);
                    const f32x4 a0 = acc[ai][bj][m][0], a1 = acc[ai][bj][m][1]; float z[8];
#pragma unroll
                    for (int e = 0; e < 4; ++e) { z[e] = a0[e] * sigmoidf_(g[e]); z[4 + e] = a1[e] * sigmoidf_(g[4 + e]); }
                    u32x4 w; w.x = cvt_pk_bf16(z[0], z[1]); w.y = cvt_pk_bf16(z[2], z[3]); w.z = cvt_pk_bf16(z[4], z[5]); w.w = cvt_pk_bf16(z[6], z[7]);
                    *(u32x4*)(Z + row * 1024 + col) = w; } }
    }
};
struct EpiGla {
    static constexpr bool PERM = true;
    const bf16_t* GATES; bf16_t* Z;
    __device__ __forceinline__ void operator()(const f32x4 (&acc)[2][2][4][2], const pg8::Unit& u, int wr, int wc, int fr, int fq) const {
        const int row0 = u.pm * 256 + wr * 64 + fr, col0 = u.pn * 256 + wc * 32 + 8 * fq;
#pragma unroll
        for (int ai = 0; ai < 2; ++ai)
#pragma unroll
            for (int m = 0; m < 4; ++m) { const size_t row = row0 + ai * 128 + m * 16;
#pragma unroll
                for (int bj = 0; bj < 2; ++bj) { const int col = col0 + bj * 128; float g[8], zp[8]; unpack8(*(const u32x4*)(GATES + row * 2048 + 1024 + col), g); unpack8(*(const u32x4*)(Z + row * 1024 + col), zp);
                    const f32x4 a0 = acc[ai][bj][m][0], a1 = acc[ai][bj][m][1]; float z[8];
#pragma unroll
                    for (int e = 0; e < 4; ++e) { z[e] = zp[e] + a0[e] * sigmoidf_(g[e]); z[4 + e] = zp[4 + e] + a1[e] * sigmoidf_(g[4 + e]); }
                    u32x4 w; w.x = cvt_pk_bf16(z[0], z[1]); w.y = cvt_pk_bf16(z[2], z[3]); w.z = cvt_pk_bf16(z[4], z[5]); w.w = cvt_pk_bf16(z[6], z[7]);
                    *(u32x4*)(Z + row * 1024 + col) = w; } }
    }
};
struct EpiWo {
    static constexpr bool PERM = false;
    const float* X; const float* MOD; float* X1;
    __device__ __forceinline__ void operator()(const f32x4 (&acc)[2][2][4][2], const pg8::Unit& u, int wr, int wc, int fr, int fq) const {
        const int row0 = u.pm * 256 + wr * 64 + fr, col0 = u.pn * 256 + wc * 32 + 4 * fq; const int b = u.pm >> 3;
        f32x4 gv[2][2];
#pragma unroll
        for (int bj = 0; bj < 2; ++bj)
#pragma unroll
            for (int n = 0; n < 2; ++n) gv[bj][n] = *(const f32x4*)(MOD + b * 6144 + 2048 + col0 + bj * 128 + n * 16);
#pragma unroll
        for (int ai = 0; ai < 2; ++ai)
#pragma unroll
            for (int m = 0; m < 4; ++m) { const size_t off = (size_t)(row0 + ai * 128 + m * 16) * D + col0;
#pragma unroll
                for (int bj = 0; bj < 2; ++bj)
#pragma unroll
                    for (int n = 0; n < 2; ++n) { const f32x4 xv = *(const f32x4*)(X + off + bj * 128 + n * 16); *(f32x4*)(X1 + off + bj * 128 + n * 16) = xv + gv[bj][n] * acc[ai][bj][m][n]; } }
    }
};

__device__ __forceinline__ void p_norm2_router(Frame& F) {
    const int tid = F.tid, lane = F.lane;
    LAS float* WR = (LAS float*)F.lds;
    LAS unsigned* hist = (LAS unsigned*)(F.lds + 36 * 1024 * 4);
    const float* rgw = F.in[19]; const float* rgb = F.in[20]; const float* rew = F.in[21]; const float* reb = F.in[22];
    for (int i = tid; i < 1024 * 4; i += NTHR) WR[(i & 3) * 1024 + (i >> 2)] = rgw[i];
    for (int i = tid; i < 1024 * 32; i += NTHR) WR[(4 + (i & 31)) * 1024 + (i >> 5)] = rew[i];
    if (tid < 32) hist[tid] = 0u;
    __syncthreads();
    const float* mod = (const float*)(F.ws + WS_MOD); const float* X1 = F.out; bf16_t* H2 = (bf16_t*)(F.ws + WS_HX);
    int* EID = (int*)(F.ws + WS_EID); float* EW = (float*)(F.ws + WS_EW);
    const int gw = F.vcu * NWAVES + F.wave, NGW = F.G * NWAVES;
    for (int w = gw; w < 2048; w += NGW) {
        const int b = w >> 6;
        f32x4 Av[4], Bv[4];
#pragma unroll
        for (int j = 0; j < 4; ++j) { const int c = 4 * lane + 256 * j; const f32x4 g = *(const f32x4*)(F.in[7] + c), s = *(const f32x4*)(mod + b * 6144 + 4 * 1024 + c); Av[j] = g * (s + 1.f); Bv[j] = *(const f32x4*)(mod + b * 6144 + 3 * 1024 + c); }
        for (int r = 0; r < 32; ++r) {
            const size_t row = (size_t)w * 32 + r; const float* xr = X1 + row * D; f32x4 v[4]; float ss = 0.f;
#pragma unroll
            for (int j = 0; j < 4; ++j) { v[j] = *(const f32x4*)(xr + 4 * lane + 256 * j); ss += (v[j][0] * v[j][0] + v[j][1] * v[j][1]) + (v[j][2] * v[j][2] + v[j][3] * v[j][3]); }
            const float rstd = 1.f / sqrtf(wave_sum(ss) * (1.f / D) + EPS);
            bf16_t* orow = H2 + row * D;
#pragma unroll
            for (int j = 0; j < 4; ++j) { v[j] = v[j] * rstd * Av[j] + Bv[j]; u32x2 wv; wv.x = cvt_pk_bf16(v[j][0], v[j][1]); wv.y = cvt_pk_bf16(v[j][2], v[j][3]); *(u32x2*)(orow + 4 * lane + 256 * j) = wv; }
            float gl[4];
#pragma unroll
            for (int o = 0; o < 4; ++o) { float s = 0.f;
#pragma unroll
                for (int j = 0; j < 4; ++j) { const f32x4 wv = *(const LAS f32x4*)(WR + o * 1024 + 4 * lane + 256 * j); s += (v[j][0] * wv[0] + v[j][1] * wv[1]) + (v[j][2] * wv[2] + v[j][3] * wv[3]); }
                gl[o] = wave_sum(s) + rgb[o]; }
            int gsel = 0; float gmax = gl[0];
#pragma unroll
            for (int o = 1; o < 4; ++o) if (gl[o] > gmax) { gmax = gl[o]; gsel = o; }
            const float pgrp = 1.f / (expf(gl[0] - gmax) + expf(gl[1] - gmax) + expf(gl[2] - gmax) + expf(gl[3] - gmax));
            gsel = __builtin_amdgcn_readfirstlane(gsel);
            float el[8];
#pragma unroll
            for (int o = 0; o < 8; ++o) { float s = 0.f; const LAS float* wp = WR + (4 + gsel * 8 + o) * 1024;
#pragma unroll
                for (int j = 0; j < 4; ++j) { const f32x4 wv = *(const LAS f32x4*)(wp + 4 * lane + 256 * j); s += (v[j][0] * wv[0] + v[j][1] * wv[1]) + (v[j][2] * wv[2] + v[j][3] * wv[3]); }
                el[o] = wave_sum(s) + reb[gsel * 8 + o]; }
            int i0 = 0; float m0 = el[0];
#pragma unroll
            for (int o = 1; o < 8; ++o) if (el[o] > m0) { m0 = el[o]; i0 = o; }
            int i1 = -1; float m1 = -3.0e38f;
#pragma unroll
            for (int o = 0; o < 8; ++o) if (o != i0 && el[o] > m1) { m1 = el[o]; i1 = o; }
            const float e1 = expf(m1 - m0), w0 = pgrp / (1.f + e1), w1 = pgrp * e1 / (1.f + e1);
            if (lane == 0) { const int x0 = gsel * 8 + i0, x1 = gsel * 8 + i1; EID[row * 2] = x0; EID[row * 2 + 1] = x1; EW[row * 2] = w0; EW[row * 2 + 1] = w1;
                atomicAdd((unsigned*)&hist[x0], 1u); atomicAdd((unsigned*)&hist[x1], 1u); }
        }
    }
    __syncthreads();
    if (tid < 32 && hist[tid]) __hip_atomic_fetch_add(F.ctl + CW_CNT + tid, hist[tid], __ATOMIC_RELAXED, __HIP_MEMORY_SCOPE_AGENT);
    __syncthreads();
}

__device__ __forceinline__ void p_index(Frame& F) {
    const int tid = F.tid;
    LAS unsigned* offL = (LAS unsigned*)F.lds;
    LAS unsigned* cntL = offL + 64;
    LAS unsigned* h2 = offL + 128;
    LAS unsigned* baseL = offL + 192;
    const int* EID = (const int*)(F.ws + WS_EID); int* POS = (int*)(F.ws + WS_POS); int* IDX = (int*)(F.ws + WS_IDX); int* TILEE = (int*)(F.ws + WS_TILEE);
    __syncthreads();
    if (tid == 0) { unsigned o = 0; for (int e = 0; e < 32; ++e) { const unsigned c = __hip_atomic_load(F.ctl + CW_CNT + e, __ATOMIC_RELAXED, __HIP_MEMORY_SCOPE_AGENT); cntL[e] = c; offL[e] = o; o += (c + 255u) & ~255u; } offL[32] = o; }
    __syncthreads();
    const unsigned ntiles = offL[32] >> 8;
    if (blockIdx.x == 0) {
        if (tid == 0) F.ctl[CW_NT] = ntiles;
        for (unsigned t = tid; t < ntiles; t += NTHR) { int e = 0; for (int q = 0; q < 32; ++q) if (t * 256u >= offL[q] && t * 256u < offL[q + 1]) e = q; TILEE[t] = e; }
    }
    for (int e = blockIdx.x; e < 32; e += F.G) for (unsigned p = offL[e] + cntL[e] + tid; p < offL[e + 1]; p += NTHR) IDX[p] = 0;
    for (int chunk = blockIdx.x; chunk < T / 256; chunk += F.G) {
        __syncthreads();
        if (tid < 32) h2[tid] = 0u;
        __syncthreads();
        const int token = chunk * 256 + (tid >> 1), k = tid & 1; const int e = EID[token * 2 + k];
        const unsigned rnk = atomicAdd((unsigned*)&h2[e], 1u);
        __syncthreads();
        if (tid < 32) baseL[tid] = h2[tid] ? __hip_atomic_fetch_add(F.ctl + CW_CUR + tid, h2[tid], __ATOMIC_RELAXED, __HIP_MEMORY_SCOPE_AGENT) : 0u;
        __syncthreads();
        const unsigned pos = offL[e] + baseL[e] + rnk;
        IDX[pos] = token; POS[token * 2 + k] = (int)pos;
    }
    __syncthreads();
}

struct SchedMoe1 {
    const char* H2; const char* W13; const int* IDX; const int* TILEE; int nunits, G, c;
    __device__ __forceinline__ bool next(int i, pg8::Unit& u) const {
        const int L = i * G + c; if (L >= nunits) return false;
        const int tile = L >> 2, pn = L & 3; const int e = __builtin_amdgcn_readfirstlane(TILEE[tile]);
        u.pm = tile; u.pn = pn; u.aux = e; u.A = H2; u.B = W13 + ((size_t)e * 1024 + (size_t)pn * 256) * 2048;
        const int tid = threadIdx.x;
#pragma unroll
        for (int k = 0; k < 2; ++k) { int R, C; pg8::stage_rc(tid * 16 + k * 8192, R, C);
            u.va[0][k] = (unsigned)IDX[tile * 256 + R] * 2048u + (unsigned)C * 2u; u.va[1][k] = (unsigned)IDX[tile * 256 + 128 + R] * 2048u + (unsigned)C * 2u; }
        return true;
    }
};
struct EpiMoe1 {
    static constexpr bool PERM = true;
    bf16_t* HID;
    __device__ __forceinline__ void operator()(const f32x4 (&acc)[2][2][4][2], const pg8::Unit& u, int wr, int wc, int fr, int fq) const {
        const int row0 = u.pm * 256 + wr * 64 + fr, col0 = u.pn * 128 + wc * 32 + 8 * fq;
#pragma unroll
        for (int ai = 0; ai < 2; ++ai)
#pragma unroll
            for (int m = 0; m < 4; ++m) { const size_t row = row0 + ai * 128 + m * 16; float hv[8];
#pragma unroll
                for (int n = 0; n < 2; ++n)
#pragma unroll
                    for (int e = 0; e < 4; ++e) { const float a = acc[ai][0][m][n][e], bq = acc[ai][1][m][n][e]; hv[4 * n + e] = a * sigmoidf_(a) * bq; }
                u32x4 w; w.x = cvt_pk_bf16(hv[0], hv[1]); w.y = cvt_pk_bf16(hv[2], hv[3]); w.z = cvt_pk_bf16(hv[4], hv[5]); w.w = cvt_pk_bf16(hv[6], hv[7]);
                *(u32x4*)(HID + row * 512 + col0) = w; }
    }
};
struct SchedMoe2 {
    const char* HID; const char* W2; const int* TILEE; int nunits, G, c;
    __device__ __forceinline__ bool next(int i, pg8::Unit& u) const {
        const int L = i * G + c; if (L >= nunits) return false;
        const int tile = L >> 2, pn = L & 3; const int e = __builtin_amdgcn_readfirstlane(TILEE[tile]);
        u.pm = tile; u.pn = pn; u.aux = e; u.A = HID + (size_t)tile * 256 * 1024; u.B = W2 + ((size_t)e * 1024 + (size_t)pn * 256) * 1024;
        pg8::contig_va(u.va, 1024); return true;
    }
};
struct EpiMoe2 {
    static constexpr bool PERM = true;
    bf16_t* Y;
    __device__ __forceinline__ void operator()(const f32x4 (&acc)[2][2][4][2], const pg8::Unit& u, int wr, int wc, int fr, int fq) const {
        const int row0 = u.pm * 256 + wr * 64 + fr, col0 = u.pn * 256 + wc * 32 + 8 * fq;
#pragma unroll
        for (int ai = 0; ai < 2; ++ai)
#pragma unroll
            for (int m = 0; m < 4; ++m) { bf16_t* rowp = Y + (size_t)(row0 + ai * 128 + m * 16) * 1024 + col0;
#pragma unroll
                for (int bj = 0; bj < 2; ++bj) { const f32x4 v0 = acc[ai][bj][m][0], v1 = acc[ai][bj][m][1];
                    u32x4 w; w.x = cvt_pk_bf16(v0[0], v0[1]); w.y = cvt_pk_bf16(v0[2], v0[3]); w.z = cvt_pk_bf16(v1[0], v1[1]); w.w = cvt_pk_bf16(v1[2], v1[3]);
                    *(u32x4*)(rowp + bj * 128) = w; } }
    }
};

__device__ __forceinline__ void p_final(Frame& F) {
    const int gw = F.vcu * NWAVES + F.wave, NGW = F.G * NWAVES, lane = F.lane;
    const float* mod = (const float*)(F.ws + WS_MOD); const bf16_t* Y = (const bf16_t*)(F.ws + WS_Y);
    const int* POS = (const int*)(F.ws + WS_POS); const float* EW = (const float*)(F.ws + WS_EW);
    for (int w = gw; w < 2048; w += NGW) {
        const int b = w >> 6; f32x4 g2[4], fg[4];
#pragma unroll
        for (int j = 0; j < 4; ++j) { g2[j] = *(const f32x4*)(mod + b * 6144 + 5 * 1024 + 4 * lane + 256 * j); fg[j] = *(const f32x4*)(F.in[26] + 4 * lane + 256 * j); }
        for (int r = 0; r < 32; ++r) {
            const size_t row = (size_t)w * 32 + r; float* xr = F.out + row * D;
            const int p0 = POS[row * 2], p1 = POS[row * 2 + 1]; const float w0 = EW[row * 2], w1 = EW[row * 2 + 1];
            f32x4 v[4]; float ss = 0.f;
#pragma unroll
            for (int j = 0; j < 4; ++j) { const int c = 4 * lane + 256 * j; const f32x4 xv = *(const f32x4*)(xr + c);
                const u32x2 a = *(const u32x2*)(Y + (size_t)p0 * 1024 + c), bq = *(const u32x2*)(Y + (size_t)p1 * 1024 + c);
                f32x4 mo; mo[0] = w0 * bf_lo(a.x) + w1 * bf_lo(bq.x); mo[1] = w0 * bf_hi(a.x) + w1 * bf_hi(bq.x); mo[2] = w0 * bf_lo(a.y) + w1 * bf_lo(bq.y); mo[3] = w0 * bf_hi(a.y) + w1 * bf_hi(bq.y);
                v[j] = xv + g2[j] * mo; ss += (v[j][0] * v[j][0] + v[j][1] * v[j][1]) + (v[j][2] * v[j][2] + v[j][3] * v[j][3]); }
            const float rstd = 1.f / sqrtf(wave_sum(ss) * (1.f / D) + EPS);
#pragma unroll
            for (int j = 0; j < 4; ++j) *(f32x4*)(xr + 4 * lane + 256 * j) = v[j] * rstd * fg[j];
        }
    }
}

__global__ void __launch_bounds__(NTHR, 2) fwd_kernel(Args args) {
    extern __shared__ __attribute__((aligned(16))) unsigned char lds_raw[];
    Frame F;
    F.lds = (LAS unsigned char*)lds_raw;
    F.tid = threadIdx.x; F.lane = F.tid & 63; F.wave = __builtin_amdgcn_readfirstlane(F.tid >> 6);
    F.G = gridDim.x; { const int bx = blockIdx.x; F.vcu = (F.G % 8 == 0) ? (bx % 8) * (F.G / 8) + bx / 8 : bx; }
    F.ws = args.ws; F.out = args.out; F.ctl = (unsigned*)(args.ws + WS_CTL);
#pragma unroll
    for (int i = 0; i < 27; ++i) F.in[i] = args.in[i];
    volatile LAS unsigned* MISC = (volatile LAS unsigned*)(F.lds + MISC_OFF);
    if (F.tid < 64) MISC[F.tid] = 0u;
    __syncthreads();
    XcdBarrier bar; bar.bar = F.ctl + CW_BAR; bar.x = 0; bar.st = nullptr;
    if (N_LAUNCHES != PER_PHASE) bar = xcd_barrier_post(F.ctl + CW_BAR, MISC + 8);
#define GRID_BAR() do { if (N_LAUNCHES != PER_PHASE) xcd_barrier(bar); } while (0)
    const int lo = args.ph_lo, hi = args.ph_hi;
#define IN(k) (lo <= (k) && (k) < hi)
#define BOTH(k) (IN(k) && IN((k) + 1))
    unsigned char* ws = F.ws;

    if (IN(0)) { p_adaln(F); p_convert(F); if (BOTH(0)) GRID_BAR(); }
    if (IN(1)) { p_norm1(F); if (BOTH(1)) GRID_BAR(); }
    if (IN(2)) {
        SchedG1 S{(const char*)(ws + WS_HX), (const char*)(ws + WS_WIN), F.G, (int)blockIdx.x}; EpiG1 E{ws};
        pg8::gemm_phase<EpiG1, SchedG1, true>(F.lds, 1024, S, E);
        if (BOTH(2)) GRID_BAR();
    }
    if (IN(3)) { p_gla_naive(F); if (BOTH(3)) GRID_BAR(); }
    if (IN(4)) { p_prep(F); if (BOTH(4)) GRID_BAR(); }
    if (IN(5)) {
        SchedSq S{(const char*)(ws + WS_PO), (const char*)(ws + WS_WP), 1024u, 512, F.G, (int)blockIdx.x}; EpiPool E{(const bf16_t*)(ws + WS_PGATES), (bf16_t*)(ws + WS_Z)};
        pg8::gemm_phase<EpiPool, SchedSq, true>(F.lds, 512, S, E);
        if (BOTH(5)) GRID_BAR();
    }
    if (IN(6)) {
        SchedSq S{(const char*)(ws + WS_HX), (const char*)(ws + WS_WGLA), 2048u, 1024, F.G, (int)blockIdx.x}; EpiGla E{(const bf16_t*)(ws + WS_PGATES), (bf16_t*)(ws + WS_Z)};
        pg8::gemm_phase<EpiGla, SchedSq, true>(F.lds, 1024, S, E);
        if (BOTH(6)) GRID_BAR();
    }
    if (IN(7)) {
        SchedSq S{(const char*)(ws + WS_Z), (const char*)(ws + WS_WO), 2048u, 1024, F.G, (int)blockIdx.x}; EpiWo E{F.in[0], (const float*)(ws + WS_MOD), F.out};
        pg8::gemm_phase<EpiWo, SchedSq, true>(F.lds, 1024, S, E);
        if (BOTH(7)) GRID_BAR();
    }
    if (IN(8)) { p_norm2_router(F); if (BOTH(8)) GRID_BAR(); }
    if (IN(9)) { p_index(F); if (BOTH(9)) GRID_BAR(); }
    if (IN(10)) {
        const int nt = (int)__hip_atomic_load(F.ctl + CW_NT, __ATOMIC_RELAXED, __HIP_MEMORY_SCOPE_AGENT);
        SchedMoe1 S{(const char*)(ws + WS_HX), (const char*)(ws + WS_W13), (const int*)(ws + WS_IDX), (const int*)(ws + WS_TILEE), nt * 4, F.G, F.vcu}; EpiMoe1 E{(bf16_t*)(ws + WS_HID)};
        pg8::gemm_phase<EpiMoe1, SchedMoe1, true>(F.lds, 1024, S, E);
        if (BOTH(10)) GRID_BAR();
    }
    if (IN(11)) {
        const int nt = (int)__hip_atomic_load(F.ctl + CW_NT, __ATOMIC_RELAXED, __HIP_MEMORY_SCOPE_AGENT);
        SchedMoe2 S{(const char*)(ws + WS_HID), (const char*)(ws + WS_W2), (const int*)(ws + WS_TILEE), nt * 4, F.G, F.vcu}; EpiMoe2 E{(bf16_t*)(ws + WS_Y)};
        pg8::gemm_phase<EpiMoe2, SchedMoe2, true>(F.lds, 512, S, E);
        if (BOTH(11)) GRID_BAR();
    }
    if (IN(12)) { p_final(F); }
#undef IN
#undef BOTH
#undef GRID_BAR
}

extern "C" void kernel_launch(void* const* d_in, const int* in_sizes, int n_in, void* d_out, int out_size, void* d_ws, size_t ws_size, hipStream_t stream) {
    static int grid = 0;
    if (grid == 0) {
        if (n_in != 27 || in_sizes[0] != T * D || out_size != T * D || ws_size < WS_END) { fprintf(stderr, "kernel_launch: unexpected shapes: n_in %d in0 %d out %d ws %zu (need %zu); nothing launched\n", n_in, n_in > 0 ? in_sizes[0] : -1, out_size, ws_size, (size_t)WS_END); grid = -1; return; }
        int dev = 0, cus = 0, per_cu = 0;
        if (hipGetDevice(&dev) != hipSuccess || hipDeviceGetAttribute(&cus, hipDeviceAttributeMultiprocessorCount, dev) != hipSuccess) { grid = -1; return; }
        if (hipFuncSetAttribute((const void*)fwd_kernel, hipFuncAttributeMaxDynamicSharedMemorySize, LDS_BYTES) != hipSuccess) { fprintf(stderr, "kernel_launch: hipFuncSetAttribute failed\n"); grid = -1; return; }
        if (hipOccupancyMaxActiveBlocksPerMultiprocessor(&per_cu, (const void*)fwd_kernel, NTHR, LDS_BYTES) != hipSuccess || per_cu < 1) fprintf(stderr, "kernel_launch: occupancy query reports %d\n", per_cu);
        (void)hipGetLastError();
        grid = cus;
    }
    if (grid < 0) return;
    if (hipMemsetAsync((char*)d_ws + WS_CTL, 0, CTL_ZERO_BYTES, stream) != hipSuccess) return;
    Args a{};
    for (int i = 0; i < 27; ++i) a.in[i] = (const float*)d_in[i];
    a.out = (float*)d_out; a.ws = (unsigned char*)d_ws;
    if (N_LAUNCHES == 1) { a.ph_lo = 0; a.ph_hi = PER_PHASE; hipLaunchKernelGGL(fwd_kernel, dim3(grid), dim3(NTHR), LDS_BYTES, stream, a); }
    else for (int p = 0; p < PER_PHASE; ++p) { a.ph_lo = p; a.ph_hi = p + 1; hipLaunchKernelGGL(fwd_kernel, dim3(grid), dim3(NTHR), LDS_BYTES, stream, a); }
}
```

```cpp
#include <hip/hip_runtime.h>
#include <cstdio>
#include <cstdint>

#define PROBE_REP -1
#ifndef MK_N_LAUNCHES
#define MK_N_LAUNCHES 1
#endif

#ifndef MOE_FP8
#define MOE_FP8 1
#endif
#ifndef YOUT_FP8
#define YOUT_FP8 1
#endif
#ifndef OG_OVERLAP
#define OG_OVERLAP 1
#define POOL_OVERLAP 1
#define CONV_OVERLAP 1
#endif
#ifndef MOE2_FP8
#define MOE2_FP8 1
#endif
#define LAS __attribute__((address_space(3)))
#define GAS __attribute__((address_space(1)))
typedef unsigned short bf16_t;
typedef short bf16x8 __attribute__((ext_vector_type(8)));
typedef float f32x4 __attribute__((ext_vector_type(4)));
typedef float f32x2 __attribute__((ext_vector_type(2)));
typedef unsigned u32x4 __attribute__((ext_vector_type(4)));
typedef unsigned u32x2 __attribute__((ext_vector_type(2)));

constexpr int D = 1024, BATCH = 32, SEQ = 2048, T = BATCH * SEQ, CTXL = 256, TC = BATCH * CTXL;
constexpr int DIN = 5664, NPAD = 5888;
constexpr int NE = 32, DE = 512;
constexpr int MAXTILES = 544, NPMAX = MAXTILES * 256;
constexpr float EPS = 1e-6f;
constexpr float SC_W13 = 64.f, SC_W2 = 8.f, SC_HID = 8.f;
constexpr int NWAVES = 8, NTHR = 512;
constexpr int PER_PHASE = 12;
constexpr int N_LAUNCHES = MK_N_LAUNCHES;

constexpr size_t MiB = 1u << 20;
constexpr size_t WS_CTL = 0, CTL_ZERO_BYTES = 32768;
constexpr size_t WS_MOD = 1 * MiB;
constexpr size_t WS_EID = 2 * MiB;
constexpr size_t WS_EW = WS_EID + 512 * 1024;
constexpr size_t WS_POS = 3 * MiB;
constexpr size_t WS_IDX = WS_POS + 512 * 1024;
constexpr size_t WS_TILEE = 4 * MiB + 512 * 1024;
constexpr size_t WS_LR = 5 * MiB;
constexpr size_t WS_WIN = 14 * MiB;
constexpr size_t WS_WP = 26 * MiB;
constexpr size_t WS_WGLA = 27 * MiB;
constexpr size_t WS_WO = 29 * MiB;
constexpr size_t WS_W13 = 32 * MiB;
constexpr size_t WS_W2 = 96 * MiB;
constexpr size_t WS_HX = 128 * MiB;
constexpr size_t WS_PU = 272 * MiB;
constexpr size_t WS_PQKV = 336 * MiB;
constexpr size_t WS_PO = 272 * MiB;
constexpr size_t WS_Z = 400 * MiB;
constexpr size_t WS_HID = 272 * MiB;
constexpr size_t WS_PG = 592 * MiB;
constexpr size_t WS_PGATES = 720 * MiB;
constexpr size_t WS_Y = 592 * MiB;
constexpr size_t WS_PKVC = 976 * MiB;
constexpr size_t WS_X1 = 864 * MiB;
constexpr size_t WS_IDXE = 5 * MiB;
constexpr size_t WS_END = 1000 * MiB;
static_assert(WS_HID + (size_t)NPMAX * 512 * 2 <= WS_PG && WS_Y + (size_t)NPMAX * 1024 * 2 <= WS_PKVC, "ws map");
constexpr int CW_CNT = 64;
constexpr int CW_CUR = 128;
constexpr int CW_NT = 192;
constexpr int CW_BAR = 4096;

constexpr int LDS_BYTES = 163840;
constexpr int MISC_OFF = LDS_BYTES - 512;

__device__ __forceinline__ unsigned cvt_pk_bf16(float lo, float hi) { unsigned r; asm volatile("v_cvt_pk_bf16_f32 %0, %1, %2" : "=v"(r) : "v"(lo), "v"(hi)); return r; }
__device__ __forceinline__ float clamp_e4m3(float x) { return __builtin_amdgcn_fmed3f(x, -448.f, 448.f); }
__device__ __forceinline__ unsigned pk4_fp8(float a, float b, float c, float d) { int p = __builtin_amdgcn_cvt_pk_fp8_f32(clamp_e4m3(a), clamp_e4m3(b), 0, false); p = __builtin_amdgcn_cvt_pk_fp8_f32(clamp_e4m3(c), clamp_e4m3(d), p, true); return (unsigned)p; }
__device__ __forceinline__ void unpack4_fp8(unsigned w, float (&f)[4]) { const f32x2 lo = __builtin_amdgcn_cvt_pk_f32_fp8((int)w, false), hi = __builtin_amdgcn_cvt_pk_f32_fp8((int)w, true); f[0] = lo[0]; f[1] = lo[1]; f[2] = hi[0]; f[3] = hi[1]; }
__device__ __forceinline__ float bf_lo(unsigned w) { return __uint_as_float(w << 16); }
__device__ __forceinline__ float bf_hi(unsigned w) { return __uint_as_float(w & 0xffff0000u); }
__device__ __forceinline__ float bf2f(bf16_t h) { return __uint_as_float(((unsigned)h) << 16); }
template <int CTRL> __device__ __forceinline__ float dpp_mov(float v) { return __builtin_bit_cast(float, __builtin_amdgcn_update_dpp(0, __builtin_bit_cast(int, v), CTRL, 0xf, 0xf, false)); }
__device__ __forceinline__ float row_sum16(float v) { v += dpp_mov<0xB1>(v); v += dpp_mov<0x4E>(v); v += dpp_mov<0x124>(v); v += dpp_mov<0x128>(v); return v; }
__device__ __forceinline__ float rlane(float v, int l) { return __builtin_bit_cast(float, __builtin_amdgcn_readlane(__builtin_bit_cast(int, v), l)); }
__device__ __forceinline__ float wave_sum(float v) { v = row_sum16(v); return (rlane(v, 0) + rlane(v, 16)) + (rlane(v, 32) + rlane(v, 48)); }
__device__ __forceinline__ float half_sum(float v, int lane) { v = row_sum16(v); const float lo = rlane(v, 0) + rlane(v, 16), hi = rlane(v, 32) + rlane(v, 48); return lane < 32 ? lo : hi; }
__device__ __forceinline__ float xchg32(float v, int lane) { const auto r = __builtin_amdgcn_permlane32_swap(__builtin_bit_cast(unsigned, v), __builtin_bit_cast(unsigned, v), false, false); return __builtin_bit_cast(float, lane < 32 ? r[1] : r[0]); }
__device__ __forceinline__ void pswap32(float& a, float& b) { asm volatile("s_nop 1\n\tv_permlane32_swap_b32 %0, %1" : "+v"(a), "+v"(b)); }
__device__ __forceinline__ void pswap16(float& a, float& b) { asm volatile("s_nop 1\n\tv_permlane16_swap_b32 %0, %1" : "+v"(a), "+v"(b)); }
__device__ __forceinline__ float swap32_sum(float a, float b) { pswap32(a, b); return a + b; }
__device__ __forceinline__ float swap16_sum(float a, float b) { pswap16(a, b); return a + b; }
__device__ __forceinline__ float swap32_max(float a) { float b = a; pswap32(a, b); return fmaxf(a, b); }
__device__ __forceinline__ float swap16_max(float a) { float b = a; pswap16(a, b); return fmaxf(a, b); }
__device__ __forceinline__ float sigmoidf_(float x) { return __builtin_amdgcn_rcpf(1.f + __expf(-x)); }
#define LDS_WAIT() asm volatile("s_waitcnt lgkmcnt(0)" ::: "memory")
__device__ __forceinline__ void unpack8(const u32x4 w, float (&f)[8]) { f[0] = bf_lo(w.x); f[1] = bf_hi(w.x); f[2] = bf_lo(w.y); f[3] = bf_hi(w.y); f[4] = bf_lo(w.z); f[5] = bf_hi(w.z); f[6] = bf_lo(w.w); f[7] = bf_hi(w.w); }

#define XB_TMO      128
#define XB_XCNT(j)  (256  + 64 * (j))
#define XB_XSUB(j)  (1280 + 64 * (j))
#define XB_XGEN(j)  (2304 + 64 * (j))
#define XB_TOP      3328
#define XB_TOPGEN   3392
#define XCD_BAR_WORDS 3456
#define XB_SPIN_CAP (1u << 18)
__device__ __forceinline__ unsigned xb_ld(unsigned* p)              { return __hip_atomic_load(p, __ATOMIC_RELAXED, __HIP_MEMORY_SCOPE_AGENT); }
__device__ __forceinline__ unsigned xb_add(unsigned* p, unsigned v) { return __hip_atomic_fetch_add(p, v, __ATOMIC_RELAXED, __HIP_MEMORY_SCOPE_AGENT); }
__device__ __forceinline__ unsigned xb_xcc_id() { return (unsigned)__builtin_amdgcn_s_getreg((3 << 11) | 20) & 0xFu; }
#define XB_SPIN(cond, bar) do { unsigned _sp = 0; while (cond) { __builtin_amdgcn_s_sleep(1); \
    if ((++_sp & 255u) == 0u) { if (xb_ld(&(bar)[XB_TMO])) break; if (_sp > XB_SPIN_CAP) { atomicAdd(&(bar)[XB_TMO], 1u); break; } } } } while (0)
struct XcdBarrier { unsigned* bar; unsigned x; volatile LAS unsigned* st; };
__device__ __forceinline__ XcdBarrier xcd_barrier_post(unsigned* bar, volatile LAS unsigned* st) {
    XcdBarrier b; b.bar = bar; b.x = xb_xcc_id(); b.st = st;
    if (threadIdx.x == 0) (void)xb_add(&bar[XB_XCNT(b.x)], 1u);
    return b;
}
__device__ __forceinline__ void xcd_barrier_complete(unsigned* bar, unsigned x, unsigned& nloc, unsigned& nx) {
    const unsigned G = gridDim.x * gridDim.y * gridDim.z;
    unsigned sum, cnt, mine, sp = 0u;
    for (;;) {
        sum = 0u; cnt = 0u; mine = 0u;
#pragma unroll
        for (unsigned j = 0; j < 16; ++j) { const unsigned c = xb_ld(&bar[XB_XCNT(j)]); sum += c; cnt += (c > 0u) ? 1u : 0u; mine = (j == x) ? c : mine; }
        if (sum == G) break;
        __builtin_amdgcn_s_sleep(1);
        if ((++sp & 255u) == 0u) { if (xb_ld(&bar[XB_TMO])) break; if (sp > XB_SPIN_CAP) { atomicAdd(&bar[XB_TMO], 1u); break; } }
    }
    nloc = mine > 0u ? mine : 1u; nx = cnt > 0u ? cnt : 1u;
}
__device__ __forceinline__ void xcd_barrier(const XcdBarrier& b) {
    asm volatile("s_waitcnt vmcnt(0)" ::: "memory");
    __syncthreads();
    if (threadIdx.x == 0) {
        unsigned* bar = b.bar;
        __builtin_amdgcn_s_waitcnt(0);
        unsigned nloc = b.st[0], nx = b.st[1];
        if (nloc == 0u) { xcd_barrier_complete(bar, b.x, nloc, nx); b.st[0] = nloc; b.st[1] = nx; }
        const unsigned old = xb_add(&bar[XB_XSUB(b.x)], 1u);
        const unsigned gen = old / nloc;
        if (old + 1u == (gen + 1u) * nloc) {
            __builtin_amdgcn_fence(__ATOMIC_RELEASE, "agent");
            asm volatile("s_waitcnt vmcnt(0)" ::: "memory");
            const unsigned og = xb_add(&bar[XB_TOP], 1u);
            const unsigned tg = og / nx;
            if (og + 1u == (tg + 1u) * nx) xb_add(&bar[XB_TOPGEN], 1u);
            else XB_SPIN(xb_ld(&bar[XB_TOPGEN]) == tg, bar);
            __builtin_amdgcn_fence(__ATOMIC_ACQUIRE, "agent");
            xb_add(&bar[XB_XGEN(b.x)], 1u);
            asm volatile("s_waitcnt vmcnt(0)" ::: "memory");
        } else {
            XB_SPIN(xb_ld(&bar[XB_XGEN(b.x)]) == gen, bar);
            __builtin_amdgcn_fence(__ATOMIC_ACQUIRE, "agent");
            asm volatile("s_waitcnt vmcnt(0)" ::: "memory");
        }
    }
    __syncthreads();
}

namespace pg8 {
constexpr int BM = 256, BK = 64, HALF = 128, HTB = HALF * BK * 2, STAGE_BYTES = 8 * HTB, NXCD = 8, WGM = 8;
__host__ __device__ __forceinline__ int lds_byte(int r, int c) { const int st = (r >> 4) * 2 + (c >> 5), rr = r & 15, cc = c & 31, ob = rr * 64 + cc * 2; return st * 1024 + (ob ^ (((ob >> 9) & 1) << 5)); }
__host__ __device__ __forceinline__ void stage_rc(int b, int& R, int& C) { const int st = b / 1024, sb = b % 1024, swz = sb ^ (((sb >> 9) & 1) << 5); R = (st >> 1) * 16 + swz / 64; C = (st & 1) * 32 + (swz % 64) / 2; }
__host__ __device__ __forceinline__ int perm32(int rho) { const int n = rho >> 4, i = rho & 15; return 8 * (i >> 2) + 4 * n + (i & 3); }

typedef int v8i_t __attribute__((ext_vector_type(8)));
typedef int v4i_t __attribute__((ext_vector_type(4)));
__device__ __forceinline__ v8i_t mk8(const bf16x8 lo, const bf16x8 hi) { return __builtin_shufflevector(__builtin_bit_cast(v4i_t, lo), __builtin_bit_cast(v4i_t, hi), 0, 1, 2, 3, 4, 5, 6, 7); }
struct Unit { const char* A; const char* B; unsigned va[2][2]; int pm, pn, aux; };

__device__ __forceinline__ void static_tile(int L, int nM, int nN, int& pm, int& pn) {
    const int nwg = nM * nN; int wgid = L; { const int q = nwg / NXCD, r = nwg % NXCD, xcd = wgid % NXCD, off = wgid / NXCD; wgid = (xcd < r ? xcd * (q + 1) : r * (q + 1) + (xcd - r) * q) + off; }
    const int nig = WGM * nN, gid = wgid / nig, fm = gid * WGM, gsz = (nM - fm) < WGM ? (nM - fm) : WGM;
    pm = fm + ((wgid % nig) % gsz); pn = (wgid % nig) / gsz;
}

template <class Epi, class Sched, bool ALIGN_EPI = true, bool FP8 = false>
__device__ __forceinline__ void gemm_phase(LAS unsigned char* lds, const int K, const Sched& S, const Epi& E) {
    const int tid = threadIdx.x, wid = __builtin_amdgcn_readfirstlane(tid >> 6), lane = tid & 63, wr = wid >> 2, wc = wid & 3, fr = lane & 15, fq = lane >> 4;
    const int nt = K / BK;
    unsigned vb[2];
#pragma unroll
    for (int i = 0; i < 2; ++i) { int R, C; stage_rc(tid * 16 + i * 8192, R, C); const int Rb = Epi::PERM ? ((R >> 5) * 64 + perm32(R & 31)) : R; vb[i] = (unsigned)(Rb * K + C) * 2u; }
    const size_t kstep = (size_t)(BK * 2);
    const size_t hstep = Epi::PERM ? (size_t)32 * K * 2 : (size_t)HALF * K * 2;
    const unsigned ldsw = (unsigned)wid * 1024u;
    int aoffk[2], boffk[2];
#pragma unroll
    for (int k = 0; k < 2; ++k) { aoffk[k] = FP8 ? lds_byte(wr * 64 + fr, fq * 16 + 8 * k) : lds_byte(wr * 64 + fr, fq * 8) + k * 1024; boffk[k] = FP8 ? lds_byte(wc * 32 + fr, fq * 16 + 8 * k) : lds_byte(wc * 32 + fr, fq * 8) + k * 1024; }
#define PG8_SA(b, h) (((b) * 2 + (h)) * HTB)
#define PG8_SB(b, h) ((4 + (b) * 2 + (h)) * HTB)
#define PG8_STAGEA(bufoff, gbase, VA, h) do { _Pragma("unroll") for (int _i = 0; _i < 2; ++_i) \
        __builtin_amdgcn_global_load_lds((const unsigned*)((const char*)(gbase) + (VA)[h][_i]), (LAS unsigned*)(lds + (bufoff) + ldsw + _i * 8192), 16, 0, 0); } while (0)
#define PG8_STAGEB(bufoff, gbase) do { _Pragma("unroll") for (int _i = 0; _i < 2; ++_i) \
        __builtin_amdgcn_global_load_lds((const unsigned*)((const char*)(gbase) + vb[_i]), (LAS unsigned*)(lds + (bufoff) + ldsw + _i * 8192), 16, 0, 0); } while (0)
#define PG8_LDA(dst, b, h) do { _Pragma("unroll") for (int m = 0; m < 4; ++m) { if constexpr (FP8) { const v4i_t _lo = *(const LAS v4i_t*)(lds + PG8_SA(b, h) + aoffk[0] + m * 2048), _hi = *(const LAS v4i_t*)(lds + PG8_SA(b, h) + aoffk[1] + m * 2048); \
            dst##8[m] = __builtin_shufflevector(_lo, _hi, 0, 1, 2, 3, 4, 5, 6, 7); } else { _Pragma("unroll") for (int k = 0; k < 2; ++k) dst[m][k] = *(const LAS bf16x8*)(lds + PG8_SA(b, h) + aoffk[k] + m * 2048); } } } while (0)
#define PG8_LDB(dst, b, h) do { _Pragma("unroll") for (int n = 0; n < 2; ++n) { if constexpr (FP8) { const v4i_t _lo = *(const LAS v4i_t*)(lds + PG8_SB(b, h) + boffk[0] + n * 2048), _hi = *(const LAS v4i_t*)(lds + PG8_SB(b, h) + boffk[1] + n * 2048); \
            dst##8[n] = __builtin_shufflevector(_lo, _hi, 0, 1, 2, 3, 4, 5, 6, 7); } else { _Pragma("unroll") for (int k = 0; k < 2; ++k) dst[n][k] = *(const LAS bf16x8*)(lds + PG8_SB(b, h) + boffk[k] + n * 2048); } } } while (0)
#define PG8_MMA(ai, bj, At, Bt) do { if constexpr (FP8) __builtin_amdgcn_sched_barrier(0); __builtin_amdgcn_s_setprio(1); _Pragma("unroll") for (int m = 0; m < 4; ++m) _Pragma("unroll") for (int n = 0; n < 2; ++n) { \
        if constexpr (FP8) { acc[ai][bj][m][n] = __builtin_amdgcn_mfma_scale_f32_16x16x128_f8f6f4(Bt##8[n], At##8[m], acc[ai][bj][m][n], 0, 0, 0, 0x7F7F7F7F, 0, 0x7F7F7F7F); } \
        else { _Pragma("unroll") for (int k = 0; k < 2; ++k) acc[ai][bj][m][n] = __builtin_amdgcn_mfma_f32_16x16x32_bf16(Bt[n][k], At[m][k], acc[ai][bj][m][n], 0, 0, 0); } } __builtin_amdgcn_s_setprio(0); if constexpr (FP8) { asm volatile("" : "+v"(acc[ai][bj][0][0]), "+v"(acc[ai][bj][0][1]), "+v"(acc[ai][bj][1][0]), "+v"(acc[ai][bj][1][1]), "+v"(acc[ai][bj][2][0]), "+v"(acc[ai][bj][2][1]), "+v"(acc[ai][bj][3][0]), "+v"(acc[ai][bj][3][1])); __builtin_amdgcn_sched_barrier(0); } } while (0)
#define PG8_WAIT_V(n) asm volatile("s_waitcnt vmcnt(" #n ")" ::: "memory")
#define PG8_WAIT_VN(N) asm volatile("s_waitcnt vmcnt(%0)" :: "n"(N) : "memory")
#define PG8_WAIT_VR(flag, N) asm volatile("s_waitcnt vmcnt(%1)\n\ts_cmp_lg_u32 %0, 0\n\ts_cbranch_scc1 .Lrx%=\n\ts_waitcnt vmcnt(8)\n.Lrx%=:" :: "s"(flag), "n"(N) : "memory", "scc")
#define PG8_WAIT_L(n) asm volatile("s_waitcnt lgkmcnt(" #n ")" ::: "memory")
#define PG8_BAR __builtin_amdgcn_s_barrier()
#define PG8_SCHED __builtin_amdgcn_sched_barrier(0)
    Unit cur, nxt; int ui = 0;
    if (!S.next(0, cur)) return;
    f32x4 acc[2][2][4][2];
#pragma unroll
    for (int a = 0; a < 2; ++a)
#pragma unroll
        for (int b = 0; b < 2; ++b)
#pragma unroll
            for (int m = 0; m < 4; ++m)
#pragma unroll
                for (int n = 0; n < 2; ++n) acc[a][b][m][n] = (f32x4){0.f, 0.f, 0.f, 0.f};
    bf16x8 At[4][2], B0[2][2], B1[2][2];
    v8i_t At8[4], B08[2], B18[2];
    const char* cA = cur.A; const char* cB = cur.B;
    PG8_STAGEB(PG8_SB(0, 0), cB); PG8_STAGEB(PG8_SB(0, 1), cB + hstep); PG8_STAGEA(PG8_SA(0, 0), cA, cur.va, 0); PG8_STAGEA(PG8_SA(0, 1), cA, cur.va, 1);
    if (wr == 1) PG8_BAR;
    PG8_WAIT_V(2); PG8_BAR;
    PG8_STAGEB(PG8_SB(1, 0), cB + kstep); PG8_STAGEA(PG8_SA(1, 0), cA + kstep, cur.va, 0); PG8_STAGEB(PG8_SB(1, 1), cB + hstep + kstep);
    PG8_WAIT_V(6); PG8_BAR;
    for (;;) {
#ifdef PROBE_KDUP
        const bool has_next = S.next((ui + 1) >> 1, nxt);
#else
        const bool has_next = S.next(ui + 1, nxt);
#endif
        if (!has_next) { nxt.A = cA; nxt.B = cB; if constexpr (Sched::GATHER) { nxt.va[0][0] = cur.va[0][0]; nxt.va[0][1] = cur.va[0][1]; nxt.va[1][0] = cur.va[1][0]; nxt.va[1][1] = cur.va[1][1]; } }
        const char* nA = nxt.A; const char* nB = nxt.B;
#pragma unroll 1
        for (int t = 0; t < nt; t += 2) {
            const bool last = (t == nt - 2);
#ifdef PROBE_KDUP
            const int relax = __builtin_amdgcn_readfirstlane(((t == 0) && (ui > 0) && ((ui & 1) == 0)) ? 1 : 0);
#else
            const int relax = __builtin_amdgcn_readfirstlane(((t == 0) && (ui > 0)) ? 1 : 0);
#endif
            const char* a1 = cA + (size_t)(t + 1) * kstep;
            const char* a2 = last ? nA : cA + (size_t)(t + 2) * kstep; const char* b2 = last ? nB : cB + (size_t)(t + 2) * kstep;
            const char* a3 = a2 + kstep; const char* b3 = b2 + kstep;
            if constexpr (FP8) { asm volatile("" : "+s"(a1), "+s"(a2), "+s"(b2), "+s"(a3), "+s"(b3)); }
            unsigned v2[2][2];
            if constexpr (Sched::GATHER) { v2[0][0] = last ? nxt.va[0][0] : cur.va[0][0]; v2[0][1] = last ? nxt.va[0][1] : cur.va[0][1]; v2[1][0] = last ? nxt.va[1][0] : cur.va[1][0]; v2[1][1] = last ? nxt.va[1][1] : cur.va[1][1]; }
            else { v2[0][0] = cur.va[0][0]; v2[0][1] = cur.va[0][1]; v2[1][0] = cur.va[1][0]; v2[1][1] = cur.va[1][1]; }
            PG8_LDB(B0, 0, 0); PG8_LDB(B1, 0, 1); PG8_SCHED; PG8_LDA(At, 0, 0);
            PG8_STAGEA(PG8_SA(1, 1), a1, cur.va, 1); PG8_WAIT_VR(relax, 8 + Epi::NISS);
            PG8_WAIT_L(0); PG8_BAR; PG8_MMA(0, 0, At, B0); PG8_MMA(0, 1, At, B1); PG8_BAR; PG8_SCHED;
            PG8_LDA(At, 0, 1); PG8_STAGEB(PG8_SB(0, 0), b2); PG8_STAGEB(PG8_SB(0, 1), b2 + hstep); PG8_STAGEA(PG8_SA(0, 0), a2, v2, 0);
            PG8_WAIT_VR(relax, 8 + Epi::NISS);
            PG8_WAIT_L(0); PG8_BAR; PG8_MMA(1, 0, At, B0); PG8_MMA(1, 1, At, B1); PG8_BAR; PG8_SCHED;
            PG8_LDB(B0, 1, 0); PG8_LDB(B1, 1, 1); PG8_SCHED; PG8_LDA(At, 1, 0); PG8_STAGEA(PG8_SA(0, 1), a2, v2, 1);
            PG8_WAIT_V(8);
            PG8_WAIT_L(0); PG8_BAR; PG8_MMA(0, 0, At, B0); PG8_MMA(0, 1, At, B1); PG8_BAR; PG8_SCHED;
            PG8_LDA(At, 1, 1); PG8_STAGEB(PG8_SB(1, 0), b3); PG8_STAGEB(PG8_SB(1, 1), b3 + hstep); PG8_STAGEA(PG8_SA(1, 0), a3, v2, 0);
            PG8_WAIT_V(8); PG8_WAIT_L(0); PG8_BAR; PG8_MMA(1, 0, At, B0); PG8_MMA(1, 1, At, B1); PG8_BAR; PG8_SCHED;
        }
        if constexpr (ALIGN_EPI) { if (wr == 0) PG8_BAR; }
        asm volatile("" ::: "memory");
#ifdef PROBE_KDUP
        if (ui & 1)
#endif
        E(acc, cur, wr, wc, fr, fq);
#ifdef PROBE_DRAIN
        asm volatile("s_waitcnt vmcnt(0)" ::: "memory");
#endif
#ifdef PROBE_EPI2
        if constexpr (Epi::IDEM) { asm volatile("" ::: "memory"); E(acc, cur, wr, wc, fr, fq); }
#endif
        if (!has_next) break;
#pragma unroll
        for (int a = 0; a < 2; ++a)
#pragma unroll
            for (int b = 0; b < 2; ++b)
#pragma unroll
                for (int m = 0; m < 4; ++m)
#pragma unroll
                    for (int n = 0; n < 2; ++n) acc[a][b][m][n] = (f32x4){0.f, 0.f, 0.f, 0.f};
        if constexpr (Sched::GATHER) cur = nxt; else { cur.A = nxt.A; cur.B = nxt.B; cur.pm = nxt.pm; cur.pn = nxt.pn; cur.aux = nxt.aux; }
        cA = nA; cB = nB; ++ui;
        if constexpr (ALIGN_EPI) { if (wr == 1) PG8_BAR; }
    }
    PG8_WAIT_V(0);
    if constexpr (!ALIGN_EPI) { if (wr == 0) PG8_BAR; }
    PG8_BAR;
#undef PG8_SA
#undef PG8_SB
#undef PG8_STAGEA
#undef PG8_STAGEB
#undef PG8_LDA
#undef PG8_LDB
#undef PG8_MMA
#undef PG8_WAIT_V
#undef PG8_WAIT_L
#undef PG8_BAR
#undef PG8_SCHED
}
__device__ __forceinline__ void contig_va(unsigned (&va)[2][2], unsigned lda) {
    const int tid = threadIdx.x;
#pragma unroll
    for (int i = 0; i < 2; ++i) { int R, C; stage_rc(tid * 16 + i * 8192, R, C); va[0][i] = (unsigned)R * lda + (unsigned)C * 2u; va[1][i] = (unsigned)(R + HALF) * lda + (unsigned)C * 2u; }
}
}


template <int BM> __device__ __forceinline__ u32x4 sel_ror8(const u32x4 keep, const u32x4 src) { u32x4 r;
    r.x = (unsigned)__builtin_amdgcn_update_dpp((int)keep.x, (int)src.x, 0x128, 0xf, BM, false); r.y = (unsigned)__builtin_amdgcn_update_dpp((int)keep.y, (int)src.y, 0x128, 0xf, BM, false);
    r.z = (unsigned)__builtin_amdgcn_update_dpp((int)keep.z, (int)src.z, 0x128, 0xf, BM, false); r.w = (unsigned)__builtin_amdgcn_update_dpp((int)keep.w, (int)src.w, 0x128, 0xf, BM, false); return r; }
__device__ __forceinline__ void st_lines(bf16_t* line0, size_t pitch  , int fr, int fq, const u32x4 p0, const u32x4 p1) {
    const bool lo = fr < 8;
    const u32x4 d0 = sel_ror8<0xC>(p0, p1);
    const u32x4 d1 = sel_ror8<0x3>(p1, p0);
    bf16_t* a = line0 + (size_t)(fr & 7) * pitch + (lo ? 0 : 32) + 8 * fq; bf16_t* a2 = a + 8 * pitch;
    asm volatile("global_store_dwordx4 %0, %1, off sc1\n\ts_nop 1" :: "v"(a), "v"(d0) : "memory");
    asm volatile("global_store_dwordx4 %0, %1, off sc1\n\ts_nop 1" :: "v"(a2), "v"(d1) : "memory");
}
__device__ __forceinline__ void ld_lines(const bf16_t* line0, size_t pitch, int fr, int fq, u32x4& p0, u32x4& p1) {
    const bool lo = fr < 8; const bf16_t* a = line0 + (size_t)(fr & 7) * pitch + (lo ? 0 : 32) + 8 * fq;
    const u32x4 l1 = *(const u32x4*)a, l2 = *(const u32x4*)(a + 8 * pitch);
    p0 = sel_ror8<0xC>(l1, l2);
    p1 = sel_ror8<0x3>(l2, l1);
}
__device__ __forceinline__ u32x4 pack8(const f32x4 v0, const f32x4 v1) { u32x4 w; w.x = cvt_pk_bf16(v0[0], v0[1]); w.y = cvt_pk_bf16(v0[2], v0[3]); w.z = cvt_pk_bf16(v1[0], v1[1]); w.w = cvt_pk_bf16(v1[2], v1[3]); return w; }

struct Frame {
    LAS unsigned char* lds;
    unsigned* ctl;
    int tid, lane, wave, vcu, G;
    const float* in[27];
    float* out;
    unsigned char* ws;
};
struct Args { const float* in[27]; float* out; unsigned char* ws; int ph_lo, ph_hi; };

__device__ __forceinline__ void p_adaln(Frame& F) {
    const int wg = blockIdx.x, tid = F.tid;
    if (wg >= 192) return;
    const float* c = F.in[1]; const float* cctx = F.in[3]; const float* wmod = F.in[4]; const float* bmod = F.in[5];
    float* mod = (float*)(F.ws + WS_MOD);
    LAS float* sc = (LAS float*)F.lds;
    for (int i = tid; i < 33 * 1024; i += NTHR) { const int r = i >> 10, k = i & 1023; const float v = (r < 32) ? c[r * 1024 + k] : cctx[k]; sc[k * 36 + r] = v / (1.f + expf(-v)); }
    __syncthreads();
    const int col = tid & 31, kq = tid >> 5, j = wg * 32 + col;
    float acc[33];
#pragma unroll
    for (int r = 0; r < 33; ++r) acc[r] = 0.f;
    for (int kk = 0; kk < 64; ++kk) {
        const int k = kq * 64 + kk; const float w = wmod[(size_t)k * 6144 + j];
        const LAS f32x4* sp = (const LAS f32x4*)(sc + k * 36);
#pragma unroll
        for (int q = 0; q < 8; ++q) { const f32x4 s4 = sp[q]; acc[4 * q] += s4[0] * w; acc[4 * q + 1] += s4[1] * w; acc[4 * q + 2] += s4[2] * w; acc[4 * q + 3] += s4[3] * w; }
        acc[32] += sc[k * 36 + 32] * w;
    }
    __syncthreads();
    LAS float* red = (LAS float*)F.lds;
#pragma unroll
    for (int r = 0; r < 33; ++r) red[(kq * 33 + r) * 32 + col] = acc[r];
    __syncthreads();
    for (int o = tid; o < 33 * 32; o += NTHR) { const int r = o >> 5, cc = o & 31; float s = 0.f;
#pragma unroll
        for (int q = 0; q < 16; ++q) s += red[(q * 33 + r) * 32 + cc];
        mod[r * 6144 + wg * 32 + cc] = s + bmod[wg * 32 + cc]; }
    __syncthreads();
}
__device__ __forceinline__ void transpose_item(const float* W, int ldw, int k0, int n0, bf16_t* WT, int ldk, int dst_row0, LAS float* scr, int lane, float scale = 1.f) {
    float tv[32];
#pragma unroll
    for (int i = 0; i < 32; ++i) { const int kk = 2 * i + (lane >> 5); tv[i] = W[(size_t)(k0 + kk) * ldw + n0 + (lane & 31)]; }
#pragma unroll
    for (int i = 0; i < 32; ++i) { const int kk = 2 * i + (lane >> 5); scr[kk * 33 + (lane & 31)] = tv[i]; }
    LDS_WAIT(); asm volatile("" ::: "memory");
    const int c = lane & 7;
#pragma unroll
    for (int j = 0; j < 4; ++j) { const int n = (lane >> 3) + 8 * j; const LAS float* s = scr + (8 * c) * 33 + n;
        u32x4 o; o.x = cvt_pk_bf16(s[0 * 33] * scale, s[1 * 33] * scale); o.y = cvt_pk_bf16(s[2 * 33] * scale, s[3 * 33] * scale); o.z = cvt_pk_bf16(s[4 * 33] * scale, s[5 * 33] * scale); o.w = cvt_pk_bf16(s[6 * 33] * scale, s[7 * 33] * scale);
        *(u32x4*)(WT + (size_t)(dst_row0 + n) * ldk + k0 + 8 * c) = o; }
    LDS_WAIT(); asm volatile("" ::: "memory");
}
__device__ __forceinline__ void transpose_item8(const float* W, int ldw, int k0, int n0, unsigned char* WT8, int ldk, int dst_row0, LAS float* scr, int lane, float scale) {
    float tv[32];
#pragma unroll
    for (int i = 0; i < 32; ++i) { const int kk = 2 * i + (lane >> 5); tv[i] = W[(size_t)(k0 + kk) * ldw + n0 + (lane & 31)]; }
#pragma unroll
    for (int i = 0; i < 32; ++i) { const int kk = 2 * i + (lane >> 5); scr[kk * 33 + (lane & 31)] = tv[i]; }
    LDS_WAIT(); asm volatile("" ::: "memory");
    const int c = lane & 7;
#pragma unroll
    for (int j = 0; j < 4; ++j) { const int n = (lane >> 3) + 8 * j; const LAS float* sp = scr + (8 * c) * 33 + n;
        u32x2 o; o.x = pk4_fp8(sp[0 * 33] * scale, sp[1 * 33] * scale, sp[2 * 33] * scale, sp[3 * 33] * scale); o.y = pk4_fp8(sp[4 * 33] * scale, sp[5 * 33] * scale, sp[6 * 33] * scale, sp[7 * 33] * scale);
        *(u32x2*)(WT8 + (size_t)(dst_row0 + n) * ldk + k0 + 8 * c) = o; }
    LDS_WAIT(); asm volatile("" ::: "memory");
}
__device__ __forceinline__ void p_wpeff_block(Frame& F, int blk) {
    const int tid = F.tid, gi = blk >> 3, eb = blk & 7;
    const float* pw = F.in[14] + (size_t)gi * 128 * 128; const float* ps = F.in[15] + gi * 128; const float* wbr = F.in[16] + (size_t)(gi * 128) * 1024 + eb * 128;
    bf16_t* WP = (bf16_t*)(F.ws + WS_WP);
    LAS float* At = (LAS float*)F.lds;
    LAS float* Bs = At + 128 * 128;
    for (int i = tid; i < 128 * 32; i += NTHR) { const int c = i & 127, j4 = (i >> 7) * 4; const f32x4 v = *(const f32x4*)(pw + c * 128 + j4);     At[(j4 + 0) * 128 + c] = v[0]; At[(j4 + 1) * 128 + c] = v[1]; At[(j4 + 2) * 128 + c] = v[2]; At[(j4 + 3) * 128 + c] = v[3]; }
    for (int i = tid; i < 128 * 32; i += NTHR) { const int j = i >> 5, e4 = (i & 31) * 4; const f32x4 v = *(const f32x4*)(wbr + (size_t)j * 1024 + e4); *(LAS f32x4*)(Bs + j * 128 + e4) = v * ps[j]; }
    __syncthreads();
    const int c0 = (tid >> 4) * 4, e0 = (tid & 15) * 8;
    f32x4 acc[4][2];
#pragma unroll
    for (int q = 0; q < 4; ++q) { acc[q][0] = (f32x4){0.f, 0.f, 0.f, 0.f}; acc[q][1] = (f32x4){0.f, 0.f, 0.f, 0.f}; }
#pragma unroll 4
    for (int j = 0; j < 128; ++j) { const f32x4 a = *(const LAS f32x4*)(At + j * 128 + c0), b0 = *(const LAS f32x4*)(Bs + j * 128 + e0), b1 = *(const LAS f32x4*)(Bs + j * 128 + e0 + 4);
#pragma unroll
        for (int q = 0; q < 4; ++q) { acc[q][0] += b0 * a[q]; acc[q][1] += b1 * a[q]; } }
#pragma unroll
    for (int h2 = 0; h2 < 2; ++h2)
#pragma unroll
        for (int x = 0; x < 4; ++x) { const int e = eb * 128 + e0 + 4 * h2 + x;
            *(u32x2*)(WP + (size_t)e * 512 + gi * 128 + c0) = (u32x2){cvt_pk_bf16(acc[0][h2][x], acc[1][h2][x]), cvt_pk_bf16(acc[2][h2][x], acc[3][h2][x])}; }
    __syncthreads();
}
__device__ __forceinline__ void p_convert(Frame& F, const bool do_base, const bool do_moe) {
    LAS float* scr = (LAS float*)(F.lds + F.wave * 16384);
    const int gw = F.vcu * NWAVES + F.wave, NGW = F.G * NWAVES, lane = F.lane;
    bf16_t* WIN = (bf16_t*)(F.ws + WS_WIN); bf16_t* WGLA = (bf16_t*)(F.ws + WS_WGLA); bf16_t* WO = (bf16_t*)(F.ws + WS_WO);
    bf16_t* W13 = (bf16_t*)(F.ws + WS_W13); bf16_t* W2 = (bf16_t*)(F.ws + WS_W2); bf16_t* WP = (bf16_t*)(F.ws + WS_WP);
    constexpr int I_IN = 16 * 177, I_SQ = 16 * 32, I_13 = 64 * 256, I_2 = 32 * 256;
    constexpr int NITEMS = I_IN + 2 * I_SQ + I_13 + I_2;
    for (int it = gw + (do_base ? 0 : I_IN + 2 * I_SQ); it < (do_moe ? NITEMS : I_IN + 2 * I_SQ); it += NGW) {
        int r = it;
        if (r < I_IN) { const int kb = r / 177, nb = r % 177; transpose_item(F.in[8], DIN, 64 * kb, 32 * nb, WIN, 1024, 32 * nb, scr, lane, (nb >= 16 && nb < 32) ? 0.08838834764831845f : 1.f); continue; }   r -= I_IN;
        if (r < I_SQ) { const int kb = r / 32, nb = r % 32; transpose_item(F.in[17], 1024, 64 * kb, 32 * nb, WGLA, 1024, 32 * nb, scr, lane); continue; } r -= I_SQ;
        if (r < I_SQ) { const int kb = r / 32, nb = r % 32; transpose_item(F.in[18], 1024, 64 * kb, 32 * nb, WO, 1024, 32 * nb, scr, lane); continue; } r -= I_SQ;
        if (r < I_13) { const int mat = r / 256, e = mat >> 1, which = mat & 1, rr = r % 256, kb = rr / 16, nb = rr % 16, n0 = 32 * nb;
            const float* src = (which ? F.in[24] : F.in[23]) + (size_t)e * 1024 * 512;
            if (MOE_FP8) transpose_item8(src, 512, 64 * kb, n0, (unsigned char*)W13 + (size_t)e * 1024 * 1024, 1024, (n0 / 128) * 256 + ((n0 % 128) / 32) * 64 + which * 32, scr, lane, SC_W13);
            else transpose_item(src, 512, 64 * kb, n0, W13 + (size_t)e * 1024 * 1024, 1024, (n0 / 128) * 256 + ((n0 % 128) / 32) * 64 + which * 32, scr, lane);
            continue; } r -= I_13;
        { const int e = r / 256, rr = r % 256, kb = rr / 32, nb = rr % 32;
            if (MOE2_FP8) transpose_item8(F.in[25] + (size_t)e * 512 * 1024, 1024, 64 * kb, 32 * nb, (unsigned char*)W2 + (size_t)e * 1024 * 512, 512, 32 * nb, scr, lane, SC_W2);
            else transpose_item(F.in[25] + (size_t)e * 512 * 1024, 1024, 64 * kb, 32 * nb, W2 + (size_t)e * 1024 * 512, 512, 32 * nb, scr, lane); }
    }
}

struct CvItem { const float* src; unsigned char* dst; int ldw, ldk; float scale; };
__device__ __forceinline__ CvItem moe_cv_item(const Frame& F, int r) {
    CvItem c; constexpr int I_13 = 64 * 256;
    if (r < I_13) { const int mat = r / 256, e = mat >> 1, which = mat & 1, rr = r % 256, kb = rr / 16, nb = rr % 16, n0 = 32 * nb;
        c.src = (which ? F.in[24] : F.in[23]) + (size_t)e * 1024 * 512 + (size_t)(64 * kb) * 512 + n0; c.ldw = 512;
        c.dst = F.ws + WS_W13 + (size_t)e * 1024 * 1024 + (size_t)((n0 / 128) * 256 + ((n0 % 128) / 32) * 64 + which * 32) * 1024 + 64 * kb; c.ldk = 1024; c.scale = SC_W13; }
    else { r -= I_13; const int e = r / 256, rr = r % 256, kb = rr / 32, nb = rr % 32;
        c.src = F.in[25] + (size_t)e * 512 * 1024 + (size_t)(64 * kb) * 1024 + 32 * nb; c.ldw = 1024;
        c.dst = F.ws + WS_W2 + (size_t)e * 1024 * 512 + (size_t)(32 * nb) * 512 + 64 * kb; c.ldk = 512; c.scale = SC_W2; }
    return c;
}
__device__ __forceinline__ void cv_load(const CvItem& c, float (&tv)[32], int lane) {
#pragma unroll
    for (int i = 0; i < 32; ++i) tv[i] = c.src[(size_t)(2 * i + (lane >> 5)) * c.ldw + (lane & 31)];
}
__device__ __forceinline__ void cv_store8(const CvItem& c, const float (&tv)[32], LAS float* scr, int lane) {
#pragma unroll
    for (int i = 0; i < 32; ++i) scr[(2 * i + (lane >> 5)) * 33 + (lane & 31)] = tv[i];
    LDS_WAIT(); asm volatile("" ::: "memory");
    const int cc = lane & 7;
#pragma unroll
    for (int j = 0; j < 4; ++j) { const int n = (lane >> 3) + 8 * j; const LAS float* sp = scr + (8 * cc) * 33 + n;
        u32x2 o; o.x = pk4_fp8(sp[0 * 33] * c.scale, sp[1 * 33] * c.scale, sp[2 * 33] * c.scale, sp[3 * 33] * c.scale); o.y = pk4_fp8(sp[4 * 33] * c.scale, sp[5 * 33] * c.scale, sp[6 * 33] * c.scale, sp[7 * 33] * c.scale);
        *(u32x2*)(c.dst + (size_t)n * c.ldk + 8 * cc) = o; }
    LDS_WAIT(); asm volatile("" ::: "memory");
}
__device__ __forceinline__ void p_convert_moe8(Frame& F) {
    LAS float* scr = (LAS float*)(F.lds + F.wave * 16384);
    const int lane = F.lane;
    constexpr int NALL = 64 * 256 + 32 * 256;
    int gw, NGW, N;
    if (F.G == 256) { const int c = (int)blockIdx.x; if (c < 192) { gw = c * NWAVES + F.wave; NGW = 192 * NWAVES; N = NALL / 2; } else { gw = NALL / 2 + (c - 192) * NWAVES + F.wave; NGW = 64 * NWAVES; N = NALL; } }
    else { gw = F.vcu * NWAVES + F.wave; NGW = F.G * NWAVES; N = NALL; }
    int it = gw; if (it >= N) return;
    float tvA[32], tvB[32]; CvItem ia = moe_cv_item(F, it), ib = ia;
    cv_load(ia, tvA, lane);
#pragma unroll 1
    for (;;) {
        const int it2 = it + NGW; const bool h2 = it2 < N;
        if (h2) { ib = moe_cv_item(F, it2); cv_load(ib, tvB, lane); }
        cv_store8(ia, tvA, scr, lane);
        if (!h2) break;
        it = it2 + NGW; const bool h3 = it < N;
        if (h3) { ia = moe_cv_item(F, it); cv_load(ia, tvA, lane); }
        cv_store8(ib, tvB, scr, lane);
        if (!h3) break;
    }
}

#define LDS_BARRIER() asm volatile("s_waitcnt lgkmcnt(0)\n\ts_barrier" ::: "memory")
template <bool LOADN>
__device__ __forceinline__ void norm1_step(const Frame& F, f32x4 (&cur)[4][4], f32x4 (&nxt)[4][4], const float* nsrc, bf16_t* drow, const f32x4 (&Av)[4], const f32x4 (&Bv)[4], const bf16x8 (&wf)[2][4],
                                           float* lrbase, const int lrmul) {
    const int lane = F.lane, wave = F.wave, tid = F.tid;
    constexpr int SROW = 2064;
    LAS unsigned char* stage = F.lds;
    LAS float* part = (LAS float*)(F.lds + 66560);
#pragma unroll
    for (int p = 0; p < 4; ++p) {
        float ss = 0.f;
        if (LOADN) {
#pragma unroll
            for (int q = 0; q < 4; ++q) nxt[p][q] = *(const f32x4*)(nsrc + (size_t)p * D + 8 * lane + 512 * (q >> 1) + 4 * (q & 1)); }
#pragma unroll
        for (int q = 0; q < 4; ++q) ss += (cur[p][q][0] * cur[p][q][0] + cur[p][q][1] * cur[p][q][1]) + (cur[p][q][2] * cur[p][q][2] + cur[p][q][3] * cur[p][q][3]);
        const float rstd = __builtin_amdgcn_rsqf(wave_sum(ss) * (1.f / D) + EPS);
#pragma unroll
        for (int j = 0; j < 2; ++j) { const f32x4 h0 = cur[p][2 * j] * rstd * Av[2 * j] + Bv[2 * j], h1 = cur[p][2 * j + 1] * rstd * Av[2 * j + 1] + Bv[2 * j + 1]; const u32x4 h = pack8(h0, h1);
            *(u32x4*)(drow + (size_t)p * D + 8 * lane + 512 * j) = h; *(LAS u32x4*)(stage + (4 * wave + p) * SROW + (8 * lane + 512 * j) * 2) = h; }
    }
    LDS_BARRIER();
    f32x4 acc[2][2];
#pragma unroll
    for (int nb = 0; nb < 2; ++nb)
#pragma unroll
        for (int nh = 0; nh < 2; ++nh) acc[nb][nh] = (f32x4){0.f, 0.f, 0.f, 0.f};
#pragma unroll
    for (int nb = 0; nb < 2; ++nb)
#pragma unroll
        for (int ks = 0; ks < 4; ++ks) { const bf16x8 bfr = *(LAS bf16x8*)(stage + (16 * nb + (lane & 15)) * SROW + (128 * wave + 32 * ks + 8 * (lane >> 4)) * 2);
#pragma unroll
            for (int nh = 0; nh < 2; ++nh) acc[nb][nh] = __builtin_amdgcn_mfma_f32_16x16x32_bf16(wf[nh][ks], bfr, acc[nb][nh], 0, 0, 0); }
#pragma unroll
    for (int nb = 0; nb < 2; ++nb)
#pragma unroll
        for (int nh = 0; nh < 2; ++nh) *(LAS f32x4*)(part + ((wave * 4 + nb * 2 + nh) * 64 + lane) * 4) = acc[nb][nh];
    LDS_BARRIER();
    {
        const int q = tid >> 7, ln = (tid & 127) >> 1, ip = tid & 1;
        f32x2 sum = (f32x2){0.f, 0.f};
#pragma unroll
        for (int w8 = 0; w8 < 8; ++w8) sum += *(LAS f32x2*)(part + ((w8 * 4 + q) * 64 + ln) * 4 + 2 * ip);
        const int slot = 16 * (q >> 1) + (ln & 15), n = 16 * (q & 1) + 4 * (ln >> 4) + 2 * ip;
        *(f32x2*)(lrbase + ((size_t)lrmul * (slot >> 2) + (slot & 3)) * 32 + n) = sum; }
}
__device__ __forceinline__ void p_norm1(Frame& F) {
    const int lane = F.lane, wave = F.wave;
    const float* mod = (const float*)(F.ws + WS_MOD); bf16_t* HX = (bf16_t*)(F.ws + WS_HX); float* LR = (float*)(F.ws + WS_LR);
    const bf16_t* WIN = (const bf16_t*)(F.ws + WS_WIN);
    bf16x8 wf[2][4];
#pragma unroll
    for (int nh = 0; nh < 2; ++nh)
#pragma unroll
        for (int ks = 0; ks < 4; ++ks) wf[nh][ks] = *(const bf16x8*)(WIN + (size_t)(5632 + 16 * nh + (lane & 15)) * 1024 + 128 * wave + 32 * ks + 8 * (lane >> 4));
    for (int wv = F.vcu; wv < 256; wv += F.G) {
        const int gw = wv * NWAVES + wave, b = wv >> 3;
        f32x4 Av[4], Bv[4];
#pragma unroll
        for (int q = 0; q < 4; ++q) { const int c = 8 * lane + 512 * (q >> 1) + 4 * (q & 1); const f32x4 g = *(const f32x4*)(F.in[6] + c), sc = *(const f32x4*)(mod + b * 6144 + 1024 + c); Av[q] = g * (sc + 1.f); Bv[q] = *(const f32x4*)(mod + b * 6144 + c); }
        f32x4 bufA[4][4], bufB[4][4];
        const float* xr = F.in[0] + (size_t)32 * gw * D; bf16_t* hr = HX + (size_t)32 * gw * D; float* lr = LR + (size_t)32 * wv * NWAVES * 32;
#pragma unroll
        for (int p = 0; p < 4; ++p)
#pragma unroll
            for (int q = 0; q < 4; ++q) bufA[p][q] = *(const f32x4*)(xr + (size_t)p * D + 8 * lane + 512 * (q >> 1) + 4 * (q & 1));
#pragma unroll 1
        for (int i2 = 0; i2 < 3; ++i2) {
            norm1_step<true>(F, bufA, bufB, xr + (size_t)(8 * i2 + 4) * D, hr + (size_t)(8 * i2) * D, Av, Bv, wf, lr + (size_t)(8 * i2) * 32, 32);
            norm1_step<true>(F, bufB, bufA, xr + (size_t)(8 * i2 + 8) * D, hr + (size_t)(8 * i2 + 4) * D, Av, Bv, wf, lr + (size_t)(8 * i2 + 4) * 32, 32);
        }
        norm1_step<true>(F, bufA, bufB, xr + (size_t)28 * D, hr + (size_t)24 * D, Av, Bv, wf, lr + (size_t)24 * 32, 32);
        norm1_step<true>(F, bufB, bufA, F.in[2] + (size_t)4 * gw * D, hr + (size_t)28 * D, Av, Bv, wf, lr + (size_t)28 * 32, 32);
#pragma unroll
        for (int q = 0; q < 4; ++q) { const int c = 8 * lane + 512 * (q >> 1) + 4 * (q & 1); const f32x4 g = *(const f32x4*)(F.in[6] + c), sc = *(const f32x4*)(mod + 32 * 6144 + 1024 + c); Av[q] = g * (sc + 1.f); Bv[q] = *(const f32x4*)(mod + 32 * 6144 + c); }
        norm1_step<false>(F, bufA, bufB, nullptr, HX + ((size_t)T + 4 * gw) * D, Av, Bv, wf, LR + ((size_t)T + 4 * wv * NWAVES) * 32, 4);
    }
    __syncthreads();
}

struct SchedG1 {
    static constexpr bool GATHER = false;
    const char* HX; const char* WIN; int G, c;
    __device__ __forceinline__ bool next(int i, pg8::Unit& u) const {
        const int L = i * G + c; constexpr int NL = 256 * 22, NC = 32 * 6;
        if (L >= NL + NC) return false;
        int pm, pn, ctx = 0;
        if (L < NL) pg8::static_tile(L, 256, 22, pm, pn);
        else { const int j = L - NL; pm = j & 31; pn = 4 + (j >> 5); ctx = 1; }
        u.pm = pm; u.pn = pn; u.aux = ctx;
        u.A = HX + ((size_t)(ctx ? T : 0) + (size_t)pm * 256) * (D * 2); u.B = WIN + (size_t)pn * 256 * (D * 2);
        pg8::contig_va(u.va, D * 2);
        return true;
    }
};
struct EpiG1 {
    static constexpr int NISS = 16; static constexpr bool IDEM = true; static constexpr bool PERM = true;
    unsigned char* ws;
    __device__ __forceinline__ void operator()(const f32x4 (&acc)[2][2][4][2], const pg8::Unit& u, int wr, int wc, int fr, int fq) const {
        const int pn = u.pn, ctx = u.aux; const int rowg = u.pm * 256 + wr * 64;
        bf16_t* base; int ldc, colt;
        if (ctx) { base = (bf16_t*)(ws + WS_PKVC); ldc = 1536; colt = (pn - 4) * 256; }
        else if (pn < 2) { base = (bf16_t*)(ws + WS_PU); ldc = 512; colt = pn * 256; }
        else if (pn < 10) { base = (bf16_t*)(ws + WS_PQKV); ldc = 2048; colt = (pn - 2) * 256; }
        else if (pn < 14) { base = (bf16_t*)(ws + WS_PG); ldc = 1024; colt = (pn - 10) * 256; }
        else { base = (bf16_t*)(ws + WS_PGATES); ldc = 2048; colt = (pn - 14) * 256; }
        bf16_t* blk = base + (size_t)rowg * ldc + colt + wc * 64;
#pragma unroll
        for (int ai = 0; ai < 2; ++ai)
#pragma unroll
            for (int m = 0; m < 4; ++m)
                st_lines(blk + (size_t)(ai * 128 + m * 16) * ldc, (size_t)ldc, fr, fq, pack8(acc[ai][0][m][0], acc[ai][0][m][1]), pack8(acc[ai][1][m][0], acc[ai][1][m][1]));
    }
};

typedef float f32x16 __attribute__((ext_vector_type(16)));
typedef short s16x4 __attribute__((ext_vector_type(4)));
typedef __bf16 bf16v2_t __attribute__((ext_vector_type(2)));
__device__ __forceinline__ unsigned pkbf(float a, float b) { bf16v2_t v; v[0] = (__bf16)a; v[1] = (__bf16)b; return __builtin_bit_cast(unsigned, v); }
__device__ __forceinline__ unsigned off_b(unsigned row, unsigned ch) { return 256u * row + 16u * (ch ^ (((row & 3u) << 2) | ((row >> 2) & 3u))); }
__device__ __forceinline__ unsigned tr_addr_b(unsigned lane, unsigned c, unsigned ks, unsigned t) {
    const unsigned h = lane >> 5, blk = (lane >> 4) & 1u, q = (lane & 15u) >> 2, pp = lane & 3u;
    return off_b(16u * ks + 8u * h + 4u * t + q, 4u * c + 2u * blk + (pp >> 1)) + 8u * (pp & 1u);
}
constexpr int GL_V = 0, GL_QD = 32768, GL_KI = 49152, GL_KR = 65536, GL_PM = 81920, GL_CUM = 90112, GL_DEC = 122880, GL_OT = 123392;
#define MFMA32(a, b, c) __builtin_amdgcn_mfma_f32_32x32x16_bf16((a), (b), (c), 0, 0, 0)
__device__ __forceinline__ void p_gla_chunk(Frame& F) {
    const int w = F.wave;
    LAS unsigned char* L = F.lds;
    const bf16_t* PQKV = (const bf16_t*)(F.ws + WS_PQKV); const bf16_t* PKVC = (const bf16_t*)(F.ws + WS_PKVC); const float* LR = (const float*)(F.ws + WS_LR);
    LAS float* CUM = (LAS float*)(L + GL_CUM); LAS float* DEC = (LAS float*)(L + GL_DEC);
    const int tid0 = F.tid;
    const int ib = w >> 2, db = w & 3;
    const unsigned A_vw = GL_V + (unsigned)((tid0 & 31) >> 4) * 16384u + off_b((unsigned)(tid0 >> 5), (unsigned)(tid0 & 15));
    const unsigned A_kr = off_b((unsigned)(tid0 >> 4), (unsigned)(tid0 & 15));
    const unsigned A_a0 = off_b((unsigned)(tid0 >> 4), (unsigned)(tid0 & 14)) + 8u * (unsigned)(tid0 & 1);
    unsigned RB, TB, PB, WB;
    { const unsigned lane0 = tid0 & 63, hh0 = lane0 >> 5, l310 = lane0 & 31; const unsigned tq = (lane0 & 15) >> 2, tp = lane0 & 3, tblk = (lane0 >> 4) & 1;
      RB = 256u * l310 + 16u * (((l310 & 3u) << 2) | ((l310 >> 2) & 3u));
      TB = 256u * (8u * hh0 + tq) + 8u * (tp & 1u) + 16u * ((2u * tblk + (tp >> 1)) ^ ((tq << 2) | (2u * hh0)));
      PB = 128u * l310 + 16u * (hh0 ^ ((l310 >> 1) & 7u));
      WB = 128u * l310 + 16u * ((l310 >> 1) & 7u) + 8u * hh0; }
    for (int wgi = blockIdx.x; wgi < 256; wgi += F.G) {
        const int b = wgi >> 3, h = (wgi >> 1) & 3, dir = wgi & 1;
        bf16_t* OD = (bf16_t*)F.out + (size_t)dir * T * D;
        const float* a2 = dir ? F.in[11] : F.in[9]; const float* ab = dir ? F.in[12] : F.in[10];
        float a2r[8];
#pragma unroll
        for (int kk = 0; kk < 8; ++kk) a2r[kk] = a2[(kk + 8 * ((tid0 >> 5) & 1)) * 512 + h * 128 + 32 * db + (tid0 & 31)];
        const float abd2 = -1.44269504089f * ab[h * 128 + 32 * db + (tid0 & 31)];
        unsigned vo = (unsigned)(dir ? 63 - (tid0 >> 5) : (tid0 >> 5)) * 3072u + 16u * (unsigned)(tid0 & 31);
        unsigned ko = (unsigned)(dir ? 63 - (tid0 >> 4) : (tid0 >> 4)) * 3072u + 16u * (unsigned)(tid0 & 15);
        const unsigned lvo = (unsigned)(dir ? 63 - (32 * ib + (tid0 & 31)) : (32 * ib + (tid0 & 31))) * 128u + 32u * (unsigned)((tid0 >> 5) & 1);
        f32x16 S[4];
#pragma unroll
        for (int q = 0; q < 4; ++q)
#pragma unroll
            for (int r = 0; r < 16; ++r) S[q][r] = 0.f;
        f32x4 lv[2]; u32x4 vreg[4], qreg[2], kreg[2];
#define GLA_LOAD(CH) do { const int _ch = (CH); const bool _ic = _ch < 4; const int _ci = _ic ? _ch : _ch - 4, _N = _ic ? CTXL : SEQ; const unsigned _rp2 = _ic ? 3072u : 4096u; \
            if (_ch == 4) { int _t = tid0; asm volatile("" : "+v"(_t)); vo = (unsigned)(dir ? 63 - (_t >> 5) : (_t >> 5)) * 4096u + 16u * (unsigned)(_t & 31); ko = (unsigned)(dir ? 63 - (_t >> 4) : (_t >> 4)) * 4096u + 16u * (unsigned)(_t & 15); } \
            const int _tok0 = dir ? (_N - 64 - 64 * _ci) : 64 * _ci; \
            const char* _gb = (const char*)(_ic ? PKVC + (size_t)b * CTXL * 1536 : PQKV + (size_t)b * SEQ * 2048) + (size_t)_tok0 * _rp2; \
            const int _qc = h * 128, _kc = _ic ? h * 128 : 512 + h * 128, _vc = _ic ? 512 + h * 256 : 1024 + h * 256; \
            const char* _lrb = (const char*)(LR + ((_ic ? (size_t)T + (size_t)b * CTXL : (size_t)b * SEQ) + _tok0) * 32 + dir * 16); \
            lv[0] = *(const f32x4*)(_lrb + (size_t)lvo); lv[1] = *(const f32x4*)(_lrb + 16 + (size_t)lvo); \
            const unsigned _vs = dir ? 0u - 16u * _rp2 : 16u * _rp2, _ks = dir ? 0u - 32u * _rp2 : 32u * _rp2;        \
            _Pragma("unroll") for (int q = 0; q < 4; ++q) vreg[q] = *(const u32x4*)(_gb + _vc * 2 + (size_t)(vo + (unsigned)q * _vs)); \
            _Pragma("unroll") for (int q = 0; q < 2; ++q) { kreg[q] = *(const u32x4*)(_gb + _kc * 2 + (size_t)(ko + (unsigned)q * _ks)); qreg[q] = *(const u32x4*)(_gb + _qc * 2 + (size_t)(ko + (unsigned)q * _ks)); } } while (0)
#define GLA_FLUSH(CI) do { const int _ci = (CI); const int _tok0 = dir ? (SEQ - 64 - 64 * _ci) : 64 * _ci; char* _ob = (char*)(OD + ((size_t)b * SEQ + _tok0) * D + h * 256); \
            const unsigned _fo = (unsigned)(dir ? 63 - (tid >> 5) : (tid >> 5)) * 2048u + 16u * (unsigned)(tid & 31), _fs = dir ? 0u - 16u * 2048u : 16u * 2048u; \
            const unsigned _fl = GL_OT + (unsigned)(tid >> 5) * 528u + (unsigned)(tid & 31) * 16u; \
            _Pragma("unroll") for (int q = 0; q < 4; ++q) *(u32x4*)(_ob + (size_t)(_fo + (unsigned)q * _fs)) = *(const LAS u32x4*)(L + _fl + 8448 * q); } while (0)
        GLA_LOAD(0);
        for (int ch = 0; ch < 36; ++ch) {
            const bool isctx = ch < 4;
            int tid = tid0; asm volatile("" : "+v"(tid), "+v"(RB), "+v"(TB), "+v"(PB), "+v"(WB));
            const int lane0 = tid & 63, hh = lane0 >> 5, l31 = lane0 & 31;
            f32x16 g;
#pragma unroll
            for (int r = 0; r < 16; ++r) g[r] = 0.f;
#pragma unroll
            for (int kk = 0; kk < 8; ++kk) g = __builtin_amdgcn_mfma_f32_32x32x2f32(lv[kk >> 2][kk & 3], a2r[kk], g, 0, 0, 0);
            float cum[16], gs[4], pg[4];
#pragma unroll
            for (int r = 0; r < 16; ++r) { const float a = __builtin_fmaf(g[r], -1.44269504089f, abd2);
                cum[r] = (fmaxf(a, 0.f) + __builtin_amdgcn_logf(1.f + __builtin_amdgcn_exp2f(-fabsf(a)))) * -0.0625f; }
#pragma unroll
            for (int q = 0; q < 4; ++q) { cum[4 * q + 1] += cum[4 * q]; cum[4 * q + 2] += cum[4 * q + 1]; cum[4 * q + 3] += cum[4 * q + 2]; gs[q] = cum[4 * q + 3]; }
#pragma unroll
            for (int q = 0; q < 4; ++q) pg[q] = xchg32(gs[q], lane0);
            { float run = 0.f;
#pragma unroll
                for (int q = 0; q < 4; ++q) { const float offq = run + (hh ? pg[q] : 0.f);
#pragma unroll
                    for (int e = 0; e < 4; ++e) cum[4 * q + e] += offq;
                    run += gs[q] + pg[q]; } }
            __syncthreads();
            if (ch >= 5) GLA_FLUSH(ch - 5);
            { LAS float* cw = (LAS float*)(L + GL_CUM) + (32 * ib + 4 * hh) * 128 + 32 * db + l31;
#pragma unroll
                for (int r = 0; r < 16; ++r) cw[((r & 3) + 8 * (r >> 2)) * 128] = cum[r]; }
#pragma unroll
            for (int q = 0; q < 4; ++q) *(LAS u32x4*)(L + A_vw + 4096 * q) = vreg[q];
            __syncthreads();
            {
                const unsigned A_tb = GL_CUM + 32u * (unsigned)(tid & 15), A_cb = A_tb + (unsigned)(tid >> 4) * 512u;
                const f32x4 t0 = *(const LAS f32x4*)(L + A_tb + 31 * 512), t1 = *(const LAS f32x4*)(L + A_tb + 31 * 512 + 16);
                const f32x4 l0 = *(const LAS f32x4*)(L + A_tb + 63 * 512) + t0, l1 = *(const LAS f32x4*)(L + A_tb + 63 * 512 + 16) + t1;
                float el8[8];
#pragma unroll
                for (int e = 0; e < 4; ++e) { el8[e] = __builtin_amdgcn_exp2f(l0[e]); el8[4 + e] = __builtin_amdgcn_exp2f(l1[e]); }
#pragma unroll
                for (int q = 0; q < 2; ++q) {
                    f32x4 c0 = *(const LAS f32x4*)(L + A_cb + 16384 * q), c1 = *(const LAS f32x4*)(L + A_cb + 16384 * q + 16);
                    if (q == 1) { c0 += t0; c1 += t1; }
                    float kf[8], qf[8], cc[8]; unpack8(kreg[q], kf); unpack8(qreg[q], qf);
#pragma unroll
                    for (int e = 0; e < 4; ++e) { cc[e] = c0[e]; cc[4 + e] = c1[e]; }
                    float kr[8], kiv[8], qd[8];
#pragma unroll
                    for (int e = 0; e < 8; ++e) { const float ex = __builtin_amdgcn_exp2f(cc[e]), inv = __builtin_amdgcn_exp2f(-cc[e]); qd[e] = qf[e] * ex; kiv[e] = kf[e] * inv; kr[e] = kiv[e] * el8[e]; }
                    u32x4 wk; wk.x = pkbf(kr[0], kr[1]); wk.y = pkbf(kr[2], kr[3]); wk.z = pkbf(kr[4], kr[5]); wk.w = pkbf(kr[6], kr[7]);
                    *(LAS u32x4*)(L + GL_KR + 8192 * q + A_kr) = wk;
                    if (!isctx) {
                        *(LAS u32x2*)(L + GL_QD + 8192 * q + A_a0) = (u32x2){pkbf(qd[0], qd[1]), pkbf(qd[2], qd[3])}; *(LAS u32x2*)(L + GL_QD + 8192 * q + (A_a0 ^ 16u)) = (u32x2){pkbf(qd[4], qd[5]), pkbf(qd[6], qd[7])};
                        *(LAS u32x2*)(L + GL_KI + 8192 * q + A_a0) = (u32x2){pkbf(kiv[0], kiv[1]), pkbf(kiv[2], kiv[3])}; *(LAS u32x2*)(L + GL_KI + 8192 * q + (A_a0 ^ 16u)) = (u32x2){pkbf(kiv[4], kiv[5]), pkbf(kiv[6], kiv[7])};
                    }
                }
            }
            if (w < 2) DEC[tid] = __builtin_amdgcn_exp2f(CUM[63 * 128 + tid] + CUM[31 * 128 + tid]);
            if (ch + 1 < 36) GLA_LOAD(ch + 1);
            __syncthreads();
            bf16x8 vb[4];
            { LAS unsigned char* vbase = L + GL_V + (w >> 2) * 16384; const unsigned c4 = (unsigned)(w & 3) << 2;
#pragma unroll
                for (int ks = 0; ks < 4; ++ks) { const s16x4 lo = __builtin_amdgcn_ds_read_tr16_b64_v4i16((LAS s16x4*)(vbase + (TB ^ (c4 << 4)) + 256 * (16 * ks)));
                    const s16x4 hi = __builtin_amdgcn_ds_read_tr16_b64_v4i16((LAS s16x4*)(vbase + (TB ^ ((c4 ^ 1u) << 4)) + 256 * (16 * ks + 4)));
                    vb[ks] = __builtin_shufflevector(lo, hi, 0, 1, 2, 3, 4, 5, 6, 7); } }
            f32x16 o[2];
            if (!isctx) {
                if (w < 3) {
                    const int jb = (w == 2) ? 1 : 0, ibs = (w == 0) ? 0 : 1;
                    f32x16 sc;
#pragma unroll
                    for (int r = 0; r < 16; ++r) sc[r] = 0.f;
#pragma unroll
                    for (int s8 = 0; s8 < 8; ++s8) { const unsigned ro = RB ^ (unsigned)((2 * s8 + hh) << 4);
                        const bf16x8 af = *(const LAS bf16x8*)(L + GL_KI + 8192 * jb + ro), bfr = *(const LAS bf16x8*)(L + GL_QD + 8192 * ibs + ro); sc = MFMA32(af, bfr, sc); }
                    const int mlim = (jb == ibs) ? l31 : 64;
#pragma unroll
                    for (int q = 0; q < 4; ++q) { float pv[4];
#pragma unroll
                        for (int e = 0; e < 4; ++e) { const int jl = e + 8 * q + 4 * hh; pv[e] = (jl > mlim) ? 0.f : sc[4 * q + e]; }
                        *(LAS u32x2*)(L + GL_PM + 4096 * ibs + (WB ^ (unsigned)((4 * jb + q) << 4))) = (u32x2){pkbf(pv[0], pv[1]), pkbf(pv[2], pv[3])}; }
                }
#pragma unroll
                for (int i2 = 0; i2 < 2; ++i2)
#pragma unroll
                    for (int r = 0; r < 16; ++r) o[i2][r] = 0.f;
#pragma unroll
                for (int q = 0; q < 4; ++q)
#pragma unroll
                    for (int s2 = 0; s2 < 2; ++s2) { u32x4 pb; pb.x = pkbf(S[q][8 * s2], S[q][8 * s2 + 1]); pb.y = pkbf(S[q][8 * s2 + 2], S[q][8 * s2 + 3]); pb.z = pkbf(S[q][8 * s2 + 4], S[q][8 * s2 + 5]); pb.w = pkbf(S[q][8 * s2 + 6], S[q][8 * s2 + 7]);
                        const bf16x8 sfr = __builtin_bit_cast(bf16x8, pb); const unsigned ro = RB ^ (unsigned)((4 * q + 2 * s2 + hh) << 4);
#pragma unroll
                        for (int i2 = 0; i2 < 2; ++i2) { const bf16x8 qfr = *(const LAS bf16x8*)(L + GL_QD + 8192 * i2 + ro); o[i2] = MFMA32(sfr, qfr, o[i2]); } }
                __syncthreads();
#pragma unroll
                for (int i2 = 0; i2 < 2; ++i2)
#pragma unroll
                    for (int ks = 0; ks < 4; ++ks) { if (i2 == 0 && ks >= 2) continue;
                        const bf16x8 pfr = *(const LAS bf16x8*)(L + GL_PM + 4096 * i2 + (PB ^ (unsigned)((2 * ks) << 4))); o[i2] = MFMA32(vb[ks], pfr, o[i2]); }
            }
#pragma unroll
            for (int q = 0; q < 4; ++q) {
#pragma unroll
                for (int g4 = 0; g4 < 4; ++g4) { const f32x4 dv = *(const LAS f32x4*)(DEC + 32 * q + 8 * g4 + 4 * hh);
#pragma unroll
                    for (int e = 0; e < 4; ++e) S[q][4 * g4 + e] *= dv[e]; }
#pragma unroll
                for (int ks = 0; ks < 4; ++ks) { const s16x4 lo = __builtin_amdgcn_ds_read_tr16_b64_v4i16((LAS s16x4*)(L + GL_KR + (TB ^ (unsigned)((4 * q) << 4)) + 256 * (16 * ks)));
                    const s16x4 hi = __builtin_amdgcn_ds_read_tr16_b64_v4i16((LAS s16x4*)(L + GL_KR + (TB ^ (unsigned)(((4 * q) ^ 1) << 4)) + 256 * (16 * ks + 4)));
                    const bf16x8 af = __builtin_shufflevector(lo, hi, 0, 1, 2, 3, 4, 5, 6, 7); S[q] = MFMA32(af, vb[ks], S[q]); }
            }
            if (!isctx) {
                const unsigned A_ot = GL_OT + (unsigned)l31 * 528u + (unsigned)(32 * w + 4 * hh) * 2u;
#pragma unroll
                for (int i2 = 0; i2 < 2; ++i2)
#pragma unroll
                    for (int rq = 0; rq < 4; ++rq) *(LAS u32x2*)(L + A_ot + (32 * i2) * 528 + 16 * rq) = (u32x2){pkbf(o[i2][4 * rq], o[i2][4 * rq + 1]), pkbf(o[i2][4 * rq + 2], o[i2][4 * rq + 3])};
            }
        }
        __syncthreads();
        { const int tid = tid0; GLA_FLUSH(31); }
#undef GLA_FLUSH
#undef GLA_LOAD
    }
    __syncthreads();
}

template <bool LOADN>
__device__ __forceinline__ void og_rows2(const bf16_t* OF, const bf16_t* OB, const bf16_t* PG, bf16_t* OG, const size_t off0, const u32x4 (&cur)[3][2][2], u32x4 (&nxt)[3][2][2], const float (&gn)[8]) {
    if (LOADN) {
#pragma unroll
        for (int rr = 0; rr < 2; ++rr)
#pragma unroll
            for (int j = 0; j < 2; ++j) { const size_t off = off0 + (size_t)(2 + rr) * D + 512 * j; nxt[0][rr][j] = *(const u32x4*)(OF + off); nxt[1][rr][j] = *(const u32x4*)(OB + off); nxt[2][rr][j] = *(const u32x4*)(PG + off); }
    }
#pragma unroll
    for (int rr = 0; rr < 2; ++rr)
#pragma unroll
        for (int j = 0; j < 2; ++j) {
            float o[8], ob[8], g[8]; unpack8(cur[0][rr][j], o); unpack8(cur[1][rr][j], ob); unpack8(cur[2][rr][j], g);
            float ss = 0.f;
#pragma unroll
            for (int e = 0; e < 8; ++e) { o[e] += ob[e]; ss += o[e] * o[e]; }
            ss = row_sum16(ss); ss = swap16_sum(ss, ss);
            const float rstd = __builtin_amdgcn_rsqf(ss * (1.f / 256.f) + EPS);
            float y[8];
#pragma unroll
            for (int e = 0; e < 8; ++e) y[e] = (o[e] * (rstd * gn[e])) * (g[e] * sigmoidf_(g[e]));
            u32x4 wv; wv.x = cvt_pk_bf16(y[0], y[1]); wv.y = cvt_pk_bf16(y[2], y[3]); wv.z = cvt_pk_bf16(y[4], y[5]); wv.w = cvt_pk_bf16(y[6], y[7]);
            *(u32x4*)(OG + off0 + (size_t)rr * D + 512 * j) = wv; }
}
__device__ __forceinline__ void p_prep(Frame& F, const bool do_og, const bool do_pool) {
    const int gw = F.vcu * NWAVES + F.wave, NGW = F.G * NWAVES, lane = F.lane;
    const bf16_t* OF = (const bf16_t*)F.out; const bf16_t* OB = OF + (size_t)T * D; const bf16_t* PG = (const bf16_t*)(F.ws + WS_PG);
    bf16_t* OG = (bf16_t*)(F.ws + WS_HX);
    float gn[8];
    { const f32x4 g0 = *(const f32x4*)(F.in[13] + 8 * (lane & 31)), g1 = *(const f32x4*)(F.in[13] + 8 * (lane & 31) + 4);
#pragma unroll
        for (int e = 0; e < 4; ++e) { gn[e] = g0[e]; gn[4 + e] = g1[e]; } }
    if (do_og)
    for (int w = gw; w < 2048; w += NGW) {
        u32x4 bufA[3][2][2], bufB[3][2][2];
        const size_t base = (size_t)w * 32 * D + 8 * lane;
#pragma unroll
        for (int rr = 0; rr < 2; ++rr)
#pragma unroll
            for (int j = 0; j < 2; ++j) { const size_t off = base + (size_t)rr * D + 512 * j; bufA[0][rr][j] = *(const u32x4*)(OF + off); bufA[1][rr][j] = *(const u32x4*)(OB + off); bufA[2][rr][j] = *(const u32x4*)(PG + off); }
#pragma unroll 1
        for (int r = 0; r < 32; r += 4) {
            og_rows2<true>(OF, OB, PG, OG, base + (size_t)r * D, bufA, bufB, gn);
            if (r + 4 < 32) og_rows2<true>(OF, OB, PG, OG, base + (size_t)(r + 2) * D, bufB, bufA, gn);
            else og_rows2<false>(OF, OB, PG, OG, base + (size_t)(r + 2) * D, bufB, bufA, gn);
        }
    }
    if (!do_pool) return;
    const bf16_t* PU = (const bf16_t*)(F.ws + WS_PU); bf16_t* PO = (bf16_t*)(F.ws + WS_PO);
    LAS unsigned* uL = (LAS unsigned*)F.lds;
    u32x4 upf[8];
    if (F.vcu < T / 64) {
#pragma unroll
        for (int q = 0; q < 8; ++q) upf[q] = *(const u32x4*)(PU + (size_t)F.vcu * 64 * 512 + (size_t)(F.tid + NTHR * q) * 8); }
    for (int tt = F.vcu; tt < T / 64; tt += F.G) {
        __syncthreads();
#pragma unroll
        for (int q = 0; q < 8; ++q) *(LAS u32x4*)(uL + (F.tid + NTHR * q) * 4) = upf[q];
        if (tt + F.G < T / 64) {
#pragma unroll
            for (int q = 0; q < 8; ++q) upf[q] = *(const u32x4*)(PU + (size_t)(tt + F.G) * 64 * 512 + (size_t)(F.tid + NTHR * q) * 8); }
        __syncthreads();
        const int cp = F.tid & 255, half = F.tid >> 8, gi = cp >> 6, hw = 1 << gi;
        const int p0 = half * 32;
        float s0 = 0.f, s1 = 0.f;
        { const int lo = (p0 - hw) < 0 ? 0 : (p0 - hw), hi = p0 + hw;
            for (int q = lo; q < hi; ++q) { const unsigned wv = uL[q * 256 + cp]; s0 += bf_lo(wv); s1 += bf_hi(wv); } }
        bf16_t* po = PO + ((size_t)tt * 64 + p0) * 512 + 2 * cp;
#pragma unroll 8
        for (int i = 0; i < 32; ++i) {
            const int p = p0 + i; const int lo = (p - hw) < 0 ? 0 : (p - hw), hi = (p + hw) > 64 ? 64 : (p + hw);
            const unsigned self = uL[p * 256 + cp]; const float inv = 1.f / (float)(hi - lo);
            *(unsigned*)(po + (size_t)i * 512) = cvt_pk_bf16(s0 * inv - bf_lo(self), s1 * inv - bf_hi(self));
            const int qa = p + hw, qd = p - hw;
            const unsigned wa = uL[(qa < 64 ? qa : 63) * 256 + cp], wd = uL[(qd >= 0 ? qd : 0) * 256 + cp];
            const float fa = qa < 64 ? 1.f : 0.f, fd = qd >= 0 ? 1.f : 0.f;
            s0 += fa * bf_lo(wa) - fd * bf_lo(wd); s1 += fa * bf_hi(wa) - fd * bf_hi(wd);
        }
    }
    __syncthreads();
}

struct SchedSq {
    static constexpr bool GATHER = false;
    const char* A; const char* B; unsigned lda; int K, G, c;
    __device__ __forceinline__ bool next(int i, pg8::Unit& u) const {
        const int L = i * G + c; if (L >= 1024) return false;
        int pm, pn; pg8::static_tile(L, 256, 4, pm, pn); u.pm = pm; u.pn = pn; u.aux = 0;
        u.A = A + (size_t)pm * 256 * lda; u.B = B + (size_t)pn * 256 * (K * 2); pg8::contig_va(u.va, lda); return true;
    }
};
struct EpiPool {
    static constexpr int NISS = 32; static constexpr bool IDEM = true; static constexpr bool PERM = true;
    const bf16_t* GATES; bf16_t* Z;
    __device__ __forceinline__ void operator()(const f32x4 (&acc)[2][2][4][2], const pg8::Unit& u, int wr, int wc, int fr, int fq) const {
        const size_t rowg = (size_t)u.pm * 256 + wr * 64; const int colb = u.pn * 256 + wc * 64;
        u32x4 gq[2][4][2];
#pragma unroll
        for (int ai = 0; ai < 2; ++ai)
#pragma unroll
            for (int m = 0; m < 4; ++m) ld_lines(GATES + (rowg + ai * 128 + m * 16) * 2048 + colb, 2048, fr, fq, gq[ai][m][0], gq[ai][m][1]);
        asm volatile("" ::: "memory");
#pragma unroll
        for (int ai = 0; ai < 2; ++ai)
#pragma unroll
            for (int m = 0; m < 4; ++m) { const size_t rg = rowg + ai * 128 + m * 16; u32x4 wv[2];
#pragma unroll
                for (int bj = 0; bj < 2; ++bj) { float g[8]; unpack8(gq[ai][m][bj], g); const f32x4 a0 = acc[ai][bj][m][0], a1 = acc[ai][bj][m][1]; f32x4 z0, z1;
#pragma unroll
                    for (int e = 0; e < 4; ++e) { z0[e] = a0[e] * sigmoidf_(g[e]); z1[e] = a1[e] * sigmoidf_(g[4 + e]); }
                    wv[bj] = pack8(z0, z1); }
                st_lines(Z + rg * 1024 + colb, 1024, fr, fq, wv[0], wv[1]); }
    }
};
struct EpiGla {
    static constexpr int NISS = 48; static constexpr bool IDEM = false; static constexpr bool PERM = true;
    const bf16_t* GATES; bf16_t* Z;
    __device__ __forceinline__ void operator()(const f32x4 (&acc)[2][2][4][2], const pg8::Unit& u, int wr, int wc, int fr, int fq) const {
        const size_t rowg = (size_t)u.pm * 256 + wr * 64; const int colb = u.pn * 256 + wc * 64;
#pragma unroll
        for (int ai = 0; ai < 2; ++ai) {
            u32x4 gq[4][2], zq[4][2];
#pragma unroll
            for (int m = 0; m < 4; ++m) { const size_t rg = rowg + ai * 128 + m * 16; ld_lines(GATES + rg * 2048 + 1024 + colb, 2048, fr, fq, gq[m][0], gq[m][1]); ld_lines(Z + rg * 1024 + colb, 1024, fr, fq, zq[m][0], zq[m][1]); }
            asm volatile("" ::: "memory");
#pragma unroll
            for (int m = 0; m < 4; ++m) { const size_t rg = rowg + ai * 128 + m * 16; u32x4 wv[2];
#pragma unroll
                for (int bj = 0; bj < 2; ++bj) { float g[8], zp[8]; unpack8(gq[m][bj], g); unpack8(zq[m][bj], zp); const f32x4 a0 = acc[ai][bj][m][0], a1 = acc[ai][bj][m][1]; f32x4 z0, z1;
#pragma unroll
                    for (int e = 0; e < 4; ++e) { z0[e] = zp[e] + a0[e] * sigmoidf_(g[e]); z1[e] = zp[4 + e] + a1[e] * sigmoidf_(g[4 + e]); }
                    wv[bj] = pack8(z0, z1); }
                st_lines(Z + rg * 1024 + colb, 1024, fr, fq, wv[0], wv[1]); }
        }
    }
};
struct EpiWo {
    static constexpr int NISS = 52; static constexpr bool IDEM = true; static constexpr bool PERM = true;
    const float* X; const float* MOD; bf16_t* X1;
    __device__ __forceinline__ void operator()(const f32x4 (&acc)[2][2][4][2], const pg8::Unit& u, int wr, int wc, int fr, int fq) const {
        const size_t rowg = (size_t)u.pm * 256 + wr * 64; const int colb = u.pn * 256 + wc * 64, col0 = colb + 8 * fq; const int b = u.pm >> 3;
        f32x4 gv[2][2];
#pragma unroll
        for (int bj = 0; bj < 2; ++bj)
#pragma unroll
            for (int n = 0; n < 2; ++n) gv[bj][n] = *(const f32x4*)(MOD + b * 6144 + 2048 + col0 + bj * 32 + n * 4);
#pragma unroll
        for (int ai = 0; ai < 2; ++ai) {
            f32x4 xq[4][2][2];
#pragma unroll
            for (int m = 0; m < 4; ++m) { const float* xr = X + (rowg + ai * 128 + m * 16 + fr) * D + col0;
#pragma unroll
                for (int bj = 0; bj < 2; ++bj) { xq[m][bj][0] = *(const f32x4*)(xr + bj * 32); xq[m][bj][1] = *(const f32x4*)(xr + bj * 32 + 4); } }
            asm volatile("" ::: "memory");
#pragma unroll
            for (int m = 0; m < 4; ++m) { const size_t rg = rowg + ai * 128 + m * 16; u32x4 wv[2];
#pragma unroll
                for (int bj = 0; bj < 2; ++bj) wv[bj] = pack8(xq[m][bj][0] + gv[bj][0] * acc[ai][bj][m][0], xq[m][bj][1] + gv[bj][1] * acc[ai][bj][m][1]);
                st_lines(X1 + rg * D + colb, D, fr, fq, wv[0], wv[1]); }
        }
    }
};

__device__ __forceinline__ float reduce4_rows(float p0, float p1, float p2, float p3) { return row_sum16(swap16_sum(swap32_sum(p0, p2), swap32_sum(p1, p3))); }
__device__ __forceinline__ float reduce8_groups(const float (&p)[8]) {
    const float t0 = swap16_sum(swap32_sum(p[0], p[4]), swap32_sum(p[2], p[6]));
    const float t1 = swap16_sum(swap32_sum(p[1], p[5]), swap32_sum(p[3], p[7]));
    int u = __builtin_bit_cast(int, 0.f);
    const float s0 = t0 + __builtin_bit_cast(float, __builtin_amdgcn_update_dpp(0, __builtin_bit_cast(int, t0), 0x128, 0xf, 0xf, false));
    const float s1 = t1 + __builtin_bit_cast(float, __builtin_amdgcn_update_dpp(0, __builtin_bit_cast(int, t1), 0x128, 0xf, 0xf, false));
    u = __builtin_amdgcn_update_dpp(u, __builtin_bit_cast(int, s0), 0xE4, 0xf, 0x3, false);
    u = __builtin_amdgcn_update_dpp(u, __builtin_bit_cast(int, s1), 0xE4, 0xf, 0xC, false);
    float v = __builtin_bit_cast(float, u);
    v += dpp_mov<0x141>(v); v += dpp_mov<0xB1>(v); v += dpp_mov<0x4E>(v);
    return v;
}
__device__ __forceinline__ float dot16(const f32x4 (&h)[4], const LAS float* wl) {
    f32x2 acc = (f32x2){0.f, 0.f};
#pragma unroll
    for (int q = 0; q < 4; ++q) { const f32x4 wv = *(const LAS f32x4*)(wl + 512 * (q >> 1) + 4 * (q & 1)); acc += (f32x2){h[q][0], h[q][1]} * (f32x2){wv[0], wv[1]}; acc += (f32x2){h[q][2], h[q][3]} * (f32x2){wv[2], wv[3]}; }
    return acc[0] + acc[1];
}
template <bool DRY>
__device__ __forceinline__ void p_norm2_router(Frame& F) {
    const int tid = F.tid, lane = F.lane;
    constexpr int WS = 1028;
    LAS float* WR = (LAS float*)F.lds;
    LAS float* LGT = WR + 36 * WS;
    LAS unsigned* hist = (LAS unsigned*)(LGT + 256 * 12);
    LAS unsigned* baseL = hist + 32;
    LAS float* rebL = (LAS float*)(baseL + 32);
    LAS unsigned char* eidL = (LAS unsigned char*)(rebL + 32);
    LAS unsigned short* rankL = (LAS unsigned short*)(eidL + 512);
    const float* rgw = F.in[19]; const float* rew = F.in[21];
    for (int i = tid; i < 1024 * 4; i += NTHR) WR[(i & 3) * WS + (i >> 2)] = rgw[i];
    for (int i = tid; i < 1024 * 32; i += NTHR) WR[(4 + (i & 31)) * WS + (i >> 5)] = rew[i];
    if (tid < 32) rebL[tid] = F.in[22][tid];
    const float rgbl = F.in[20][lane >> 4];
    const float* mod = (const float*)(F.ws + WS_MOD); const bf16_t* X1 = (const bf16_t*)(F.ws + WS_X1); bf16_t* H2 = (bf16_t*)(F.ws + WS_HX);
    int* EID = (int*)(F.ws + WS_EID); float* EW = (float*)(F.ws + WS_EW); int* SLOT = (int*)(F.ws + WS_POS); int* IDXE = (int*)(F.ws + WS_IDXE);
    for (int blk = F.vcu; blk < T / 256; blk += F.G) {
        __syncthreads();
        if (tid < 32) hist[tid] = 0u;
        __syncthreads();
        const int b = blk >> 3; const size_t row0 = (size_t)blk * 256 + F.wave * 32;
        f32x4 Av[4], Bv[4];
#pragma unroll
        for (int q = 0; q < 4; ++q) { const int c = 8 * lane + 512 * (q >> 1) + 4 * (q & 1); const f32x4 g = *(const f32x4*)(F.in[7] + c), sc = *(const f32x4*)(mod + b * 6144 + 4 * 1024 + c); Av[q] = g * (sc + 1.f); Bv[q] = *(const f32x4*)(mod + b * 6144 + 3 * 1024 + c); }
        u32x4 nxb[4][2];
#pragma unroll
        for (int p = 0; p < 4; ++p)
#pragma unroll
            for (int j = 0; j < 2; ++j) nxb[p][j] = *(const u32x4*)(X1 + (row0 + p) * D + 8 * lane + 512 * j);
        for (int r4 = 0; r4 < 32; r4 += 4)
#pragma unroll
        for (int p = 0; p < 4; ++p) {
            const int r = r4 + p, rl = F.wave * 32 + r;
            const size_t row = row0 + r; f32x4 v[4]; float ss = 0.f;
#pragma unroll
            for (int j = 0; j < 2; ++j) { float f[8]; unpack8(nxb[p][j], f); v[2 * j] = (f32x4){f[0], f[1], f[2], f[3]}; v[2 * j + 1] = (f32x4){f[4], f[5], f[6], f[7]}; }
            if (r + 4 < 32) {
#pragma unroll
                for (int j = 0; j < 2; ++j) nxb[p][j] = *(const u32x4*)(X1 + (row + 4) * D + 8 * lane + 512 * j); }
#pragma unroll
            for (int q = 0; q < 4; ++q) ss += (v[q][0] * v[q][0] + v[q][1] * v[q][1]) + (v[q][2] * v[q][2] + v[q][3] * v[q][3]);
            const float rstd = __builtin_amdgcn_rsqf(wave_sum(ss) * (1.f / D) + EPS);
#pragma unroll
            for (int q = 0; q < 4; ++q) v[q] = v[q] * rstd * Av[q] + Bv[q];
#pragma unroll
            for (int j = 0; j < 2; ++j) {
                if (MOE_FP8) { u32x2 w8; w8.x = pk4_fp8(v[2 * j][0], v[2 * j][1], v[2 * j][2], v[2 * j][3]); w8.y = pk4_fp8(v[2 * j + 1][0], v[2 * j + 1][1], v[2 * j + 1][2], v[2 * j + 1][3]);
                    *(u32x2*)((unsigned char*)H2 + row * D + 8 * lane + 512 * j) = w8; }
                else { u32x4 wv; wv.x = cvt_pk_bf16(v[2 * j][0], v[2 * j][1]); wv.y = cvt_pk_bf16(v[2 * j][2], v[2 * j][3]); wv.z = cvt_pk_bf16(v[2 * j + 1][0], v[2 * j + 1][1]); wv.w = cvt_pk_bf16(v[2 * j + 1][2], v[2 * j + 1][3]);
                    *(u32x4*)(H2 + row * D + 8 * lane + 512 * j) = wv; } }
            const float gx = reduce4_rows(dot16(v, WR + 0 * WS + 8 * lane), dot16(v, WR + 1 * WS + 8 * lane), dot16(v, WR + 2 * WS + 8 * lane), dot16(v, WR + 3 * WS + 8 * lane)) + rgbl;
            if ((lane & 15) == 0) LGT[rl * 12 + (lane >> 4)] = gx;
            const float gmx = swap32_max(swap16_max(gx));
            const unsigned long long gmask = __builtin_amdgcn_ballot_w64(gx == gmx);
            const int gsel = gmask ? (int)(__builtin_ctzll(gmask) >> 4) : 0;
            if (lane == 0) eidL[rl * 2] = (unsigned char)gsel;
            float ep[8];
            { const LAS float* wg = WR + (4 + gsel * 8) * WS + 8 * lane;
#pragma unroll
                for (int o = 0; o < 8; ++o) ep[o] = dot16(v, wg + o * WS); }
            const float ex = reduce8_groups(ep);
            if ((lane & 7) == 0) LGT[rl * 12 + 4 + (lane >> 3)] = ex;
        }
        if (lane < 32) {
            const int rl = F.wave * 32 + lane; const size_t row = row0 + lane;
            const f32x4 gl = *(const LAS f32x4*)(LGT + rl * 12), e0 = *(const LAS f32x4*)(LGT + rl * 12 + 4), e1 = *(const LAS f32x4*)(LGT + rl * 12 + 8);
            const int gsel = eidL[rl * 2];
            const float gmax = fmaxf(fmaxf(gl[0], gl[1]), fmaxf(gl[2], gl[3]));
            const float pgrp = 1.f / (expf(gl[0] - gmax) + expf(gl[1] - gmax) + expf(gl[2] - gmax) + expf(gl[3] - gmax));
            const f32x4 b0 = *(const LAS f32x4*)(rebL + gsel * 8), b1 = *(const LAS f32x4*)(rebL + gsel * 8 + 4);
            float el[8];
#pragma unroll
            for (int o = 0; o < 4; ++o) { el[o] = e0[o] + b0[o]; el[4 + o] = e1[o] + b1[o]; }
            int i0 = 0; float m0 = el[0];
#pragma unroll
            for (int o = 1; o < 8; ++o) if (el[o] > m0) { m0 = el[o]; i0 = o; }
            int i1 = -1; float m1 = -3.0e38f;
#pragma unroll
            for (int o = 0; o < 8; ++o) if (o != i0 && el[o] > m1) { m1 = el[o]; i1 = o; }
            if (i1 < 0) { i1 = (i0 + 1) & 7; m1 = el[0];
#pragma unroll
                for (int o = 1; o < 8; ++o) if (o == i1) m1 = el[o]; }
            const float e1x = expf(m1 - m0), w0 = pgrp / (1.f + e1x), w1 = pgrp * e1x / (1.f + e1x);
            const int x0 = gsel * 8 + i0, x1 = gsel * 8 + i1;
            *(u32x2*)(EID + row * 2) = (u32x2){(unsigned)x0, (unsigned)x1}; *(f32x2*)(EW + row * 2) = (f32x2){w0, w1};
            eidL[rl * 2] = (unsigned char)x0; eidL[rl * 2 + 1] = (unsigned char)x1;
            rankL[rl * 2] = (unsigned short)atomicAdd((unsigned*)&hist[x0], 1u); rankL[rl * 2 + 1] = (unsigned short)atomicAdd((unsigned*)&hist[x1], 1u);
        }
        __syncthreads();
        if (!DRY) {
        if (tid < 32) baseL[tid] = hist[tid] ? __hip_atomic_fetch_add(F.ctl + CW_CNT + tid, hist[tid], __ATOMIC_RELAXED, __HIP_MEMORY_SCOPE_AGENT) : 0u;
        __syncthreads();
        { const int e = eidL[tid]; const unsigned slot = baseL[e] + rankL[tid]; const int token = blk * 256 + (tid >> 1);
            IDXE[(size_t)e * 65536 + slot] = token; SLOT[token * 2 + (tid & 1)] = (int)slot; }
        }
    }
    __syncthreads();
}
__device__ __forceinline__ void moe_tables(Frame& F) {
    volatile LAS unsigned* M = (volatile LAS unsigned*)(F.lds + MISC_OFF);
    __syncthreads();
    if (F.tid == 0) { unsigned o = 0; for (int e = 0; e < 32; ++e) { const unsigned c = __hip_atomic_load(F.ctl + CW_CNT + e, __ATOMIC_RELAXED, __HIP_MEMORY_SCOPE_AGENT); M[64 + e] = c; M[16 + e] = o; o += (c + 255u) & ~255u; } M[48] = o; }
    __syncthreads();
}

struct SchedMoe1 {
    static constexpr bool GATHER = true;
    const char* H2; const char* W13; const int* IDXE; const volatile LAS unsigned* M; int nunits, G, c;
    __device__ __forceinline__ bool next(int i, pg8::Unit& u) const {
        const int L = i * G + c; if (L >= nunits) return false;
        const int tile = L >> 2, pn = L & 3; const unsigned base = (unsigned)tile * 256u; int e = 0;
        for (int q = 1; q < 32; ++q) e += (M[16 + q] <= base) ? 1 : 0;
        e = __builtin_amdgcn_readfirstlane(e);
        const unsigned lb = base - M[16 + e], cnt = M[64 + e];
        u.pm = tile; u.pn = pn; u.aux = e; u.A = H2; u.B = W13 + ((size_t)e * 1024 + (size_t)pn * 256) * (MOE_FP8 ? 1024 : 2048);
        const int tid = threadIdx.x; const int* ie = IDXE + (size_t)e * 65536;
#pragma unroll
        for (int k = 0; k < 2; ++k) { int R, C; pg8::stage_rc(tid * 16 + k * 8192, R, C);
            const unsigned s0 = lb + R, s1 = lb + 128 + R; const int t0 = s0 < cnt ? ie[s0] : 0, t1 = s1 < cnt ? ie[s1] : 0;
            u.va[0][k] = (unsigned)t0 * (MOE_FP8 ? 1024u : 2048u) + (unsigned)C * 2u; u.va[1][k] = (unsigned)t1 * (MOE_FP8 ? 1024u : 2048u) + (unsigned)C * 2u; }
        return true;
    }
};
struct EpiMoe1 {
    static constexpr int NISS = 8; static constexpr bool IDEM = true; static constexpr bool PERM = true;
    bf16_t* HID;
    __device__ __forceinline__ void operator()(const f32x4 (&acc)[2][2][4][2], const pg8::Unit& u, int wr, int wc, int fr, int fq) const {
        const int row0 = u.pm * 256 + wr * 64 + fr, col0 = u.pn * 128 + wc * 32 + 8 * fq;
#pragma unroll
        for (int ai = 0; ai < 2; ++ai)
#pragma unroll
            for (int m = 0; m < 4; ++m) { const size_t row = row0 + ai * 128 + m * 16; float hv[8];
#pragma unroll
                for (int n = 0; n < 2; ++n)
#pragma unroll
                    for (int e = 0; e < 4; ++e) { const float a = acc[ai][0][m][n][e] * (MOE_FP8 ? 1.f / SC_W13 : 1.f), bq = acc[ai][1][m][n][e] * (MOE_FP8 ? (MOE2_FP8 ? SC_HID : 1.f) / SC_W13 : 1.f); hv[4 * n + e] = a * sigmoidf_(a) * bq; }
                if (MOE2_FP8) { u32x2 w8; w8.x = pk4_fp8(hv[0], hv[1], hv[2], hv[3]); w8.y = pk4_fp8(hv[4], hv[5], hv[6], hv[7]); *(u32x2*)((unsigned char*)HID + row * 512 + col0) = w8; }
                else { u32x4 w; w.x = cvt_pk_bf16(hv[0], hv[1]); w.y = cvt_pk_bf16(hv[2], hv[3]); w.z = cvt_pk_bf16(hv[4], hv[5]); w.w = cvt_pk_bf16(hv[6], hv[7]);
                    *(u32x4*)(HID + row * 512 + col0) = w; } }
    }
};
struct SchedMoe2 {
    static constexpr bool GATHER = false;
    const char* HID; const char* W2; const volatile LAS unsigned* M; int nunits, G, c;
    __device__ __forceinline__ bool next(int i, pg8::Unit& u) const {
        const int L = i * G + c; if (L >= nunits) return false;
        const int tile = L >> 2, pn = L & 3; const unsigned base = (unsigned)tile * 256u; int e = 0;
        for (int q = 1; q < 32; ++q) e += (M[16 + q] <= base) ? 1 : 0;
        e = __builtin_amdgcn_readfirstlane(e);
        u.pm = tile; u.pn = pn; u.aux = e; u.A = HID + (size_t)tile * 256 * (MOE2_FP8 ? 512 : 1024); u.B = W2 + ((size_t)e * 1024 + (size_t)pn * 256) * (MOE2_FP8 ? 512 : 1024);
        pg8::contig_va(u.va, MOE2_FP8 ? 512 : 1024); return true;
    }
};
struct EpiMoe2 {
    static constexpr int NISS = 16; static constexpr bool IDEM = true; static constexpr bool PERM = true;
    bf16_t* Y;
    __device__ __forceinline__ void operator()(const f32x4 (&acc)[2][2][4][2], const pg8::Unit& u, int wr, int wc, int fr, int fq) const {
        if (YOUT_FP8) {
            unsigned char* blk8 = (unsigned char*)Y + ((size_t)u.pm * 256 + wr * 64 + fr) * 1024 + u.pn * 256 + wc * 64 + 8 * fq; constexpr float sy = MOE2_FP8 ? 64.f / (SC_HID * SC_W2) : 64.f;
#pragma unroll
            for (int ai = 0; ai < 2; ++ai)
#pragma unroll
                for (int m = 0; m < 4; ++m)
#pragma unroll
                    for (int bj = 0; bj < 2; ++bj) { f32x4 v0 = acc[ai][bj][m][0], v1 = acc[ai][bj][m][1]; if constexpr (sy != 1.f) { v0 = v0 * sy; v1 = v1 * sy; }
                        *(u32x2*)(blk8 + (size_t)(ai * 128 + m * 16) * 1024 + 32 * bj) = (u32x2){pk4_fp8(v0[0], v0[1], v0[2], v0[3]), pk4_fp8(v1[0], v1[1], v1[2], v1[3])}; }
            return;
        }
        bf16_t* blk = Y + ((size_t)u.pm * 256 + wr * 64) * 1024 + u.pn * 256 + wc * 64;
#pragma unroll
        for (int ai = 0; ai < 2; ++ai)
#pragma unroll
            for (int m = 0; m < 4; ++m) st_lines(blk + (size_t)(ai * 128 + m * 16) * 1024, 1024, fr, fq, pack8(acc[ai][0][m][0], acc[ai][0][m][1]), pack8(acc[ai][1][m][0], acc[ai][1][m][1]));
    }
};

__device__ __forceinline__ void p_final(Frame& F) {
    const int gw = F.vcu * NWAVES + F.wave, NGW = F.G * NWAVES, lane = F.lane;
    const float* mod = (const float*)(F.ws + WS_MOD); const bf16_t* Y = (const bf16_t*)(F.ws + WS_Y); const bf16_t* X1 = (const bf16_t*)(F.ws + WS_X1);
    const int* EID = (const int*)(F.ws + WS_EID); const int* SLOT = (const int*)(F.ws + WS_POS); const float* EW = (const float*)(F.ws + WS_EW);
    const volatile LAS unsigned* M = (const volatile LAS unsigned*)(F.lds + MISC_OFF);
    for (int w = gw; w < 2048; w += NGW) {
        const int b = w >> 6; f32x4 g2[4], fg[4];
#pragma unroll
        for (int j = 0; j < 2; ++j)
#pragma unroll
            for (int hf = 0; hf < 2; ++hf) { const int c = 8 * lane + 512 * j + 4 * hf; g2[2 * j + hf] = *(const f32x4*)(mod + b * 6144 + 5 * 1024 + c); fg[2 * j + hf] = *(const f32x4*)(F.in[26] + c); }
        const size_t prow = (size_t)w * 32 + (lane & 31);
        const int p0v = (int)M[16 + EID[prow * 2]] + SLOT[prow * 2], p1v = (int)M[16 + EID[prow * 2 + 1]] + SLOT[prow * 2 + 1]; const float ysc = YOUT_FP8 ? 1.f / 64.f : (MOE2_FP8 ? 1.f / (SC_HID * SC_W2) : 1.f); const float w0v = EW[prow * 2] * ysc, w1v = EW[prow * 2 + 1] * ysc;
        u32x4 nxb[4][2]; u32x4 ny0b[4][2], ny1b[4][2];
#define P12_LOAD(pp, rr) do { const int _p0 = __builtin_amdgcn_readlane(p0v, (rr)), _p1 = __builtin_amdgcn_readlane(p1v, (rr)); const bf16_t* _xr = X1 + ((size_t)w * 32 + (rr)) * D; \
            _Pragma("unroll") for (int j = 0; j < 2; ++j) { const int c = 8 * lane + 512 * j; nxb[pp][j] = *(const u32x4*)(_xr + c); \
                if (YOUT_FP8) { const u32x2 _a = *(const u32x2*)((const unsigned char*)Y + (size_t)_p0 * 1024 + c), _b = *(const u32x2*)((const unsigned char*)Y + (size_t)_p1 * 1024 + c); ny0b[pp][j].x = _a.x; ny0b[pp][j].y = _a.y; ny1b[pp][j].x = _b.x; ny1b[pp][j].y = _b.y; } \
                else { ny0b[pp][j] = *(const u32x4*)(Y + (size_t)_p0 * 1024 + c); ny1b[pp][j] = *(const u32x4*)(Y + (size_t)_p1 * 1024 + c); } } } while (0)
        P12_LOAD(0, 0); P12_LOAD(1, 1); P12_LOAD(2, 2); P12_LOAD(3, 3);
        for (int r4 = 0; r4 < 32; r4 += 4)
#pragma unroll
        for (int p = 0; p < 4; ++p) {
            const int r = r4 + p;
            u32x4 xq[2], y0[2], y1[2];
#pragma unroll
            for (int j = 0; j < 2; ++j) { xq[j] = nxb[p][j]; y0[j] = ny0b[p][j]; y1[j] = ny1b[p][j]; }
            const float w0 = __builtin_bit_cast(float, __builtin_amdgcn_readlane(__builtin_bit_cast(int, w0v), r)), w1 = __builtin_bit_cast(float, __builtin_amdgcn_readlane(__builtin_bit_cast(int, w1v), r));
            if (r + 4 < 32) P12_LOAD(p, r + 4);
            float ss = 0.f; f32x4 v[4];
#pragma unroll
            for (int j = 0; j < 2; ++j) { float a[8], bq[8], xf[8]; unpack8(xq[j], xf);
                if (YOUT_FP8) { float t4[4]; unpack4_fp8(y0[j].x, t4); a[0] = t4[0]; a[1] = t4[1]; a[2] = t4[2]; a[3] = t4[3]; unpack4_fp8(y0[j].y, t4); a[4] = t4[0]; a[5] = t4[1]; a[6] = t4[2]; a[7] = t4[3];
                    unpack4_fp8(y1[j].x, t4); bq[0] = t4[0]; bq[1] = t4[1]; bq[2] = t4[2]; bq[3] = t4[3]; unpack4_fp8(y1[j].y, t4); bq[4] = t4[0]; bq[5] = t4[1]; bq[6] = t4[2]; bq[7] = t4[3]; }
                else { unpack8(y0[j], a); unpack8(y1[j], bq); }
#pragma unroll
                for (int hf = 0; hf < 2; ++hf) { f32x4 t;
#pragma unroll
                    for (int e = 0; e < 4; ++e) t[e] = xf[4 * hf + e] + g2[2 * j + hf][e] * (w0 * a[4 * hf + e] + w1 * bq[4 * hf + e]);
                    v[2 * j + hf] = t; ss += (t[0] * t[0] + t[1] * t[1]) + (t[2] * t[2] + t[3] * t[3]); } }
            const float rstd = __builtin_amdgcn_rsqf(wave_sum(ss) * (1.f / D) + EPS);
            float* xo = F.out + ((size_t)w * 32 + r) * D;
#pragma unroll
            for (int j = 0; j < 2; ++j) { const int c = 8 * lane + 512 * j; *(f32x4*)(xo + c) = v[2 * j] * rstd * fg[2 * j]; *(f32x4*)(xo + c + 4) = v[2 * j + 1] * rstd * fg[2 * j + 1]; }
        }
#undef P12_LOAD
    }
}

__global__ void __launch_bounds__(NTHR, 2) fwd_kernel(Args args) {
    extern __shared__ __attribute__((aligned(16))) unsigned char lds_raw[];
    Frame F;
    F.lds = (LAS unsigned char*)lds_raw;
    F.tid = threadIdx.x; F.lane = F.tid & 63; F.wave = __builtin_amdgcn_readfirstlane(F.tid >> 6);
    F.G = gridDim.x; { const int bx = blockIdx.x; F.vcu = (F.G % 8 == 0) ? (bx % 8) * (F.G / 8) + bx / 8 : bx; }
    F.ws = args.ws; F.out = args.out; F.ctl = (unsigned*)(args.ws + WS_CTL);
#pragma unroll
    for (int i = 0; i < 27; ++i) F.in[i] = args.in[i];
    volatile LAS unsigned* MISC = (volatile LAS unsigned*)(F.lds + MISC_OFF);
    if (F.tid < 128) MISC[F.tid] = 0u;
    __syncthreads();
    XcdBarrier bar; bar.bar = F.ctl + CW_BAR; bar.x = 0; bar.st = nullptr;
    if (N_LAUNCHES != PER_PHASE) bar = xcd_barrier_post(F.ctl + CW_BAR, MISC + 8);
#define GRID_BAR() do { if (N_LAUNCHES != PER_PHASE) xcd_barrier(bar); } while (0)
#ifdef PROBE_A
    unsigned long long t_a0 = 0, t_a1 = 0, t_b0 = 0, t_b1 = 0;
#define STAMP(k) do { const unsigned long long _t = wall_clock64(); if ((k) == PROBE_A) t_a0 = _t; if ((k) == PROBE_A + 1) t_a1 = _t; if ((k) == PROBE_B) t_b0 = _t; if ((k) == PROBE_B + 1) t_b1 = _t; } while (0)
#else
#define STAMP(k) do {} while (0)
#endif
    const int lo = args.ph_lo, hi = args.ph_hi;
#define IN(k) (lo <= (k) && (k) < hi)
#define BOTH(k) (IN(k) && IN((k) + 1))
#define REP(k) for (int _r = 0; _r < ((k) == PROBE_REP ? 2 : 1); ++_r)
    unsigned char* ws = F.ws;

    STAMP(0);
    if (IN(0)) { REP(0) { p_adaln(F); for (int bq = (int)blockIdx.x - 192; bq >= 0 && bq < 32; bq += 64) p_wpeff_block(F, bq); if (F.G < 224 && blockIdx.x == 0) for (int bq = 0; bq < 32; ++bq) p_wpeff_block(F, bq); p_convert(F, true, CONV_OVERLAP == 0); } if (BOTH(0)) GRID_BAR(); }
    STAMP(1);
    if (IN(1)) { REP(1) p_norm1(F); if (BOTH(1)) GRID_BAR(); }
    STAMP(2);
    if (IN(2)) {
        SchedG1 S{(const char*)(ws + WS_HX), (const char*)(ws + WS_WIN), F.G, (int)blockIdx.x}; EpiG1 E{ws};
        const bool par = ((blockIdx.x >> 3) & 1) != 0;
        if (CONV_OVERLAP && par) { if (MOE_FP8 && MOE2_FP8) p_convert_moe8(F); else p_convert(F, false, true); __syncthreads(); }
        REP(2) pg8::gemm_phase<EpiG1, SchedG1, true>(F.lds, 1024, S, E);
        if (CONV_OVERLAP && !par) { __syncthreads(); if (MOE_FP8 && MOE2_FP8) p_convert_moe8(F); else p_convert(F, false, true); }
        if (BOTH(2)) GRID_BAR();
    }
    STAMP(3);
    if (IN(3)) {
        const bool par = ((blockIdx.x >> 3) & 1) != 0;
        if (POOL_OVERLAP && par) p_prep(F, false, true);
        REP(3) p_gla_chunk(F);
        if (POOL_OVERLAP && !par) p_prep(F, false, true);
        if (BOTH(3)) GRID_BAR();
    }
    STAMP(4);
    if (IN(4) && !(OG_OVERLAP && POOL_OVERLAP)) { REP(4) p_prep(F, OG_OVERLAP == 0, POOL_OVERLAP == 0); if (BOTH(4)) GRID_BAR(); }
    STAMP(5);
    if (IN(5)) {
        SchedSq S{(const char*)(ws + WS_PO), (const char*)(ws + WS_WP), 1024u, 512, F.G, (int)blockIdx.x}; EpiPool E{(const bf16_t*)(ws + WS_PGATES), (bf16_t*)(ws + WS_Z)};
        if (OG_OVERLAP && ((blockIdx.x >> 3) & 1)) p_prep(F, true, false);
        REP(5) pg8::gemm_phase<EpiPool, SchedSq, true>(F.lds, 512, S, E);
        if (OG_OVERLAP && !((blockIdx.x >> 3) & 1)) p_prep(F, true, false);
        asm volatile("s_waitcnt vmcnt(0)" ::: "memory"); __syncthreads();
        if (OG_OVERLAP && BOTH(5)) GRID_BAR();
    }
    STAMP(6);
    if (IN(6)) {
        SchedSq S{(const char*)(ws + WS_HX), (const char*)(ws + WS_WGLA), 2048u, 1024, F.G, (int)blockIdx.x}; EpiGla E{(const bf16_t*)(ws + WS_PGATES), (bf16_t*)(ws + WS_Z)};
        pg8::gemm_phase<EpiGla, SchedSq, true>(F.lds, 1024, S, E);
        if (BOTH(6)) GRID_BAR();
    }
    STAMP(7);
    if (IN(7)) {
        SchedSq S{(const char*)(ws + WS_Z), (const char*)(ws + WS_WO), 2048u, 1024, F.G, (int)blockIdx.x}; EpiWo E{F.in[0], (const float*)(ws + WS_MOD), (bf16_t*)(ws + WS_X1)};
        REP(7) pg8::gemm_phase<EpiWo, SchedSq, true>(F.lds, 1024, S, E);
        if (BOTH(7)) GRID_BAR();
    }
    STAMP(8);
    if (IN(8)) { if (PROBE_REP == 8) p_norm2_router<true>(F); p_norm2_router<false>(F); if (BOTH(8)) GRID_BAR(); }
    STAMP(9);
    if (IN(9)) {
        moe_tables(F);
        const volatile LAS unsigned* M = (const volatile LAS unsigned*)(F.lds + MISC_OFF); const int nt = (int)(M[48] >> 8);
        SchedMoe1 S{(const char*)(ws + WS_HX), (const char*)(ws + WS_W13), (const int*)(ws + WS_IDXE), M, nt * 4, F.G, F.vcu}; EpiMoe1 E{(bf16_t*)(ws + WS_HID)};
        REP(9) pg8::gemm_phase<EpiMoe1, SchedMoe1, true, MOE_FP8 != 0>(F.lds, MOE_FP8 ? 512 : 1024, S, E);
        if (BOTH(9)) GRID_BAR();
    }
    STAMP(10);
    if (IN(10)) {
        moe_tables(F);
        const volatile LAS unsigned* M = (const volatile LAS unsigned*)(F.lds + MISC_OFF); const int nt = (int)(M[48] >> 8);
        SchedMoe2 S{(const char*)(ws + WS_HID), (const char*)(ws + WS_W2), M, nt * 4, F.G, F.vcu}; EpiMoe2 E{(bf16_t*)(ws + WS_Y)};
        REP(10) pg8::gemm_phase<EpiMoe2, SchedMoe2, true, MOE2_FP8 != 0>(F.lds, MOE2_FP8 ? 256 : 512, S, E);
        if (BOTH(10)) GRID_BAR();
    }
    STAMP(11);
    if (IN(11)) { moe_tables(F); REP(11) p_final(F); }
    STAMP(12);
#ifdef PROBE_A
    {
        if (blockIdx.x == 0 && F.tid == 0) { float* pr = (float*)(F.ws + WS_TILEE + 4096); pr[0] = (float)(t_a1 - t_a0) * 0.01f; pr[1] = (float)(t_b1 - t_b0) * 0.01f; }
        GRID_BAR();
        const float* pr = (const float*)(F.ws + WS_TILEE + 4096); const float va = sqrtf(__hip_atomic_load(pr, __ATOMIC_RELAXED, __HIP_MEMORY_SCOPE_AGENT)), vb = __hip_atomic_load(pr + 1, __ATOMIC_RELAXED, __HIP_MEMORY_SCOPE_AGENT);
        for (size_t i = (size_t)blockIdx.x * NTHR + F.tid; i < (size_t)T * D; i += (size_t)F.G * NTHR) F.out[i] = (i == 0) ? vb : va;
    }
#endif
#undef IN
#undef BOTH
#undef GRID_BAR
}

extern "C" void kernel_launch(void* const* d_in, const int* in_sizes, int n_in, void* d_out, int out_size, void* d_ws, size_t ws_size, hipStream_t stream) {
    static int grid = 0;
    if (grid == 0) {
        if (n_in != 27 || in_sizes[0] != T * D || out_size != T * D || ws_size < WS_END) { fprintf(stderr, "kernel_launch: unexpected shapes: n_in %d in0 %d out %d ws %zu (need %zu); nothing launched\n", n_in, n_in > 0 ? in_sizes[0] : -1, out_size, ws_size, (size_t)WS_END); grid = -1; return; }
        int dev = 0, cus = 0, per_cu = 0;
        if (hipGetDevice(&dev) != hipSuccess || hipDeviceGetAttribute(&cus, hipDeviceAttributeMultiprocessorCount, dev) != hipSuccess) { grid = -1; return; }
        if (hipFuncSetAttribute((const void*)fwd_kernel, hipFuncAttributeMaxDynamicSharedMemorySize, LDS_BYTES) != hipSuccess) { fprintf(stderr, "kernel_launch: hipFuncSetAttribute failed\n"); grid = -1; return; }
        if (hipOccupancyMaxActiveBlocksPerMultiprocessor(&per_cu, (const void*)fwd_kernel, NTHR, LDS_BYTES) != hipSuccess || per_cu < 1) fprintf(stderr, "kernel_launch: occupancy query reports %d\n", per_cu);
        (void)hipGetLastError();
        grid = cus;
    }
    if (grid < 0) return;
    if (hipMemsetAsync((char*)d_ws + WS_CTL, 0, CTL_ZERO_BYTES, stream) != hipSuccess) return;
    Args a{};
    for (int i = 0; i < 27; ++i) a.in[i] = (const float*)d_in[i];
    a.out = (float*)d_out; a.ws = (unsigned char*)d_ws;
    if (N_LAUNCHES == 1) { a.ph_lo = 0; a.ph_hi = PER_PHASE; hipLaunchKernelGGL(fwd_kernel, dim3(grid), dim3(NTHR), LDS_BYTES, stream, a); }
    else for (int p = 0; p < PER_PHASE; ++p) { a.ph_lo = p; a.ph_hi = p + 1; hipLaunchKernelGGL(fwd_kernel, dim3(grid), dim3(NTHR), LDS_BYTES, stream, a); }
}
```

```cpp
#include <hip/hip_runtime.h>
#include <cstdio>
#include <cstdint>

#define PROBE_REP -1
#ifndef MK_N_LAUNCHES
#define MK_N_LAUNCHES 1
#endif

#ifndef MOE_FP8
#define MOE_FP8 1
#endif
#ifndef YOUT_FP8
#define YOUT_FP8 1
#endif
#ifndef OG_OVERLAP
#define OG_OVERLAP 1
#define POOL_OVERLAP 1
#define CONV_OVERLAP 1
#endif
#ifndef MOE2_FP8
#define MOE2_FP8 1
#endif
#define LAS __attribute__((address_space(3)))
#define GAS __attribute__((address_space(1)))
typedef unsigned short bf16_t;
typedef short bf16x8 __attribute__((ext_vector_type(8)));
typedef float f32x4 __attribute__((ext_vector_type(4)));
typedef float f32x2 __attribute__((ext_vector_type(2)));
typedef unsigned u32x4 __attribute__((ext_vector_type(4)));
typedef unsigned u32x2 __attribute__((ext_vector_type(2)));

constexpr int D = 1024, BATCH = 32, SEQ = 2048, T = BATCH * SEQ, CTXL = 256, TC = BATCH * CTXL;
constexpr int DIN = 5664, NPAD = 5888;
constexpr int NE = 32, DE = 512;
constexpr int MAXTILES = 544, NPMAX = MAXTILES * 256;
constexpr float EPS = 1e-6f;
constexpr float SC_W13 = 64.f, SC_W2 = 8.f, SC_HID = 8.f;
constexpr int NWAVES = 8, NTHR = 512;
constexpr int PER_PHASE = 12;
constexpr int N_LAUNCHES = MK_N_LAUNCHES;

constexpr size_t MiB = 1u << 20;
constexpr size_t WS_CTL = 0, CTL_ZERO_BYTES = 32768;
constexpr size_t WS_MOD = 1 * MiB;
constexpr size_t WS_EID = 2 * MiB;
constexpr size_t WS_EW = WS_EID + 512 * 1024;
constexpr size_t WS_POS = 3 * MiB;
constexpr size_t WS_IDX = WS_POS + 512 * 1024;
constexpr size_t WS_TILEE = 4 * MiB + 512 * 1024;
constexpr size_t WS_LR = 5 * MiB;
constexpr size_t WS_WIN = 14 * MiB;
constexpr size_t WS_WP = 26 * MiB;
constexpr size_t WS_WGLA = 27 * MiB;
constexpr size_t WS_WO = 29 * MiB;
constexpr size_t WS_W13 = 32 * MiB;
constexpr size_t WS_W2 = 96 * MiB;
constexpr size_t WS_HX = 128 * MiB;
constexpr size_t WS_PU = 272 * MiB;
constexpr size_t WS_PQKV = 336 * MiB;
constexpr size_t WS_PO = 272 * MiB;
constexpr size_t WS_Z = 400 * MiB;
constexpr size_t WS_HID = 272 * MiB;
constexpr size_t WS_PG = 592 * MiB;
constexpr size_t WS_PGATES = 720 * MiB;
constexpr size_t WS_Y = 592 * MiB;
constexpr size_t WS_PKVC = 976 * MiB;
constexpr size_t WS_X1 = 864 * MiB;
constexpr size_t WS_IDXE = 5 * MiB;
constexpr size_t WS_END = 1000 * MiB;
static_assert(WS_HID + (size_t)NPMAX * 512 * 2 <= WS_PG && WS_Y + (size_t)NPMAX * 1024 * 2 <= WS_PKVC, "ws map");
constexpr int CW_CNT = 64;
constexpr int CW_CUR = 128;
constexpr int CW_NT = 192;
constexpr int CW_BAR = 4096;

constexpr int LDS_BYTES = 163840;
constexpr int MISC_OFF = LDS_BYTES - 512;

__device__ __forceinline__ unsigned cvt_pk_bf16(float lo, float hi) { unsigned r; asm volatile("v_cvt_pk_bf16_f32 %0, %1, %2" : "=v"(r) : "v"(lo), "v"(hi)); return r; }
__device__ __forceinline__ float clamp_e4m3(float x) { return __builtin_amdgcn_fmed3f(x, -448.f, 448.f); }
__device__ __forceinline__ unsigned pk4_fp8(float a, float b, float c, float d) { int p = __builtin_amdgcn_cvt_pk_fp8_f32(clamp_e4m3(a), clamp_e4m3(b), 0, false); p = __builtin_amdgcn_cvt_pk_fp8_f32(clamp_e4m3(c), clamp_e4m3(d), p, true); return (unsigned)p; }
__device__ __forceinline__ void unpack4_fp8(unsigned w, float (&f)[4]) { const f32x2 lo = __builtin_amdgcn_cvt_pk_f32_fp8((int)w, false), hi = __builtin_amdgcn_cvt_pk_f32_fp8((int)w, true); f[0] = lo[0]; f[1] = lo[1]; f[2] = hi[0]; f[3] = hi[1]; }
__device__ __forceinline__ float bf_lo(unsigned w) { return __uint_as_float(w << 16); }
__device__ __forceinline__ float bf_hi(unsigned w) { return __uint_as_float(w & 0xffff0000u); }
__device__ __forceinline__ float bf2f(bf16_t h) { return __uint_as_float(((unsigned)h) << 16); }
template <int CTRL> __device__ __forceinline__ float dpp_mov(float v) { return __builtin_bit_cast(float, __builtin_amdgcn_update_dpp(0, __builtin_bit_cast(int, v), CTRL, 0xf, 0xf, false)); }
__device__ __forceinline__ float row_sum16(float v) { v += dpp_mov<0xB1>(v); v += dpp_mov<0x4E>(v); v += dpp_mov<0x124>(v); v += dpp_mov<0x128>(v); return v; }
__device__ __forceinline__ float rlane(float v, int l) { return __builtin_bit_cast(float, __builtin_amdgcn_readlane(__builtin_bit_cast(int, v), l)); }
__device__ __forceinline__ float wave_sum(float v) { v = row_sum16(v); return (rlane(v, 0) + rlane(v, 16)) + (rlane(v, 32) + rlane(v, 48)); }
__device__ __forceinline__ float half_sum(float v, int lane) { v = row_sum16(v); const float lo = rlane(v, 0) + rlane(v, 16), hi = rlane(v, 32) + rlane(v, 48); return lane < 32 ? lo : hi; }
__device__ __forceinline__ float xchg32(float v, int lane) { const auto r = __builtin_amdgcn_permlane32_swap(__builtin_bit_cast(unsigned, v), __builtin_bit_cast(unsigned, v), false, false); return __builtin_bit_cast(float, lane < 32 ? r[1] : r[0]); }
__device__ __forceinline__ void pswap32(float& a, float& b) { asm volatile("s_nop 1\n\tv_permlane32_swap_b32 %0, %1" : "+v"(a), "+v"(b)); }
__device__ __forceinline__ void pswap16(float& a, float& b) { asm volatile("s_nop 1\n\tv_permlane16_swap_b32 %0, %1" : "+v"(a), "+v"(b)); }
__device__ __forceinline__ float swap32_sum(float a, float b) { pswap32(a, b); return a + b; }
__device__ __forceinline__ float swap16_sum(float a, float b) { pswap16(a, b); return a + b; }
__device__ __forceinline__ float swap32_max(float a) { float b = a; pswap32(a, b); return fmaxf(a, b); }
__device__ __forceinline__ float swap16_max(float a) { float b = a; pswap16(a, b); return fmaxf(a, b); }
__device__ __forceinline__ float sigmoidf_(float x) { return __builtin_amdgcn_rcpf(1.f + __expf(-x)); }
#define LDS_WAIT() asm volatile("s_waitcnt lgkmcnt(0)" ::: "memory")
__device__ __forceinline__ void unpack8(const u32x4 w, float (&f)[8]) { f[0] = bf_lo(w.x); f[1] = bf_hi(w.x); f[2] = bf_lo(w.y); f[3] = bf_hi(w.y); f[4] = bf_lo(w.z); f[5] = bf_hi(w.z); f[6] = bf_lo(w.w); f[7] = bf_hi(w.w); }

#define XB_TMO      128
#define XB_XCNT(j)  (256  + 64 * (j))
#define XB_XSUB(j)  (1280 + 64 * (j))
#define XB_XGEN(j)  (2304 + 64 * (j))
#define XB_TOP      3328
#define XB_TOPGEN   3392
#define XCD_BAR_WORDS 3456
#define XB_SPIN_CAP (1u << 18)
__device__ __forceinline__ unsigned xb_ld(unsigned* p)              { return __hip_atomic_load(p, __ATOMIC_RELAXED, __HIP_MEMORY_SCOPE_AGENT); }
__device__ __forceinline__ unsigned xb_add(unsigned* p, unsigned v) { return __hip_atomic_fetch_add(p, v, __ATOMIC_RELAXED, __HIP_MEMORY_SCOPE_AGENT); }
__device__ __forceinline__ unsigned xb_xcc_id() { return (unsigned)__builtin_amdgcn_s_getreg((3 << 11) | 20) & 0xFu; }
#define XB_SPIN(cond, bar) do { unsigned _sp = 0; while (cond) { __builtin_amdgcn_s_sleep(1); \
    if ((++_sp & 255u) == 0u) { if (xb_ld(&(bar)[XB_TMO])) break; if (_sp > XB_SPIN_CAP) { atomicAdd(&(bar)[XB_TMO], 1u); break; } } } } while (0)
struct XcdBarrier { unsigned* bar; unsigned x; volatile LAS unsigned* st; };
__device__ __forceinline__ XcdBarrier xcd_barrier_post(unsigned* bar, volatile LAS unsigned* st) {
    XcdBarrier b; b.bar = bar; b.x = xb_xcc_id(); b.st = st;
    if (threadIdx.x == 0) (void)xb_add(&bar[XB_XCNT(b.x)], 1u);
    return b;
}
__device__ __forceinline__ void xcd_barrier_complete(unsigned* bar, unsigned x, unsigned& nloc, unsigned& nx) {
    const unsigned G = gridDim.x * gridDim.y * gridDim.z;
    unsigned sum, cnt, mine, sp = 0u;
    for (;;) {
        sum = 0u; cnt = 0u; mine = 0u;
#pragma unroll
        for (unsigned j = 0; j < 16; ++j) { const unsigned c = xb_ld(&bar[XB_XCNT(j)]); sum += c; cnt += (c > 0u) ? 1u : 0u; mine = (j == x) ? c : mine; }
        if (sum == G) break;
        __builtin_amdgcn_s_sleep(1);
        if ((++sp & 255u) == 0u) { if (xb_ld(&bar[XB_TMO])) break; if (sp > XB_SPIN_CAP) { atomicAdd(&bar[XB_TMO], 1u); break; } }
    }
    nloc = mine > 0u ? mine : 1u; nx = cnt > 0u ? cnt : 1u;
}
__device__ __forceinline__ void xcd_barrier(const XcdBarrier& b) {
    asm volatile("s_waitcnt vmcnt(0)" ::: "memory");
    __syncthreads();
    if (threadIdx.x == 0) {
        unsigned* bar = b.bar;
        __builtin_amdgcn_s_waitcnt(0);
        unsigned nloc = b.st[0], nx = b.st[1];
        if (nloc == 0u) { xcd_barrier_complete(bar, b.x, nloc, nx); b.st[0] = nloc; b.st[1] = nx; }
        const unsigned old = xb_add(&bar[XB_XSUB(b.x)], 1u);
        const unsigned gen = old / nloc;
        if (old + 1u == (gen + 1u) * nloc) {
            __builtin_amdgcn_fence(__ATOMIC_RELEASE, "agent");
            asm volatile("s_waitcnt vmcnt(0)" ::: "memory");
            const unsigned og = xb_add(&bar[XB_TOP], 1u);
            const unsigned tg = og / nx;
            if (og + 1u == (tg + 1u) * nx) xb_add(&bar[XB_TOPGEN], 1u);
            else XB_SPIN(xb_ld(&bar[XB_TOPGEN]) == tg, bar);
            __builtin_amdgcn_fence(__ATOMIC_ACQUIRE, "agent");
            xb_add(&bar[XB_XGEN(b.x)], 1u);
            asm volatile("s_waitcnt vmcnt(0)" ::: "memory");
        } else {
            XB_SPIN(xb_ld(&bar[XB_XGEN(b.x)]) == gen, bar);
            __builtin_amdgcn_fence(__ATOMIC_ACQUIRE, "agent");
            asm volatile("s_waitcnt vmcnt(0)" ::: "memory");
        }
    }
    __syncthreads();
}

namespace pg8 {
constexpr int BM = 256, BK = 64, HALF = 128, HTB = HALF * BK * 2, STAGE_BYTES = 8 * HTB, NXCD = 8, WGM = 8;
__host__ __device__ __forceinline__ int lds_byte(int r, int c) { const int st = (r >> 4) * 2 + (c >> 5), rr = r & 15, cc = c & 31, ob = rr * 64 + cc * 2; return st * 1024 + (ob ^ (((ob >> 9) & 1) << 5)); }
__host__ __device__ __forceinline__ void stage_rc(int b, int& R, int& C) { const int st = b / 1024, sb = b % 1024, swz = sb ^ (((sb >> 9) & 1) << 5); R = (st >> 1) * 16 + swz / 64; C = (st & 1) * 32 + (swz % 64) / 2; }
__host__ __device__ __forceinline__ int perm32(int rho) { const int n = rho >> 4, i = rho & 15; return 8 * (i >> 2) + 4 * n + (i & 3); }

typedef int v8i_t __attribute__((ext_vector_type(8)));
typedef int v4i_t __attribute__((ext_vector_type(4)));
__device__ __forceinline__ v8i_t mk8(const bf16x8 lo, const bf16x8 hi) { return __builtin_shufflevector(__builtin_bit_cast(v4i_t, lo), __builtin_bit_cast(v4i_t, hi), 0, 1, 2, 3, 4, 5, 6, 7); }
struct Unit { const char* A; const char* B; unsigned va[2][2]; int pm, pn, aux; };

__device__ __forceinline__ void static_tile(int L, int nM, int nN, int& pm, int& pn) {
    const int nwg = nM * nN; int wgid = L; { const int q = nwg / NXCD, r = nwg % NXCD, xcd = wgid % NXCD, off = wgid / NXCD; wgid = (xcd < r ? xcd * (q + 1) : r * (q + 1) + (xcd - r) * q) + off; }
    const int nig = WGM * nN, gid = wgid / nig, fm = gid * WGM, gsz = (nM - fm) < WGM ? (nM - fm) : WGM;
    pm = fm + ((wgid % nig) % gsz); pn = (wgid % nig) / gsz;
}

template <class Epi, class Sched, bool ALIGN_EPI = true, bool FP8 = false>
__device__ __forceinline__ void gemm_phase(LAS unsigned char* lds, const int K, const Sched& S, const Epi& E) {
    const int tid = threadIdx.x, wid = __builtin_amdgcn_readfirstlane(tid >> 6), lane = tid & 63, wr = wid >> 2, wc = wid & 3, fr = lane & 15, fq = lane >> 4;
    const int nt = K / BK;
    unsigned vb[2];
#pragma unroll
    for (int i = 0; i < 2; ++i) { int R, C; stage_rc(tid * 16 + i * 8192, R, C); const int Rb = Epi::PERM ? ((R >> 5) * 64 + perm32(R & 31)) : R; vb[i] = (unsigned)(Rb * K + C) * 2u; }
    const size_t kstep = (size_t)(BK * 2);
    const size_t hstep = Epi::PERM ? (size_t)32 * K * 2 : (size_t)HALF * K * 2;
    const unsigned ldsw = (unsigned)wid * 1024u;
    int aoffk[2], boffk[2];
#pragma unroll
    for (int k = 0; k < 2; ++k) { aoffk[k] = FP8 ? lds_byte(wr * 64 + fr, fq * 16 + 8 * k) : lds_byte(wr * 64 + fr, fq * 8) + k * 1024; boffk[k] = FP8 ? lds_byte(wc * 32 + fr, fq * 16 + 8 * k) : lds_byte(wc * 32 + fr, fq * 8) + k * 1024; }
#define PG8_SA(b, h) (((b) * 2 + (h)) * HTB)
#define PG8_SB(b, h) ((4 + (b) * 2 + (h)) * HTB)
#define PG8_STAGEA(bufoff, gbase, VA, h) do { _Pragma("unroll") for (int _i = 0; _i < 2; ++_i) \
        __builtin_amdgcn_global_load_lds((const unsigned*)((const char*)(gbase) + (VA)[h][_i]), (LAS unsigned*)(lds + (bufoff) + ldsw + _i * 8192), 16, 0, 0); } while (0)
#define PG8_STAGEB(bufoff, gbase) do { _Pragma("unroll") for (int _i = 0; _i < 2; ++_i) \
        __builtin_amdgcn_global_load_lds((const unsigned*)((const char*)(gbase) + vb[_i]), (LAS unsigned*)(lds + (bufoff) + ldsw + _i * 8192), 16, 0, 0); } while (0)
#define PG8_LDA(dst, b, h) do { _Pragma("unroll") for (int m = 0; m < 4; ++m) { if constexpr (FP8) { const v4i_t _lo = *(const LAS v4i_t*)(lds + PG8_SA(b, h) + aoffk[0] + m * 2048), _hi = *(const LAS v4i_t*)(lds + PG8_SA(b, h) + aoffk[1] + m * 2048); \
            dst##8[m] = __builtin_shufflevector(_lo, _hi, 0, 1, 2, 3, 4, 5, 6, 7); } else { _Pragma("unroll") for (int k = 0; k < 2; ++k) dst[m][k] = *(const LAS bf16x8*)(lds + PG8_SA(b, h) + aoffk[k] + m * 2048); } } } while (0)
#define PG8_LDB(dst, b, h) do { _Pragma("unroll") for (int n = 0; n < 2; ++n) { if constexpr (FP8) { const v4i_t _lo = *(const LAS v4i_t*)(lds + PG8_SB(b, h) + boffk[0] + n * 2048), _hi = *(const LAS v4i_t*)(lds + PG8_SB(b, h) + boffk[1] + n * 2048); \
            dst##8[n] = __builtin_shufflevector(_lo, _hi, 0, 1, 2, 3, 4, 5, 6, 7); } else { _Pragma("unroll") for (int k = 0; k < 2; ++k) dst[n][k] = *(const LAS bf16x8*)(lds + PG8_SB(b, h) + boffk[k] + n * 2048); } } } while (0)
#define PG8_MMA(ai, bj, At, Bt) do { if constexpr (FP8) __builtin_amdgcn_sched_barrier(0); __builtin_amdgcn_s_setprio(1); _Pragma("unroll") for (int m = 0; m < 4; ++m) _Pragma("unroll") for (int n = 0; n < 2; ++n) { \
        if constexpr (FP8) { acc[ai][bj][m][n] = __builtin_amdgcn_mfma_scale_f32_16x16x128_f8f6f4(Bt##8[n], At##8[m], acc[ai][bj][m][n], 0, 0, 0, 0x7F7F7F7F, 0, 0x7F7F7F7F); } \
        else { _Pragma("unroll") for (int k = 0; k < 2; ++k) acc[ai][bj][m][n] = __builtin_amdgcn_mfma_f32_16x16x32_bf16(Bt[n][k], At[m][k], acc[ai][bj][m][n], 0, 0, 0); } } __builtin_amdgcn_s_setprio(0); if constexpr (FP8) { asm volatile("" : "+v"(acc[ai][bj][0][0]), "+v"(acc[ai][bj][0][1]), "+v"(acc[ai][bj][1][0]), "+v"(acc[ai][bj][1][1]), "+v"(acc[ai][bj][2][0]), "+v"(acc[ai][bj][2][1]), "+v"(acc[ai][bj][3][0]), "+v"(acc[ai][bj][3][1])); __builtin_amdgcn_sched_barrier(0); } } while (0)
#define PG8_WAIT_V(n) asm volatile("s_waitcnt vmcnt(" #n ")" ::: "memory")
#define PG8_WAIT_VN(N) asm volatile("s_waitcnt vmcnt(%0)" :: "n"(N) : "memory")
#define PG8_WAIT_VR(flag, N) asm volatile("s_waitcnt vmcnt(%1)\n\ts_cmp_lg_u32 %0, 0\n\ts_cbranch_scc1 .Lrx%=\n\ts_waitcnt vmcnt(8)\n.Lrx%=:" :: "s"(flag), "n"(N) : "memory", "scc")
#define PG8_WAIT_L(n) asm volatile("s_waitcnt lgkmcnt(" #n ")" ::: "memory")
#define PG8_BAR __builtin_amdgcn_s_barrier()
#define PG8_SCHED __builtin_amdgcn_sched_barrier(0)
    Unit cur, nxt; int ui = 0;
    if (!S.next(0, cur)) return;
    f32x4 acc[2][2][4][2];
#pragma unroll
    for (int a = 0; a < 2; ++a)
#pragma unroll
        for (int b = 0; b < 2; ++b)
#pragma unroll
            for (int m = 0; m < 4; ++m)
#pragma unroll
                for (int n = 0; n < 2; ++n) acc[a][b][m][n] = (f32x4){0.f, 0.f, 0.f, 0.f};
    bf16x8 At[4][2], B0[2][2], B1[2][2];
    v8i_t At8[4], B08[2], B18[2];
    const char* cA = cur.A; const char* cB = cur.B;
    PG8_STAGEB(PG8_SB(0, 0), cB); PG8_STAGEB(PG8_SB(0, 1), cB + hstep); PG8_STAGEA(PG8_SA(0, 0), cA, cur.va, 0); PG8_STAGEA(PG8_SA(0, 1), cA, cur.va, 1);
    if (wr == 1) PG8_BAR;
    PG8_WAIT_V(2); PG8_BAR;
    PG8_STAGEB(PG8_SB(1, 0), cB + kstep); PG8_STAGEA(PG8_SA(1, 0), cA + kstep, cur.va, 0); PG8_STAGEB(PG8_SB(1, 1), cB + hstep + kstep);
    PG8_WAIT_V(6); PG8_BAR;
    for (;;) {
#ifdef PROBE_KDUP
        const bool has_next = S.next((ui + 1) >> 1, nxt);
#else
        const bool has_next = S.next(ui + 1, nxt);
#endif
        if (!has_next) { nxt.A = cA; nxt.B = cB; if constexpr (Sched::GATHER) { nxt.va[0][0] = cur.va[0][0]; nxt.va[0][1] = cur.va[0][1]; nxt.va[1][0] = cur.va[1][0]; nxt.va[1][1] = cur.va[1][1]; } }
        const char* nA = nxt.A; const char* nB = nxt.B;
#pragma unroll 1
        for (int t = 0; t < nt; t += 2) {
            const bool last = (t == nt - 2);
#ifdef PROBE_KDUP
            const int relax = __builtin_amdgcn_readfirstlane(((t == 0) && (ui > 0) && ((ui & 1) == 0)) ? 1 : 0);
#else
            const int relax = __builtin_amdgcn_readfirstlane(((t == 0) && (ui > 0)) ? 1 : 0);
#endif
            const char* a1 = cA + (size_t)(t + 1) * kstep;
            const char* a2 = last ? nA : cA + (size_t)(t + 2) * kstep; const char* b2 = last ? nB : cB + (size_t)(t + 2) * kstep;
            const char* a3 = a2 + kstep; const char* b3 = b2 + kstep;
            if constexpr (FP8) { asm volatile("" : "+s"(a1), "+s"(a2), "+s"(b2), "+s"(a3), "+s"(b3)); }
            unsigned v2[2][2];
            if constexpr (Sched::GATHER) { v2[0][0] = last ? nxt.va[0][0] : cur.va[0][0]; v2[0][1] = last ? nxt.va[0][1] : cur.va[0][1]; v2[1][0] = last ? nxt.va[1][0] : cur.va[1][0]; v2[1][1] = last ? nxt.va[1][1] : cur.va[1][1]; }
            else { v2[0][0] = cur.va[0][0]; v2[0][1] = cur.va[0][1]; v2[1][0] = cur.va[1][0]; v2[1][1] = cur.va[1][1]; }
            PG8_LDB(B0, 0, 0); PG8_LDB(B1, 0, 1); PG8_SCHED; PG8_LDA(At, 0, 0);
            PG8_STAGEA(PG8_SA(1, 1), a1, cur.va, 1); PG8_WAIT_VR(relax, 8 + Epi::NISS);
            PG8_WAIT_L(0); PG8_BAR; PG8_MMA(0, 0, At, B0); PG8_MMA(0, 1, At, B1); PG8_BAR; PG8_SCHED;
            PG8_LDA(At, 0, 1); PG8_STAGEB(PG8_SB(0, 0), b2); PG8_STAGEB(PG8_SB(0, 1), b2 + hstep); PG8_STAGEA(PG8_SA(0, 0), a2, v2, 0);
            PG8_WAIT_VR(relax, 8 + Epi::NISS);
            PG8_WAIT_L(0); PG8_BAR; PG8_MMA(1, 0, At, B0); PG8_MMA(1, 1, At, B1); PG8_BAR; PG8_SCHED;
            PG8_LDB(B0, 1, 0); PG8_LDB(B1, 1, 1); PG8_SCHED; PG8_LDA(At, 1, 0); PG8_STAGEA(PG8_SA(0, 1), a2, v2, 1);
            PG8_WAIT_V(8);
            PG8_WAIT_L(0); PG8_BAR; PG8_MMA(0, 0, At, B0); PG8_MMA(0, 1, At, B1); PG8_BAR; PG8_SCHED;
            PG8_LDA(At, 1, 1); PG8_STAGEB(PG8_SB(1, 0), b3); PG8_STAGEB(PG8_SB(1, 1), b3 + hstep); PG8_STAGEA(PG8_SA(1, 0), a3, v2, 0);
            PG8_WAIT_V(8); PG8_WAIT_L(0); PG8_BAR; PG8_MMA(1, 0, At, B0); PG8_MMA(1, 1, At, B1); PG8_BAR; PG8_SCHED;
        }
        if constexpr (ALIGN_EPI) { if (wr == 0) PG8_BAR; }
        asm volatile("" ::: "memory");
#ifdef PROBE_KDUP
        if (ui & 1)
#endif
        E(acc, cur, wr, wc, fr, fq);
#ifdef PROBE_DRAIN
        asm volatile("s_waitcnt vmcnt(0)" ::: "memory");
#endif
#ifdef PROBE_EPI2
        if constexpr (Epi::IDEM) { asm volatile("" ::: "memory"); E(acc, cur, wr, wc, fr, fq); }
#endif
        if (!has_next) break;
#pragma unroll
        for (int a = 0; a < 2; ++a)
#pragma unroll
            for (int b = 0; b < 2; ++b)
#pragma unroll
                for (int m = 0; m < 4; ++m)
#pragma unroll
                    for (int n = 0; n < 2; ++n) acc[a][b][m][n] = (f32x4){0.f, 0.f, 0.f, 0.f};
        if constexpr (Sched::GATHER) cur = nxt; else { cur.A = nxt.A; cur.B = nxt.B; cur.pm = nxt.pm; cur.pn = nxt.pn; cur.aux = nxt.aux; }
        cA = nA; cB = nB; ++ui;
        if constexpr (ALIGN_EPI) { if (wr == 1) PG8_BAR; }
    }
    PG8_WAIT_V(0);
    if constexpr (!ALIGN_EPI) { if (wr == 0) PG8_BAR; }
    PG8_BAR;
#undef PG8_SA
#undef PG8_SB
#undef PG8_STAGEA
#undef PG8_STAGEB
#undef PG8_LDA
#undef PG8_LDB
#undef PG8_MMA
#undef PG8_WAIT_V
#undef PG8_WAIT_L
#undef PG8_BAR
#undef PG8_SCHED
}
__device__ __forceinline__ void contig_va(unsigned (&va)[2][2], unsigned lda) {
    const int tid = threadIdx.x;
#pragma unroll
    for (int i = 0; i < 2; ++i) { int R, C; stage_rc(tid * 16 + i * 8192, R, C); va[0][i] = (unsigned)R * lda + (unsigned)C * 2u; va[1][i] = (unsigned)(R + HALF) * lda + (unsigned)C * 2u; }
}
}


template <int BM> __device__ __forceinline__ u32x4 sel_ror8(const u32x4 keep, const u32x4 src) { u32x4 r;
    r.x = (unsigned)__builtin_amdgcn_update_dpp((int)keep.x, (int)src.x, 0x128, 0xf, BM, false); r.y = (unsigned)__builtin_amdgcn_update_dpp((int)keep.y, (int)src.y, 0x128, 0xf, BM, false);
    r.z = (unsigned)__builtin_amdgcn_update_dpp((int)keep.z, (int)src.z, 0x128, 0xf, BM, false); r.w = (unsigned)__builtin_amdgcn_update_dpp((int)keep.w, (int)src.w, 0x128, 0xf, BM, false); return r; }
__device__ __forceinline__ void st_lines(bf16_t* line0, size_t pitch  , int fr, int fq, const u32x4 p0, const u32x4 p1) {
    const bool lo = fr < 8;
    const u32x4 d0 = sel_ror8<0xC>(p0, p1);
    const u32x4 d1 = sel_ror8<0x3>(p1, p0);
    bf16_t* a = line0 + (size_t)(fr & 7) * pitch + (lo ? 0 : 32) + 8 * fq; bf16_t* a2 = a + 8 * pitch;
    asm volatile("global_store_dwordx4 %0, %1, off sc1\n\ts_nop 1" :: "v"(a), "v"(d0) : "memory");
    asm volatile("global_store_dwordx4 %0, %1, off sc1\n\ts_nop 1" :: "v"(a2), "v"(d1) : "memory");
}
__device__ __forceinline__ void ld_lines(const bf16_t* line0, size_t pitch, int fr, int fq, u32x4& p0, u32x4& p1) {
    const bool lo = fr < 8; const bf16_t* a = line0 + (size_t)(fr & 7) * pitch + (lo ? 0 : 32) + 8 * fq;
    const u32x4 l1 = *(const u32x4*)a, l2 = *(const u32x4*)(a + 8 * pitch);
    p0 = sel_ror8<0xC>(l1, l2);
    p1 = sel_ror8<0x3>(l2, l1);
}
__device__ __forceinline__ u32x4 pack8(const f32x4 v0, const f32x4 v1) { u32x4 w; w.x = cvt_pk_bf16(v0[0], v0[1]); w.y = cvt_pk_bf16(v0[2], v0[3]); w.z = cvt_pk_bf16(v1[0], v1[1]); w.w = cvt_pk_bf16(v1[2], v1[3]); return w; }

struct Frame {
    LAS unsigned char* lds;
    unsigned* ctl;
    int tid, lane, wave, vcu, G;
    const float* in[27];
    float* out;
    unsigned char* ws;
};
struct Args { const float* in[27]; float* out; unsigned char* ws; int ph_lo, ph_hi; };

__device__ __forceinline__ void p_adaln(Frame& F) {
    const int wg = blockIdx.x, tid = F.tid;
    if (wg >= 192) return;
    const float* c = F.in[1]; const float* cctx = F.in[3]; const float* wmod = F.in[4]; const float* bmod = F.in[5];
    float* mod = (float*)(F.ws + WS_MOD);
    LAS float* sc = (LAS float*)F.lds;
    for (int i = tid; i < 33 * 1024; i += NTHR) { const int r = i >> 10, k = i & 1023; const float v = (r < 32) ? c[r * 1024 + k] : cctx[k]; sc[k * 36 + r] = v / (1.f + expf(-v)); }
    __syncthreads();
    const int col = tid & 31, kq = tid >> 5, j = wg * 32 + col;
    float acc[33];
#pragma unroll
    for (int r = 0; r < 33; ++r) acc[r] = 0.f;
    for (int kk = 0; kk < 64; ++kk) {
        const int k = kq * 64 + kk; const float w = wmod[(size_t)k * 6144 + j];
        const LAS f32x4* sp = (const LAS f32x4*)(sc + k * 36);
#pragma unroll
        for (int q = 0; q < 8; ++q) { const f32x4 s4 = sp[q]; acc[4 * q] += s4[0] * w; acc[4 * q + 1] += s4[1] * w; acc[4 * q + 2] += s4[2] * w; acc[4 * q + 3] += s4[3] * w; }
        acc[32] += sc[k * 36 + 32] * w;
    }
    __syncthreads();
    LAS float* red = (LAS float*)F.lds;
#pragma unroll
    for (int r = 0; r < 33; ++r) red[(kq * 33 + r) * 32 + col] = acc[r];
    __syncthreads();
    for (int o = tid; o < 33 * 32; o += NTHR) { const int r = o >> 5, cc = o & 31; float s = 0.f;
#pragma unroll
        for (int q = 0; q < 16; ++q) s += red[(q * 33 + r) * 32 + cc];
        mod[r * 6144 + wg * 32 + cc] = s + bmod[wg * 32 + cc]; }
    __syncthreads();
}
__device__ __forceinline__ void transpose_item(const float* W, int ldw, int k0, int n0, bf16_t* WT, int ldk, int dst_row0, LAS float* scr, int lane, float scale = 1.f) {
    float tv[32];
#pragma unroll
    for (int i = 0; i < 32; ++i) { const int kk = 2 * i + (lane >> 5); tv[i] = W[(size_t)(k0 + kk) * ldw + n0 + (lane & 31)]; }
#pragma unroll
    for (int i = 0; i < 32; ++i) { const int kk = 2 * i + (lane >> 5); scr[kk * 33 + (lane & 31)] = tv[i]; }
    LDS_WAIT(); asm volatile("" ::: "memory");
    const int c = lane & 7;
#pragma unroll
    for (int j = 0; j < 4; ++j) { const int n = (lane >> 3) + 8 * j; const LAS float* s = scr + (8 * c) * 33 + n;
        u32x4 o; o.x = cvt_pk_bf16(s[0 * 33] * scale, s[1 * 33] * scale); o.y = cvt_pk_bf16(s[2 * 33] * scale, s[3 * 33] * scale); o.z = cvt_pk_bf16(s[4 * 33] * scale, s[5 * 33] * scale); o.w = cvt_pk_bf16(s[6 * 33] * scale, s[7 * 33] * scale);
        *(u32x4*)(WT + (size_t)(dst_row0 + n) * ldk + k0 + 8 * c) = o; }
    LDS_WAIT(); asm volatile("" ::: "memory");
}
__device__ __forceinline__ void transpose_item8(const float* W, int ldw, int k0, int n0, unsigned char* WT8, int ldk, int dst_row0, LAS float* scr, int lane, float scale) {
    float tv[32];
#pragma unroll
    for (int i = 0; i < 32; ++i) { const int kk = 2 * i + (lane >> 5); tv[i] = W[(size_t)(k0 + kk) * ldw + n0 + (lane & 31)]; }
#pragma unroll
    for (int i = 0; i < 32; ++i) { const int kk = 2 * i + (lane >> 5); scr[kk * 33 + (lane & 31)] = tv[i]; }
    LDS_WAIT(); asm volatile("" ::: "memory");
    const int c = lane & 7;
#pragma unroll
    for (int j = 0; j < 4; ++j) { const int n = (lane >> 3) + 8 * j; const LAS float* sp = scr + (8 * c) * 33 + n;
        u32x2 o; o.x = pk4_fp8(sp[0 * 33] * scale, sp[1 * 33] * scale, sp[2 * 33] * scale, sp[3 * 33] * scale); o.y = pk4_fp8(sp[4 * 33] * scale, sp[5 * 33] * scale, sp[6 * 33] * scale, sp[7 * 33] * scale);
        *(u32x2*)(WT8 + (size_t)(dst_row0 + n) * ldk + k0 + 8 * c) = o; }
    LDS_WAIT(); asm volatile("" ::: "memory");
}
__device__ __forceinline__ void p_wpeff_block(Frame& F, int blk) {
    const int tid = F.tid, gi = blk >> 3, eb = blk & 7;
    const float* pw = F.in[14] + (size_t)gi * 128 * 128; const float* ps = F.in[15] + gi * 128; const float* wbr = F.in[16] + (size_t)(gi * 128) * 1024 + eb * 128;
    bf16_t* WP = (bf16_t*)(F.ws + WS_WP);
    LAS float* At = (LAS float*)F.lds;
    LAS float* Bs = At + 128 * 128;
    for (int i = tid; i < 128 * 32; i += NTHR) { const int c = i & 127, j4 = (i >> 7) * 4; const f32x4 v = *(const f32x4*)(pw + c * 128 + j4);     At[(j4 + 0) * 128 + c] = v[0]; At[(j4 + 1) * 128 + c] = v[1]; At[(j4 + 2) * 128 + c] = v[2]; At[(j4 + 3) * 128 + c] = v[3]; }
    for (int i = tid; i < 128 * 32; i += NTHR) { const int j = i >> 5, e4 = (i & 31) * 4; const f32x4 v = *(const f32x4*)(wbr + (size_t)j * 1024 + e4); *(LAS f32x4*)(Bs + j * 128 + e4) = v * ps[j]; }
    __syncthreads();
    const int c0 = (tid >> 4) * 4, e0 = (tid & 15) * 8;
    f32x4 acc[4][2];
#pragma unroll
    for (int q = 0; q < 4; ++q) { acc[q][0] = (f32x4){0.f, 0.f, 0.f, 0.f}; acc[q][1] = (f32x4){0.f, 0.f, 0.f, 0.f}; }
#pragma unroll 4
    for (int j = 0; j < 128; ++j) { const f32x4 a = *(const LAS f32x4*)(At + j * 128 + c0), b0 = *(const LAS f32x4*)(Bs + j * 128 + e0), b1 = *(const LAS f32x4*)(Bs + j * 128 + e0 + 4);
#pragma unroll
        for (int q = 0; q < 4; ++q) { acc[q][0] += b0 * a[q]; acc[q][1] += b1 * a[q]; } }
#pragma unroll
    for (int h2 = 0; h2 < 2; ++h2)
#pragma unroll
        for (int x = 0; x < 4; ++x) { const int e = eb * 128 + e0 + 4 * h2 + x;
            *(u32x2*)(WP + (size_t)e * 512 + gi * 128 + c0) = (u32x2){cvt_pk_bf16(acc[0][h2][x], acc[1][h2][x]), cvt_pk_bf16(acc[2][h2][x], acc[3][h2][x])}; }
    __syncthreads();
}
__device__ __forceinline__ void p_convert(Frame& F, const bool do_base, const bool do_moe) {
    LAS float* scr = (LAS float*)(F.lds + F.wave * 16384);
    const int gw = F.vcu * NWAVES + F.wave, NGW = F.G * NWAVES, lane = F.lane;
    bf16_t* WIN = (bf16_t*)(F.ws + WS_WIN); bf16_t* WGLA = (bf16_t*)(F.ws + WS_WGLA); bf16_t* WO = (bf16_t*)(F.ws + WS_WO);
    bf16_t* W13 = (bf16_t*)(F.ws + WS_W13); bf16_t* W2 = (bf16_t*)(F.ws + WS_W2); bf16_t* WP = (bf16_t*)(F.ws + WS_WP);
    constexpr int I_IN = 16 * 177, I_SQ = 16 * 32, I_13 = 64 * 256, I_2 = 32 * 256;
    constexpr int NITEMS = I_IN + 2 * I_SQ + I_13 + I_2;
    for (int it = gw + (do_base ? 0 : I_IN + 2 * I_SQ); it < (do_moe ? NITEMS : I_IN + 2 * I_SQ); it += NGW) {
        int r = it;
        if (r < I_IN) { const int kb = r / 177, nb = r % 177; transpose_item(F.in[8], DIN, 64 * kb, 32 * nb, WIN, 1024, 32 * nb, scr, lane, (nb >= 16 && nb < 32) ? 0.08838834764831845f : 1.f); continue; }   r -= I_IN;
        if (r < I_SQ) { const int kb = r / 32, nb = r % 32; transpose_item(F.in[17], 1024, 64 * kb, 32 * nb, WGLA, 1024, 32 * nb, scr, lane); continue; } r -= I_SQ;
        if (r < I_SQ) { const int kb = r / 32, nb = r % 32; transpose_item(F.in[18], 1024, 64 * kb, 32 * nb, WO, 1024, 32 * nb, scr, lane); continue; } r -= I_SQ;
        if (r < I_13) { const int mat = r / 256, e = mat >> 1, which = mat & 1, rr = r % 256, kb = rr / 16, nb = rr % 16, n0 = 32 * nb;
            const float* src = (which ? F.in[24] : F.in[23]) + (size_t)e * 1024 * 512;
            if (MOE_FP8) transpose_item8(src, 512, 64 * kb, n0, (unsigned char*)W13 + (size_t)e * 1024 * 1024, 1024, (n0 / 128) * 256 + ((n0 % 128) / 32) * 64 + which * 32, scr, lane, SC_W13);
            else transpose_item(src, 512, 64 * kb, n0, W13 + (size_t)e * 1024 * 1024, 1024, (n0 / 128) * 256 + ((n0 % 128) / 32) * 64 + which * 32, scr, lane);
            continue; } r -= I_13;
        { const int e = r / 256, rr = r % 256, kb = rr / 32, nb = rr % 32;
            if (MOE2_FP8) transpose_item8(F.in[25] + (size_t)e * 512 * 1024, 1024, 64 * kb, 32 * nb, (unsigned char*)W2 + (size_t)e * 1024 * 512, 512, 32 * nb, scr, lane, SC_W2);
            else transpose_item(F.in[25] + (size_t)e * 512 * 1024, 1024, 64 * kb, 32 * nb, W2 + (size_t)e * 1024 * 512, 512, 32 * nb, scr, lane); }
    }
}

__device__ __forceinline__ void norm_rows(const float* src, bf16_t* dst, int row0, int nrows  , const float* gain, const float* scv, const float* shv, int lane) {
    f32x4 Av[4], Bv[4];
#pragma unroll
    for (int q = 0; q < 4; ++q) { const int c = 8 * lane + 512 * (q >> 1) + 4 * (q & 1); const f32x4 g = *(const f32x4*)(gain + c), sc = *(const f32x4*)(scv + c); Av[q] = g * (sc + 1.f); Bv[q] = *(const f32x4*)(shv + c); }
    f32x4 buf[4][4];
#pragma unroll
    for (int p = 0; p < 4; ++p)
#pragma unroll
        for (int q = 0; q < 4; ++q) buf[p][q] = *(const f32x4*)(src + (size_t)(row0 + p) * D + 8 * lane + 512 * (q >> 1) + 4 * (q & 1));
    for (int r = 0; r < nrows; r += 4) {
#pragma unroll
        for (int p = 0; p < 4; ++p) {
            f32x4 v[4]; float ss = 0.f;
#pragma unroll
            for (int q = 0; q < 4; ++q) v[q] = buf[p][q];
            if (r + 4 + p < nrows) {
#pragma unroll
                for (int q = 0; q < 4; ++q) buf[p][q] = *(const f32x4*)(src + (size_t)(row0 + r + 4 + p) * D + 8 * lane + 512 * (q >> 1) + 4 * (q & 1)); }
#pragma unroll
            for (int q = 0; q < 4; ++q) ss += (v[q][0] * v[q][0] + v[q][1] * v[q][1]) + (v[q][2] * v[q][2] + v[q][3] * v[q][3]);
            const float rstd = 1.f / sqrtf(wave_sum(ss) * (1.f / D) + EPS);
            bf16_t* orow = dst + (size_t)(row0 + r + p) * D;
#pragma unroll
            for (int j = 0; j < 2; ++j) { const f32x4 h0 = v[2 * j] * rstd * Av[2 * j] + Bv[2 * j], h1 = v[2 * j + 1] * rstd * Av[2 * j + 1] + Bv[2 * j + 1]; *(u32x4*)(orow + 8 * lane + 512 * j) = pack8(h0, h1); }
        }
    }
}
#define LDS_BARRIER() asm volatile("s_waitcnt lgkmcnt(0)\n\ts_barrier" ::: "memory")
template <bool LOADN>
__device__ __forceinline__ void norm1_step(const Frame& F, f32x4 (&cur)[4][4], f32x4 (&nxt)[4][4], const float* nsrc, bf16_t* drow, const f32x4 (&Av)[4], const f32x4 (&Bv)[4], const bf16x8 (&wf)[2][4],
                                           float* lrbase, const int lrmul) {
    const int lane = F.lane, wave = F.wave, tid = F.tid;
    constexpr int SROW = 2064;
    LAS unsigned char* stage = F.lds;
    LAS float* part = (LAS float*)(F.lds + 66560);
#pragma unroll
    for (int p = 0; p < 4; ++p) {
        float ss = 0.f;
        if (LOADN) {
#pragma unroll
            for (int q = 0; q < 4; ++q) nxt[p][q] = *(const f32x4*)(nsrc + (size_t)p * D + 8 * lane + 512 * (q >> 1) + 4 * (q & 1)); }
#pragma unroll
        for (int q = 0; q < 4; ++q) ss += (cur[p][q][0] * cur[p][q][0] + cur[p][q][1] * cur[p][q][1]) + (cur[p][q][2] * cur[p][q][2] + cur[p][q][3] * cur[p][q][3]);
        const float rstd = 1.f / sqrtf(wave_sum(ss) * (1.f / D) + EPS);
#pragma unroll
        for (int j = 0; j < 2; ++j) { const f32x4 h0 = cur[p][2 * j] * rstd * Av[2 * j] + Bv[2 * j], h1 = cur[p][2 * j + 1] * rstd * Av[2 * j + 1] + Bv[2 * j + 1]; const u32x4 h = pack8(h0, h1);
            *(u32x4*)(drow + (size_t)p * D + 8 * lane + 512 * j) = h; *(LAS u32x4*)(stage + (4 * wave + p) * SROW + (8 * lane + 512 * j) * 2) = h; }
    }
    LDS_BARRIER();
    f32x4 acc[2][2];
#pragma unroll
    for (int nb = 0; nb < 2; ++nb)
#pragma unroll
        for (int nh = 0; nh < 2; ++nh) acc[nb][nh] = (f32x4){0.f, 0.f, 0.f, 0.f};
#pragma unroll
    for (int nb = 0; nb < 2; ++nb)
#pragma unroll
        for (int ks = 0; ks < 4; ++ks) { const bf16x8 bfr = *(LAS bf16x8*)(stage + (16 * nb + (lane & 15)) * SROW + (128 * wave + 32 * ks + 8 * (lane >> 4)) * 2);
#pragma unroll
            for (int nh = 0; nh < 2; ++nh) acc[nb][nh] = __builtin_amdgcn_mfma_f32_16x16x32_bf16(wf[nh][ks], bfr, acc[nb][nh], 0, 0, 0); }
#pragma unroll
    for (int nb = 0; nb < 2; ++nb)
#pragma unroll
        for (int nh = 0; nh < 2; ++nh) *(LAS f32x4*)(part + ((wave * 4 + nb * 2 + nh) * 64 + lane) * 4) = acc[nb][nh];
    LDS_BARRIER();
    {
        const int q = tid >> 7, ln = (tid & 127) >> 1, ip = tid & 1;
        f32x2 sum = (f32x2){0.f, 0.f};
#pragma unroll
        for (int w8 = 0; w8 < 8; ++w8) sum += *(LAS f32x2*)(part + ((w8 * 4 + q) * 64 + ln) * 4 + 2 * ip);
        const int slot = 16 * (q >> 1) + (ln & 15), n = 16 * (q & 1) + 4 * (ln >> 4) + 2 * ip;
        *(f32x2*)(lrbase + ((size_t)lrmul * (slot >> 2) + (slot & 3)) * 32 + n) = sum; }
}
__device__ __forceinline__ void p_norm1(Frame& F) {
    const int lane = F.lane, wave = F.wave;
    const float* mod = (const float*)(F.ws + WS_MOD); bf16_t* HX = (bf16_t*)(F.ws + WS_HX); float* LR = (float*)(F.ws + WS_LR);
    const bf16_t* WIN = (const bf16_t*)(F.ws + WS_WIN);
    bf16x8 wf[2][4];
#pragma unroll
    for (int nh = 0; nh < 2; ++nh)
#pragma unroll
        for (int ks = 0; ks < 4; ++ks) wf[nh][ks] = *(const bf16x8*)(WIN + (size_t)(5632 + 16 * nh + (lane & 15)) * 1024 + 128 * wave + 32 * ks + 8 * (lane >> 4));
    for (int wv = F.vcu; wv < 256; wv += F.G) {
        const int gw = wv * NWAVES + wave, b = wv >> 3;
        f32x4 Av[4], Bv[4];
#pragma unroll
        for (int q = 0; q < 4; ++q) { const int c = 8 * lane + 512 * (q >> 1) + 4 * (q & 1); const f32x4 g = *(const f32x4*)(F.in[6] + c), sc = *(const f32x4*)(mod + b * 6144 + 1024 + c); Av[q] = g * (sc + 1.f); Bv[q] = *(const f32x4*)(mod + b * 6144 + c); }
        f32x4 bufA[4][4], bufB[4][4];
        const float* xr = F.in[0] + (size_t)32 * gw * D; bf16_t* hr = HX + (size_t)32 * gw * D; float* lr = LR + (size_t)32 * wv * NWAVES * 32;
#pragma unroll
        for (int p = 0; p < 4; ++p)
#pragma unroll
            for (int q = 0; q < 4; ++q) bufA[p][q] = *(const f32x4*)(xr + (size_t)p * D + 8 * lane + 512 * (q >> 1) + 4 * (q & 1));
#pragma unroll 1
        for (int i2 = 0; i2 < 3; ++i2) {
            norm1_step<true>(F, bufA, bufB, xr + (size_t)(8 * i2 + 4) * D, hr + (size_t)(8 * i2) * D, Av, Bv, wf, lr + (size_t)(8 * i2) * 32, 32);
            norm1_step<true>(F, bufB, bufA, xr + (size_t)(8 * i2 + 8) * D, hr + (size_t)(8 * i2 + 4) * D, Av, Bv, wf, lr + (size_t)(8 * i2 + 4) * 32, 32);
        }
        norm1_step<true>(F, bufA, bufB, xr + (size_t)28 * D, hr + (size_t)24 * D, Av, Bv, wf, lr + (size_t)24 * 32, 32);
        norm1_step<true>(F, bufB, bufA, F.in[2] + (size_t)4 * gw * D, hr + (size_t)28 * D, Av, Bv, wf, lr + (size_t)28 * 32, 32);
#pragma unroll
        for (int q = 0; q < 4; ++q) { const int c = 8 * lane + 512 * (q >> 1) + 4 * (q & 1); const f32x4 g = *(const f32x4*)(F.in[6] + c), sc = *(const f32x4*)(mod + 32 * 6144 + 1024 + c); Av[q] = g * (sc + 1.f); Bv[q] = *(const f32x4*)(mod + 32 * 6144 + c); }
        norm1_step<false>(F, bufA, bufB, nullptr, HX + ((size_t)T + 4 * gw) * D, Av, Bv, wf, LR + ((size_t)T + 4 * wv * NWAVES) * 32, 4);
    }
    __syncthreads();
}

struct SchedG1 {
    static constexpr bool GATHER = false;
    const char* HX; const char* WIN; int G, c;
    __device__ __forceinline__ bool next(int i, pg8::Unit& u) const {
        const int L = i * G + c; constexpr int NL = 256 * 22, NC = 32 * 6;
        if (L >= NL + NC) return false;
        int pm, pn, ctx = 0;
        if (L < NL) pg8::static_tile(L, 256, 22, pm, pn);
        else { const int j = L - NL; pm = j & 31; pn = 4 + (j >> 5); ctx = 1; }
        u.pm = pm; u.pn = pn; u.aux = ctx;
        u.A = HX + ((size_t)(ctx ? T : 0) + (size_t)pm * 256) * (D * 2); u.B = WIN + (size_t)pn * 256 * (D * 2);
        pg8::contig_va(u.va, D * 2);
        return true;
    }
};
struct EpiG1 {
    static constexpr int NISS = 16; static constexpr bool IDEM = true; static constexpr bool PERM = true;
    unsigned char* ws;
    __device__ __forceinline__ void operator()(const f32x4 (&acc)[2][2][4][2], const pg8::Unit& u, int wr, int wc, int fr, int fq) const {
        const int pn = u.pn, ctx = u.aux; const int rowg = u.pm * 256 + wr * 64;
        bf16_t* base; int ldc, colt;
        if (ctx) { base = (bf16_t*)(ws + WS_PKVC); ldc = 1536; colt = (pn - 4) * 256; }
        else if (pn < 2) { base = (bf16_t*)(ws + WS_PU); ldc = 512; colt = pn * 256; }
        else if (pn < 10) { base = (bf16_t*)(ws + WS_PQKV); ldc = 2048; colt = (pn - 2) * 256; }
        else if (pn < 14) { base = (bf16_t*)(ws + WS_PG); ldc = 1024; colt = (pn - 10) * 256; }
        else { base = (bf16_t*)(ws + WS_PGATES); ldc = 2048; colt = (pn - 14) * 256; }
        bf16_t* blk = base + (size_t)rowg * ldc + colt + wc * 64;
#pragma unroll
        for (int ai = 0; ai < 2; ++ai)
#pragma unroll
            for (int m = 0; m < 4; ++m)
                st_lines(blk + (size_t)(ai * 128 + m * 16) * ldc, (size_t)ldc, fr, fq, pack8(acc[ai][0][m][0], acc[ai][0][m][1]), pack8(acc[ai][1][m][0], acc[ai][1][m][1]));
    }
};

typedef float f32x16 __attribute__((ext_vector_type(16)));
typedef short s16x4 __attribute__((ext_vector_type(4)));
typedef __bf16 bf16v2_t __attribute__((ext_vector_type(2)));
__device__ __forceinline__ unsigned pkbf(float a, float b) { bf16v2_t v; v[0] = (__bf16)a; v[1] = (__bf16)b; return __builtin_bit_cast(unsigned, v); }
__device__ __forceinline__ unsigned off_b(unsigned row, unsigned ch) { return 256u * row + 16u * (ch ^ (((row & 3u) << 2) | ((row >> 2) & 3u))); }
__device__ __forceinline__ unsigned tr_addr_b(unsigned lane, unsigned c, unsigned ks, unsigned t) {
    const unsigned h = lane >> 5, blk = (lane >> 4) & 1u, q = (lane & 15u) >> 2, pp = lane & 3u;
    return off_b(16u * ks + 8u * h + 4u * t + q, 4u * c + 2u * blk + (pp >> 1)) + 8u * (pp & 1u);
}
constexpr int GL_V = 0, GL_QD = 32768, GL_KI = 49152, GL_KR = 65536, GL_PM = 81920, GL_CUM = 90112, GL_DEC = 122880, GL_OT = 123392;
#define MFMA32(a, b, c) __builtin_amdgcn_mfma_f32_32x32x16_bf16((a), (b), (c), 0, 0, 0)
__device__ __forceinline__ void p_gla_chunk(Frame& F) {
    const int w = F.wave;
    LAS unsigned char* L = F.lds;
    const bf16_t* PQKV = (const bf16_t*)(F.ws + WS_PQKV); const bf16_t* PKVC = (const bf16_t*)(F.ws + WS_PKVC); const float* LR = (const float*)(F.ws + WS_LR);
    LAS float* CUM = (LAS float*)(L + GL_CUM); LAS float* DEC = (LAS float*)(L + GL_DEC);
    const int tid0 = F.tid;
    const int ib = w >> 2, db = w & 3;
    const unsigned A_vw = GL_V + (unsigned)((tid0 & 31) >> 4) * 16384u + off_b((unsigned)(tid0 >> 5), (unsigned)(tid0 & 15));
    const unsigned A_kr = off_b((unsigned)(tid0 >> 4), (unsigned)(tid0 & 15));
    const unsigned A_a0 = off_b((unsigned)(tid0 >> 4), (unsigned)(tid0 & 14)) + 8u * (unsigned)(tid0 & 1);
    unsigned RB, TB, PB, WB;
    { const unsigned lane0 = tid0 & 63, hh0 = lane0 >> 5, l310 = lane0 & 31; const unsigned tq = (lane0 & 15) >> 2, tp = lane0 & 3, tblk = (lane0 >> 4) & 1;
      RB = 256u * l310 + 16u * (((l310 & 3u) << 2) | ((l310 >> 2) & 3u));
      TB = 256u * (8u * hh0 + tq) + 8u * (tp & 1u) + 16u * ((2u * tblk + (tp >> 1)) ^ ((tq << 2) | (2u * hh0)));
      PB = 128u * l310 + 16u * (hh0 ^ ((l310 >> 1) & 7u));
      WB = 128u * l310 + 16u * ((l310 >> 1) & 7u) + 8u * hh0; }
    for (int wgi = blockIdx.x; wgi < 256; wgi += F.G) {
        const int b = wgi >> 3, h = (wgi >> 1) & 3, dir = wgi & 1;
        bf16_t* OD = (bf16_t*)F.out + (size_t)dir * T * D;
        const float* a2 = dir ? F.in[11] : F.in[9]; const float* ab = dir ? F.in[12] : F.in[10];
        float a2r[8];
#pragma unroll
        for (int kk = 0; kk < 8; ++kk) a2r[kk] = a2[(kk + 8 * ((tid0 >> 5) & 1)) * 512 + h * 128 + 32 * db + (tid0 & 31)];
        const float abd2 = -1.44269504089f * ab[h * 128 + 32 * db + (tid0 & 31)];
        unsigned vo = (unsigned)(dir ? 63 - (tid0 >> 5) : (tid0 >> 5)) * 3072u + 16u * (unsigned)(tid0 & 31);
        unsigned ko = (unsigned)(dir ? 63 - (tid0 >> 4) : (tid0 >> 4)) * 3072u + 16u * (unsigned)(tid0 & 15);
        const unsigned lvo = (unsigned)(dir ? 63 - (32 * ib + (tid0 & 31)) : (32 * ib + (tid0 & 31))) * 128u + 32u * (unsigned)((tid0 >> 5) & 1);
        f32x16 S[4];
#pragma unroll
        for (int q = 0; q < 4; ++q)
#pragma unroll
            for (int r = 0; r < 16; ++r) S[q][r] = 0.f;
        f32x4 lv[2]; u32x4 vreg[4], qreg[2], kreg[2];
#define GLA_LOAD(CH) do { const int _ch = (CH); const bool _ic = _ch < 4; const int _ci = _ic ? _ch : _ch - 4, _N = _ic ? CTXL : SEQ; const unsigned _rp2 = _ic ? 3072u : 4096u; \
            if (_ch == 4) { int _t = tid0; asm volatile("" : "+v"(_t)); vo = (unsigned)(dir ? 63 - (_t >> 5) : (_t >> 5)) * 4096u + 16u * (unsigned)(_t & 31); ko = (unsigned)(dir ? 63 - (_t >> 4) : (_t >> 4)) * 4096u + 16u * (unsigned)(_t & 15); } \
            const int _tok0 = dir ? (_N - 64 - 64 * _ci) : 64 * _ci; \
            const char* _gb = (const char*)(_ic ? PKVC + (size_t)b * CTXL * 1536 : PQKV + (size_t)b * SEQ * 2048) + (size_t)_tok0 * _rp2; \
            const int _qc = h * 128, _kc = _ic ? h * 128 : 512 + h * 128, _vc = _ic ? 512 + h * 256 : 1024 + h * 256; \
            const char* _lrb = (const char*)(LR + ((_ic ? (size_t)T + (size_t)b * CTXL : (size_t)b * SEQ) + _tok0) * 32 + dir * 16); \
            lv[0] = *(const f32x4*)(_lrb + (size_t)lvo); lv[1] = *(const f32x4*)(_lrb + 16 + (size_t)lvo); \
            const unsigned _vs = dir ? 0u - 16u * _rp2 : 16u * _rp2, _ks = dir ? 0u - 32u * _rp2 : 32u * _rp2;        \
            _Pragma("unroll") for (int q = 0; q < 4; ++q) vreg[q] = *(const u32x4*)(_gb + _vc * 2 + (size_t)(vo + (unsigned)q * _vs)); \
            _Pragma("unroll") for (int q = 0; q < 2; ++q) { kreg[q] = *(const u32x4*)(_gb + _kc * 2 + (size_t)(ko + (unsigned)q * _ks)); qreg[q] = *(const u32x4*)(_gb + _qc * 2 + (size_t)(ko + (unsigned)q * _ks)); } } while (0)
#define GLA_FLUSH(CI) do { const int _ci = (CI); const int _tok0 = dir ? (SEQ - 64 - 64 * _ci) : 64 * _ci; char* _ob = (char*)(OD + ((size_t)b * SEQ + _tok0) * D + h * 256); \
            const unsigned _fo = (unsigned)(dir ? 63 - (tid >> 5) : (tid >> 5)) * 2048u + 16u * (unsigned)(tid & 31), _fs = dir ? 0u - 16u * 2048u : 16u * 2048u; \
            const unsigned _fl = GL_OT + (unsigned)(tid >> 5) * 528u + (unsigned)(tid & 31) * 16u; \
            _Pragma("unroll") for (int q = 0; q < 4; ++q) *(u32x4*)(_ob + (size_t)(_fo + (unsigned)q * _fs)) = *(const LAS u32x4*)(L + _fl + 8448 * q); } while (0)
        GLA_LOAD(0);
        for (int ch = 0; ch < 36; ++ch) {
            const bool isctx = ch < 4;
            int tid = tid0; asm volatile("" : "+v"(tid), "+v"(RB), "+v"(TB), "+v"(PB), "+v"(WB));
            const int lane0 = tid & 63, hh = lane0 >> 5, l31 = lane0 & 31;
            f32x16 g;
#pragma unroll
            for (int r = 0; r < 16; ++r) g[r] = 0.f;
#pragma unroll
            for (int kk = 0; kk < 8; ++kk) g = __builtin_amdgcn_mfma_f32_32x32x2f32(lv[kk >> 2][kk & 3], a2r[kk], g, 0, 0, 0);
            float cum[16], gs[4], pg[4];
#pragma unroll
            for (int r = 0; r < 16; ++r) { const float a = __builtin_fmaf(g[r], -1.44269504089f, abd2);
                cum[r] = (fmaxf(a, 0.f) + __builtin_amdgcn_logf(1.f + __builtin_amdgcn_exp2f(-fabsf(a)))) * -0.0625f; }
#pragma unroll
            for (int q = 0; q < 4; ++q) { cum[4 * q + 1] += cum[4 * q]; cum[4 * q + 2] += cum[4 * q + 1]; cum[4 * q + 3] += cum[4 * q + 2]; gs[q] = cum[4 * q + 3]; }
#pragma unroll
            for (int q = 0; q < 4; ++q) pg[q] = xchg32(gs[q], lane0);
            { float run = 0.f;
#pragma unroll
                for (int q = 0; q < 4; ++q) { const float offq = run + (hh ? pg[q] : 0.f);
#pragma unroll
                    for (int e = 0; e < 4; ++e) cum[4 * q + e] += offq;
                    run += gs[q] + pg[q]; } }
            __syncthreads();
            if (ch >= 5) GLA_FLUSH(ch - 5);
            { LAS float* cw = (LAS float*)(L + GL_CUM) + (32 * ib + 4 * hh) * 128 + 32 * db + l31;
#pragma unroll
                for (int r = 0; r < 16; ++r) cw[((r & 3) + 8 * (r >> 2)) * 128] = cum[r]; }
#pragma unroll
            for (int q = 0; q < 4; ++q) *(LAS u32x4*)(L + A_vw + 4096 * q) = vreg[q];
            __syncthreads();
            {
                const unsigned A_tb = GL_CUM + 32u * (unsigned)(tid & 15), A_cb = A_tb + (unsigned)(tid >> 4) * 512u;
                const f32x4 t0 = *(const LAS f32x4*)(L + A_tb + 31 * 512), t1 = *(const LAS f32x4*)(L + A_tb + 31 * 512 + 16);
                const f32x4 l0 = *(const LAS f32x4*)(L + A_tb + 63 * 512) + t0, l1 = *(const LAS f32x4*)(L + A_tb + 63 * 512 + 16) + t1;
                float el8[8];
#pragma unroll
                for (int e = 0; e < 4; ++e) { el8[e] = __builtin_amdgcn_exp2f(l0[e]); el8[4 + e] = __builtin_amdgcn_exp2f(l1[e]); }
#pragma unroll
                for (int q = 0; q < 2; ++q) {
                    f32x4 c0 = *(const LAS f32x4*)(L + A_cb + 16384 * q), c1 = *(const LAS f32x4*)(L + A_cb + 16384 * q + 16);
                    if (q == 1) { c0 += t0; c1 += t1; }
                    float kf[8], qf[8], cc[8]; unpack8(kreg[q], kf); unpack8(qreg[q], qf);
#pragma unroll
                    for (int e = 0; e < 4; ++e) { cc[e] = c0[e]; cc[4 + e] = c1[e]; }
                    float kr[8], kiv[8], qd[8];
#pragma unroll
                    for (int e = 0; e < 8; ++e) { const float ex = __builtin_amdgcn_exp2f(cc[e]), inv = __builtin_amdgcn_exp2f(-cc[e]); qd[e] = qf[e] * ex; kiv[e] = kf[e] * inv; kr[e] = kiv[e] * el8[e]; }
                    u32x4 wk; wk.x = pkbf(kr[0], kr[1]); wk.y = pkbf(kr[2], kr[3]); wk.z = pkbf(kr[4], kr[5]); wk.w = pkbf(kr[6], kr[7]);
                    *(LAS u32x4*)(L + GL_KR + 8192 * q + A_kr) = wk;
                    if (!isctx) {
                        *(LAS u32x2*)(L + GL_QD + 8192 * q + A_a0) = (u32x2){pkbf(qd[0], qd[1]), pkbf(qd[2], qd[3])}; *(LAS u32x2*)(L + GL_QD + 8192 * q + (A_a0 ^ 16u)) = (u32x2){pkbf(qd[4], qd[5]), pkbf(qd[6], qd[7])};
                        *(LAS u32x2*)(L + GL_KI + 8192 * q + A_a0) = (u32x2){pkbf(kiv[0], kiv[1]), pkbf(kiv[2], kiv[3])}; *(LAS u32x2*)(L + GL_KI + 8192 * q + (A_a0 ^ 16u)) = (u32x2){pkbf(kiv[4], kiv[5]), pkbf(kiv[6], kiv[7])};
                    }
                }
            }
            if (w < 2) DEC[tid] = __builtin_amdgcn_exp2f(CUM[63 * 128 + tid] + CUM[31 * 128 + tid]);
            if (ch + 1 < 36) GLA_LOAD(ch + 1);
            __syncthreads();
            bf16x8 vb[4];
            { LAS unsigned char* vbase = L + GL_V + (w >> 2) * 16384; const unsigned c4 = (unsigned)(w & 3) << 2;
#pragma unroll
                for (int ks = 0; ks < 4; ++ks) { const s16x4 lo = __builtin_amdgcn_ds_read_tr16_b64_v4i16((LAS s16x4*)(vbase + (TB ^ (c4 << 4)) + 256 * (16 * ks)));
                    const s16x4 hi = __builtin_amdgcn_ds_read_tr16_b64_v4i16((LAS s16x4*)(vbase + (TB ^ ((c4 ^ 1u) << 4)) + 256 * (16 * ks + 4)));
                    vb[ks] = __builtin_shufflevector(lo, hi, 0, 1, 2, 3, 4, 5, 6, 7); } }
            f32x16 o[2];
            if (!isctx) {
                if (w < 3) {
                    const int jb = (w == 2) ? 1 : 0, ibs = (w == 0) ? 0 : 1;
                    f32x16 sc;
#pragma unroll
                    for (int r = 0; r < 16; ++r) sc[r] = 0.f;
                    bf16x8 kf2[2], qf2[2];
                    { const unsigned ro = RB ^ (unsigned)(hh << 4); kf2[0] = *(const LAS bf16x8*)(L + GL_KI + 8192 * jb + ro); qf2[0] = *(const LAS bf16x8*)(L + GL_QD + 8192 * ibs + ro); }
#pragma unroll
                    for (int s8 = 0; s8 < 8; ++s8) {
                        if (s8 + 1 < 8) { const unsigned ro = RB ^ (unsigned)((2 * (s8 + 1) + hh) << 4); kf2[(s8 + 1) & 1] = *(const LAS bf16x8*)(L + GL_KI + 8192 * jb + ro); qf2[(s8 + 1) & 1] = *(const LAS bf16x8*)(L + GL_QD + 8192 * ibs + ro); }
                        __builtin_amdgcn_sched_barrier(0);
                        sc = MFMA32(kf2[s8 & 1], qf2[s8 & 1], sc); }
                    const int mlim = (jb == ibs) ? l31 : 64;
#pragma unroll
                    for (int q = 0; q < 4; ++q) { float pv[4];
#pragma unroll
                        for (int e = 0; e < 4; ++e) { const int jl = e + 8 * q + 4 * hh; pv[e] = (jl > mlim) ? 0.f : sc[4 * q + e]; }
                        *(LAS u32x2*)(L + GL_PM + 4096 * ibs + (WB ^ (unsigned)((4 * jb + q) << 4))) = (u32x2){pkbf(pv[0], pv[1]), pkbf(pv[2], pv[3])}; }
                }
#pragma unroll
                for (int i2 = 0; i2 < 2; ++i2)
#pragma unroll
                    for (int r = 0; r < 16; ++r) o[i2][r] = 0.f;
                { bf16x8 qf[2][2];
                    { const unsigned ro = RB ^ (unsigned)(hh << 4); qf[0][0] = *(const LAS bf16x8*)(L + GL_QD + ro); qf[0][1] = *(const LAS bf16x8*)(L + GL_QD + 8192 + ro); }
#pragma unroll
                    for (int st = 0; st < 8; ++st) { const int q = st >> 1, s2 = st & 1;
                        if (st + 1 < 8) { const unsigned ro = RB ^ (unsigned)((2 * (st + 1) + hh) << 4); qf[(st + 1) & 1][0] = *(const LAS bf16x8*)(L + GL_QD + ro); qf[(st + 1) & 1][1] = *(const LAS bf16x8*)(L + GL_QD + 8192 + ro); }
                        u32x4 pb; pb.x = pkbf(S[q][8 * s2], S[q][8 * s2 + 1]); pb.y = pkbf(S[q][8 * s2 + 2], S[q][8 * s2 + 3]); pb.z = pkbf(S[q][8 * s2 + 4], S[q][8 * s2 + 5]); pb.w = pkbf(S[q][8 * s2 + 6], S[q][8 * s2 + 7]);
                        const bf16x8 sfr = __builtin_bit_cast(bf16x8, pb);
                        __builtin_amdgcn_sched_barrier(0);
                        o[0] = MFMA32(sfr, qf[st & 1][0], o[0]); o[1] = MFMA32(sfr, qf[st & 1][1], o[1]); } }
                __syncthreads();
                { bf16x8 pf[6];
#pragma unroll
                    for (int st = 0; st < 6; ++st) { const int i2 = st < 2 ? 0 : 1, ks = st < 2 ? st : st - 2; pf[st] = *(const LAS bf16x8*)(L + GL_PM + 4096 * i2 + (PB ^ (unsigned)((2 * ks) << 4))); }
                    __builtin_amdgcn_sched_barrier(0);
#pragma unroll
                    for (int st = 0; st < 6; ++st) { const int i2 = st < 2 ? 0 : 1, ks = st < 2 ? st : st - 2; o[i2] = MFMA32(vb[ks], pf[st], o[i2]); } }
            }
            {
#define KR_FRAG(Q, KS) __builtin_shufflevector(__builtin_amdgcn_ds_read_tr16_b64_v4i16((LAS s16x4*)(L + GL_KR + (TB ^ (unsigned)((4 * (Q)) << 4)) + 256 * (16 * (KS)))), \
                                               __builtin_amdgcn_ds_read_tr16_b64_v4i16((LAS s16x4*)(L + GL_KR + (TB ^ (unsigned)(((4 * (Q)) ^ 1) << 4)) + 256 * (16 * (KS) + 4))), 0, 1, 2, 3, 4, 5, 6, 7)
                bf16x8 kf[2]; kf[0] = KR_FRAG(0, 0);
#pragma unroll
                for (int q = 0; q < 4; ++q) {
                    f32x4 dv[4];
#pragma unroll
                    for (int g4 = 0; g4 < 4; ++g4) dv[g4] = *(const LAS f32x4*)(DEC + 32 * q + 8 * g4 + 4 * hh);
#pragma unroll
                    for (int g4 = 0; g4 < 4; ++g4)
#pragma unroll
                        for (int e = 0; e < 4; ++e) S[q][4 * g4 + e] *= dv[g4][e];
#pragma unroll
                    for (int ks = 0; ks < 4; ++ks) { const int st = 4 * q + ks;
                        if (st + 1 < 16) kf[(st + 1) & 1] = KR_FRAG((st + 1) >> 2, (st + 1) & 3);
                        S[q] = MFMA32(kf[st & 1], vb[ks], S[q]); }
                }
#undef KR_FRAG
            }
            if (!isctx) {
                const unsigned A_ot = GL_OT + (unsigned)l31 * 528u + (unsigned)(32 * w + 4 * hh) * 2u;
#pragma unroll
                for (int i2 = 0; i2 < 2; ++i2)
#pragma unroll
                    for (int rq = 0; rq < 4; ++rq) *(LAS u32x2*)(L + A_ot + (32 * i2) * 528 + 16 * rq) = (u32x2){pkbf(o[i2][4 * rq], o[i2][4 * rq + 1]), pkbf(o[i2][4 * rq + 2], o[i2][4 * rq + 3])};
            }
        }
        __syncthreads();
        { const int tid = tid0; GLA_FLUSH(31); }
#undef GLA_FLUSH
#undef GLA_LOAD
    }
    __syncthreads();
}

template <bool LOADN>
__device__ __forceinline__ void og_rows2(const bf16_t* OF, const bf16_t* OB, const bf16_t* PG, bf16_t* OG, const size_t off0, const u32x4 (&cur)[3][2][2], u32x4 (&nxt)[3][2][2], const float (&gn)[8]) {
    if (LOADN) {
#pragma unroll
        for (int rr = 0; rr < 2; ++rr)
#pragma unroll
            for (int j = 0; j < 2; ++j) { const size_t off = off0 + (size_t)(2 + rr) * D + 512 * j; nxt[0][rr][j] = *(const u32x4*)(OF + off); nxt[1][rr][j] = *(const u32x4*)(OB + off); nxt[2][rr][j] = *(const u32x4*)(PG + off); }
    }
#pragma unroll
    for (int rr = 0; rr < 2; ++rr)
#pragma unroll
        for (int j = 0; j < 2; ++j) {
            float o[8], ob[8], g[8]; unpack8(cur[0][rr][j], o); unpack8(cur[1][rr][j], ob); unpack8(cur[2][rr][j], g);
            float ss = 0.f;
#pragma unroll
            for (int e = 0; e < 8; ++e) { o[e] += ob[e]; ss += o[e] * o[e]; }
            ss = row_sum16(ss); ss = swap16_sum(ss, ss);
            const float rstd = __builtin_amdgcn_rsqf(ss * (1.f / 256.f) + EPS);
            float y[8];
#pragma unroll
            for (int e = 0; e < 8; ++e) y[e] = (o[e] * (rstd * gn[e])) * (g[e] * sigmoidf_(g[e]));
            u32x4 wv; wv.x = cvt_pk_bf16(y[0], y[1]); wv.y = cvt_pk_bf16(y[2], y[3]); wv.z = cvt_pk_bf16(y[4], y[5]); wv.w = cvt_pk_bf16(y[6], y[7]);
            *(u32x4*)(OG + off0 + (size_t)rr * D + 512 * j) = wv; }
}
__device__ __forceinline__ void p_prep(Frame& F, const bool do_og, const bool do_pool) {
    const int gw = F.vcu * NWAVES + F.wave, NGW = F.G * NWAVES, lane = F.lane;
    const bf16_t* OF = (const bf16_t*)F.out; const bf16_t* OB = OF + (size_t)T * D; const bf16_t* PG = (const bf16_t*)(F.ws + WS_PG);
    bf16_t* OG = (bf16_t*)(F.ws + WS_HX);
    float gn[8];
    { const f32x4 g0 = *(const f32x4*)(F.in[13] + 8 * (lane & 31)), g1 = *(const f32x4*)(F.in[13] + 8 * (lane & 31) + 4);
#pragma unroll
        for (int e = 0; e < 4; ++e) { gn[e] = g0[e]; gn[4 + e] = g1[e]; } }
    if (do_og)
    for (int w = gw; w < 2048; w += NGW) {
        u32x4 bufA[3][2][2], bufB[3][2][2];
        const size_t base = (size_t)w * 32 * D + 8 * lane;
#pragma unroll
        for (int rr = 0; rr < 2; ++rr)
#pragma unroll
            for (int j = 0; j < 2; ++j) { const size_t off = base + (size_t)rr * D + 512 * j; bufA[0][rr][j] = *(const u32x4*)(OF + off); bufA[1][rr][j] = *(const u32x4*)(OB + off); bufA[2][rr][j] = *(const u32x4*)(PG + off); }
#pragma unroll 1
        for (int r = 0; r < 32; r += 4) {
            og_rows2<true>(OF, OB, PG, OG, base + (size_t)r * D, bufA, bufB, gn);
            if (r + 4 < 32) og_rows2<true>(OF, OB, PG, OG, base + (size_t)(r + 2) * D, bufB, bufA, gn);
            else og_rows2<false>(OF, OB, PG, OG, base + (size_t)(r + 2) * D, bufB, bufA, gn);
        }
    }
    if (!do_pool) return;
    const bf16_t* PU = (const bf16_t*)(F.ws + WS_PU); bf16_t* PO = (bf16_t*)(F.ws + WS_PO);
    LAS unsigned* uL = (LAS unsigned*)F.lds;
    u32x4 upf[8];
    if (F.vcu < T / 64) {
#pragma unroll
        for (int q = 0; q < 8; ++q) upf[q] = *(const u32x4*)(PU + (size_t)F.vcu * 64 * 512 + (size_t)(F.tid + NTHR * q) * 8); }
    for (int tt = F.vcu; tt < T / 64; tt += F.G) {
        __syncthreads();
#pragma unroll
        for (int q = 0; q < 8; ++q) *(LAS u32x4*)(uL + (F.tid + NTHR * q) * 4) = upf[q];
        if (tt + F.G < T / 64) {
#pragma unroll
            for (int q = 0; q < 8; ++q) upf[q] = *(const u32x4*)(PU + (size_t)(tt + F.G) * 64 * 512 + (size_t)(F.tid + NTHR * q) * 8); }
        __syncthreads();
        const int cp = F.tid & 255, half = F.tid >> 8, gi = cp >> 6, hw = 1 << gi;
        const int p0 = half * 32;
        float s0 = 0.f, s1 = 0.f;
        { const int lo = (p0 - hw) < 0 ? 0 : (p0 - hw), hi = p0 + hw;
            for (int q = lo; q < hi; ++q) { const unsigned wv = uL[q * 256 + cp]; s0 += bf_lo(wv); s1 += bf_hi(wv); } }
        bf16_t* po = PO + ((size_t)tt * 64 + p0) * 512 + 2 * cp;
#pragma unroll 8
        for (int i = 0; i < 32; ++i) {
            const int p = p0 + i; const int lo = (p - hw) < 0 ? 0 : (p - hw), hi = (p + hw) > 64 ? 64 : (p + hw);
            const unsigned self = uL[p * 256 + cp]; const float inv = 1.f / (float)(hi - lo);
            *(unsigned*)(po + (size_t)i * 512) = cvt_pk_bf16(s0 * inv - bf_lo(self), s1 * inv - bf_hi(self));
            const int qa = p + hw, qd = p - hw;
            const unsigned wa = uL[(qa < 64 ? qa : 63) * 256 + cp], wd = uL[(qd >= 0 ? qd : 0) * 256 + cp];
            const float fa = qa < 64 ? 1.f : 0.f, fd = qd >= 0 ? 1.f : 0.f;
            s0 += fa * bf_lo(wa) - fd * bf_lo(wd); s1 += fa * bf_hi(wa) - fd * bf_hi(wd);
        }
    }
    __syncthreads();
}

struct SchedSq {
    static constexpr bool GATHER = false;
    const char* A; const char* B; unsigned lda; int K, G, c;
    __device__ __forceinline__ bool next(int i, pg8::Unit& u) const {
        const int L = i * G + c; if (L >= 1024) return false;
        int pm, pn; pg8::static_tile(L, 256, 4, pm, pn); u.pm = pm; u.pn = pn; u.aux = 0;
        u.A = A + (size_t)pm * 256 * lda; u.B = B + (size_t)pn * 256 * (K * 2); pg8::contig_va(u.va, lda); return true;
    }
};
struct EpiPool {
    static constexpr int NISS = 32; static constexpr bool IDEM = true; static constexpr bool PERM = true;
    const bf16_t* GATES; bf16_t* Z;
    __device__ __forceinline__ void operator()(const f32x4 (&acc)[2][2][4][2], const pg8::Unit& u, int wr, int wc, int fr, int fq) const {
        const size_t rowg = (size_t)u.pm * 256 + wr * 64; const int colb = u.pn * 256 + wc * 64;
        u32x4 gq[2][4][2];
#pragma unroll
        for (int ai = 0; ai < 2; ++ai)
#pragma unroll
            for (int m = 0; m < 4; ++m) ld_lines(GATES + (rowg + ai * 128 + m * 16) * 2048 + colb, 2048, fr, fq, gq[ai][m][0], gq[ai][m][1]);
        asm volatile("" ::: "memory");
#pragma unroll
        for (int ai = 0; ai < 2; ++ai)
#pragma unroll
            for (int m = 0; m < 4; ++m) { const size_t rg = rowg + ai * 128 + m * 16; u32x4 wv[2];
#pragma unroll
                for (int bj = 0; bj < 2; ++bj) { float g[8]; unpack8(gq[ai][m][bj], g); const f32x4 a0 = acc[ai][bj][m][0], a1 = acc[ai][bj][m][1]; f32x4 z0, z1;
#pragma unroll
                    for (int e = 0; e < 4; ++e) { z0[e] = a0[e] * sigmoidf_(g[e]); z1[e] = a1[e] * sigmoidf_(g[4 + e]); }
                    wv[bj] = pack8(z0, z1); }
                st_lines(Z + rg * 1024 + colb, 1024, fr, fq, wv[0], wv[1]); }
    }
};
struct EpiGla {
    static constexpr int NISS = 48; static constexpr bool IDEM = false; static constexpr bool PERM = true;
    const bf16_t* GATES; bf16_t* Z;
    __device__ __forceinline__ void operator()(const f32x4 (&acc)[2][2][4][2], const pg8::Unit& u, int wr, int wc, int fr, int fq) const {
        const size_t rowg = (size_t)u.pm * 256 + wr * 64; const int colb = u.pn * 256 + wc * 64;
#pragma unroll
        for (int ai = 0; ai < 2; ++ai) {
            u32x4 gq[4][2], zq[4][2];
#pragma unroll
            for (int m = 0; m < 4; ++m) { const size_t rg = rowg + ai * 128 + m * 16; ld_lines(GATES + rg * 2048 + 1024 + colb, 2048, fr, fq, gq[m][0], gq[m][1]); ld_lines(Z + rg * 1024 + colb, 1024, fr, fq, zq[m][0], zq[m][1]); }
            asm volatile("" ::: "memory");
#pragma unroll
            for (int m = 0; m < 4; ++m) { const size_t rg = rowg + ai * 128 + m * 16; u32x4 wv[2];
#pragma unroll
                for (int bj = 0; bj < 2; ++bj) { float g[8], zp[8]; unpack8(gq[m][bj], g); unpack8(zq[m][bj], zp); const f32x4 a0 = acc[ai][bj][m][0], a1 = acc[ai][bj][m][1]; f32x4 z0, z1;
#pragma unroll
                    for (int e = 0; e < 4; ++e) { z0[e] = zp[e] + a0[e] * sigmoidf_(g[e]); z1[e] = zp[4 + e] + a1[e] * sigmoidf_(g[4 + e]); }
                    wv[bj] = pack8(z0, z1); }
                st_lines(Z + rg * 1024 + colb, 1024, fr, fq, wv[0], wv[1]); }
        }
    }
};
struct EpiWo {
    static constexpr int NISS = 52; static constexpr bool IDEM = true; static constexpr bool PERM = true;
    const float* X; const float* MOD; bf16_t* X1;
    __device__ __forceinline__ void operator()(const f32x4 (&acc)[2][2][4][2], const pg8::Unit& u, int wr, int wc, int fr, int fq) const {
        const size_t rowg = (size_t)u.pm * 256 + wr * 64; const int colb = u.pn * 256 + wc * 64, col0 = colb + 8 * fq; const int b = u.pm >> 3;
        f32x4 gv[2][2];
#pragma unroll
        for (int bj = 0; bj < 2; ++bj)
#pragma unroll
            for (int n = 0; n < 2; ++n) gv[bj][n] = *(const f32x4*)(MOD + b * 6144 + 2048 + col0 + bj * 32 + n * 4);
#pragma unroll
        for (int ai = 0; ai < 2; ++ai) {
            f32x4 xq[4][2][2];
#pragma unroll
            for (int m = 0; m < 4; ++m) { const float* xr = X + (rowg + ai * 128 + m * 16 + fr) * D + col0;
#pragma unroll
                for (int bj = 0; bj < 2; ++bj) { xq[m][bj][0] = *(const f32x4*)(xr + bj * 32); xq[m][bj][1] = *(const f32x4*)(xr + bj * 32 + 4); } }
            asm volatile("" ::: "memory");
#pragma unroll
            for (int m = 0; m < 4; ++m) { const size_t rg = rowg + ai * 128 + m * 16; u32x4 wv[2];
#pragma unroll
                for (int bj = 0; bj < 2; ++bj) wv[bj] = pack8(xq[m][bj][0] + gv[bj][0] * acc[ai][bj][m][0], xq[m][bj][1] + gv[bj][1] * acc[ai][bj][m][1]);
                st_lines(X1 + rg * D + colb, D, fr, fq, wv[0], wv[1]); }
        }
    }
};

__device__ __forceinline__ float reduce4_rows(float p0, float p1, float p2, float p3) { return row_sum16(swap16_sum(swap32_sum(p0, p2), swap32_sum(p1, p3))); }
__device__ __forceinline__ float reduce8_groups(const float (&p)[8]) {
    const float t0 = swap16_sum(swap32_sum(p[0], p[4]), swap32_sum(p[2], p[6]));
    const float t1 = swap16_sum(swap32_sum(p[1], p[5]), swap32_sum(p[3], p[7]));
    int u = __builtin_bit_cast(int, 0.f);
    const float s0 = t0 + __builtin_bit_cast(float, __builtin_amdgcn_update_dpp(0, __builtin_bit_cast(int, t0), 0x128, 0xf, 0xf, false));
    const float s1 = t1 + __builtin_bit_cast(float, __builtin_amdgcn_update_dpp(0, __builtin_bit_cast(int, t1), 0x128, 0xf, 0xf, false));
    u = __builtin_amdgcn_update_dpp(u, __builtin_bit_cast(int, s0), 0xE4, 0xf, 0x3, false);
    u = __builtin_amdgcn_update_dpp(u, __builtin_bit_cast(int, s1), 0xE4, 0xf, 0xC, false);
    float v = __builtin_bit_cast(float, u);
    v += dpp_mov<0x141>(v); v += dpp_mov<0xB1>(v); v += dpp_mov<0x4E>(v);
    return v;
}
__device__ __forceinline__ float dot16(const f32x4 (&h)[4], const LAS float* wl) {
    f32x2 acc = (f32x2){0.f, 0.f};
#pragma unroll
    for (int q = 0; q < 4; ++q) { const f32x4 wv = *(const LAS f32x4*)(wl + 512 * (q >> 1) + 4 * (q & 1)); acc += (f32x2){h[q][0], h[q][1]} * (f32x2){wv[0], wv[1]}; acc += (f32x2){h[q][2], h[q][3]} * (f32x2){wv[2], wv[3]}; }
    return acc[0] + acc[1];
}
template <bool DRY>
__device__ __forceinline__ void p_norm2_router(Frame& F) {
    const int tid = F.tid, lane = F.lane;
    constexpr int WS = 1028;
    LAS float* WR = (LAS float*)F.lds;
    LAS float* LGT = WR + 36 * WS;
    LAS unsigned* hist = (LAS unsigned*)(LGT + 256 * 12);
    LAS unsigned* baseL = hist + 32;
    LAS float* rebL = (LAS float*)(baseL + 32);
    LAS unsigned char* eidL = (LAS unsigned char*)(rebL + 32);
    LAS unsigned short* rankL = (LAS unsigned short*)(eidL + 512);
    const float* rgw = F.in[19]; const float* rew = F.in[21];
    for (int i = tid; i < 1024 * 4; i += NTHR) WR[(i & 3) * WS + (i >> 2)] = rgw[i];
    for (int i = tid; i < 1024 * 32; i += NTHR) WR[(4 + (i & 31)) * WS + (i >> 5)] = rew[i];
    if (tid < 32) rebL[tid] = F.in[22][tid];
    const float rgbl = F.in[20][lane >> 4];
    const float* mod = (const float*)(F.ws + WS_MOD); const bf16_t* X1 = (const bf16_t*)(F.ws + WS_X1); bf16_t* H2 = (bf16_t*)(F.ws + WS_HX);
    int* EID = (int*)(F.ws + WS_EID); float* EW = (float*)(F.ws + WS_EW); int* SLOT = (int*)(F.ws + WS_POS); int* IDXE = (int*)(F.ws + WS_IDXE);
    for (int blk = F.vcu; blk < T / 256; blk += F.G) {
        __syncthreads();
        if (tid < 32) hist[tid] = 0u;
        __syncthreads();
        const int b = blk >> 3; const size_t row0 = (size_t)blk * 256 + F.wave * 32;
        f32x4 Av[4], Bv[4];
#pragma unroll
        for (int q = 0; q < 4; ++q) { const int c = 8 * lane + 512 * (q >> 1) + 4 * (q & 1); const f32x4 g = *(const f32x4*)(F.in[7] + c), sc = *(const f32x4*)(mod + b * 6144 + 4 * 1024 + c); Av[q] = g * (sc + 1.f); Bv[q] = *(const f32x4*)(mod + b * 6144 + 3 * 1024 + c); }
        u32x4 nxb[4][2];
#pragma unroll
        for (int p = 0; p < 4; ++p)
#pragma unroll
            for (int j = 0; j < 2; ++j) nxb[p][j] = *(const u32x4*)(X1 + (row0 + p) * D + 8 * lane + 512 * j);
        for (int r4 = 0; r4 < 32; r4 += 4)
#pragma unroll
        for (int p = 0; p < 4; ++p) {
            const int r = r4 + p, rl = F.wave * 32 + r;
            const size_t row = row0 + r; f32x4 v[4]; float ss = 0.f;
#pragma unroll
            for (int j = 0; j < 2; ++j) { float f[8]; unpack8(nxb[p][j], f); v[2 * j] = (f32x4){f[0], f[1], f[2], f[3]}; v[2 * j + 1] = (f32x4){f[4], f[5], f[6], f[7]}; }
            if (r + 4 < 32) {
#pragma unroll
                for (int j = 0; j < 2; ++j) nxb[p][j] = *(const u32x4*)(X1 + (row + 4) * D + 8 * lane + 512 * j); }
#pragma unroll
            for (int q = 0; q < 4; ++q) ss += (v[q][0] * v[q][0] + v[q][1] * v[q][1]) + (v[q][2] * v[q][2] + v[q][3] * v[q][3]);
            const float rstd = __builtin_amdgcn_rsqf(wave_sum(ss) * (1.f / D) + EPS);
#pragma unroll
            for (int q = 0; q < 4; ++q) v[q] = v[q] * rstd * Av[q] + Bv[q];
#pragma unroll
            for (int j = 0; j < 2; ++j) {
                if (MOE_FP8) { u32x2 w8; w8.x = pk4_fp8(v[2 * j][0], v[2 * j][1], v[2 * j][2], v[2 * j][3]); w8.y = pk4_fp8(v[2 * j + 1][0], v[2 * j + 1][1], v[2 * j + 1][2], v[2 * j + 1][3]);
                    *(u32x2*)((unsigned char*)H2 + row * D + 8 * lane + 512 * j) = w8; }
                else { u32x4 wv; wv.x = cvt_pk_bf16(v[2 * j][0], v[2 * j][1]); wv.y = cvt_pk_bf16(v[2 * j][2], v[2 * j][3]); wv.z = cvt_pk_bf16(v[2 * j + 1][0], v[2 * j + 1][1]); wv.w = cvt_pk_bf16(v[2 * j + 1][2], v[2 * j + 1][3]);
                    *(u32x4*)(H2 + row * D + 8 * lane + 512 * j) = wv; } }
            const float gx = reduce4_rows(dot16(v, WR + 0 * WS + 8 * lane), dot16(v, WR + 1 * WS + 8 * lane), dot16(v, WR + 2 * WS + 8 * lane), dot16(v, WR + 3 * WS + 8 * lane)) + rgbl;
            if ((lane & 15) == 0) LGT[rl * 12 + (lane >> 4)] = gx;
            const float gmx = swap32_max(swap16_max(gx));
            const unsigned long long gmask = __builtin_amdgcn_ballot_w64(gx == gmx);
            const int gsel = gmask ? (int)(__builtin_ctzll(gmask) >> 4) : 0;
            if (lane == 0) eidL[rl * 2] = (unsigned char)gsel;
            float ep[8];
            { const LAS float* wg = WR + (4 + gsel * 8) * WS + 8 * lane;
#pragma unroll
                for (int o = 0; o < 8; ++o) ep[o] = dot16(v, wg + o * WS); }
            const float ex = reduce8_groups(ep);
            if ((lane & 7) == 0) LGT[rl * 12 + 4 + (lane >> 3)] = ex;
        }
        if (lane < 32) {
            const int rl = F.wave * 32 + lane; const size_t row = row0 + lane;
            const f32x4 gl = *(const LAS f32x4*)(LGT + rl * 12), e0 = *(const LAS f32x4*)(LGT + rl * 12 + 4), e1 = *(const LAS f32x4*)(LGT + rl * 12 + 8);
            const int gsel = eidL[rl * 2];
            const float gmax = fmaxf(fmaxf(gl[0], gl[1]), fmaxf(gl[2], gl[3]));
            const float pgrp = 1.f / (expf(gl[0] - gmax) + expf(gl[1] - gmax) + expf(gl[2] - gmax) + expf(gl[3] - gmax));
            const f32x4 b0 = *(const LAS f32x4*)(rebL + gsel * 8), b1 = *(const LAS f32x4*)(rebL + gsel * 8 + 4);
            float el[8];
#pragma unroll
            for (int o = 0; o < 4; ++o) { el[o] = e0[o] + b0[o]; el[4 + o] = e1[o] + b1[o]; }
            int i0 = 0; float m0 = el[0];
#pragma unroll
            for (int o = 1; o < 8; ++o) if (el[o] > m0) { m0 = el[o]; i0 = o; }
            int i1 = -1; float m1 = -3.0e38f;
#pragma unroll
            for (int o = 0; o < 8; ++o) if (o != i0 && el[o] > m1) { m1 = el[o]; i1 = o; }
            if (i1 < 0) { i1 = (i0 + 1) & 7; m1 = el[0];
#pragma unroll
                for (int o = 1; o < 8; ++o) if (o == i1) m1 = el[o]; }
            const float e1x = expf(m1 - m0), w0 = pgrp / (1.f + e1x), w1 = pgrp * e1x / (1.f + e1x);
            const int x0 = gsel * 8 + i0, x1 = gsel * 8 + i1;
            *(u32x2*)(EID + row * 2) = (u32x2){(unsigned)x0, (unsigned)x1}; *(f32x2*)(EW + row * 2) = (f32x2){w0, w1};
            eidL[rl * 2] = (unsigned char)x0; eidL[rl * 2 + 1] = (unsigned char)x1;
            rankL[rl * 2] = (unsigned short)atomicAdd((unsigned*)&hist[x0], 1u); rankL[rl * 2 + 1] = (unsigned short)atomicAdd((unsigned*)&hist[x1], 1u);
        }
        __syncthreads();
        if (!DRY) {
        if (tid < 32) baseL[tid] = hist[tid] ? __hip_atomic_fetch_add(F.ctl + CW_CNT + tid, hist[tid], __ATOMIC_RELAXED, __HIP_MEMORY_SCOPE_AGENT) : 0u;
        __syncthreads();
        { const int e = eidL[tid]; const unsigned slot = baseL[e] + rankL[tid]; const int token = blk * 256 + (tid >> 1);
            IDXE[(size_t)e * 65536 + slot] = token; SLOT[token * 2 + (tid & 1)] = (int)slot; }
        }
    }
    __syncthreads();
}
__device__ __forceinline__ void moe_tables(Frame& F) {
    volatile LAS unsigned* M = (volatile LAS unsigned*)(F.lds + MISC_OFF);
    __syncthreads();
    if (F.tid == 0) { unsigned o = 0; for (int e = 0; e < 32; ++e) { const unsigned c = __hip_atomic_load(F.ctl + CW_CNT + e, __ATOMIC_RELAXED, __HIP_MEMORY_SCOPE_AGENT); M[64 + e] = c; M[16 + e] = o; o += (c + 255u) & ~255u; } M[48] = o; }
    __syncthreads();
}

struct SchedMoe1 {
    static constexpr bool GATHER = true;
    const char* H2; const char* W13; const int* IDXE; const volatile LAS unsigned* M; int nunits, G, c;
    __device__ __forceinline__ bool next(int i, pg8::Unit& u) const {
        const int L = i * G + c; if (L >= nunits) return false;
        const int tile = L >> 2, pn = L & 3; const unsigned base = (unsigned)tile * 256u; int e = 0;
        for (int q = 1; q < 32; ++q) e += (M[16 + q] <= base) ? 1 : 0;
        e = __builtin_amdgcn_readfirstlane(e);
        const unsigned lb = base - M[16 + e], cnt = M[64 + e];
        u.pm = tile; u.pn = pn; u.aux = e; u.A = H2; u.B = W13 + ((size_t)e * 1024 + (size_t)pn * 256) * (MOE_FP8 ? 1024 : 2048);
        const int tid = threadIdx.x; const int* ie = IDXE + (size_t)e * 65536;
#pragma unroll
        for (int k = 0; k < 2; ++k) { int R, C; pg8::stage_rc(tid * 16 + k * 8192, R, C);
            const unsigned s0 = lb + R, s1 = lb + 128 + R; const int t0 = s0 < cnt ? ie[s0] : 0, t1 = s1 < cnt ? ie[s1] : 0;
            u.va[0][k] = (unsigned)t0 * (MOE_FP8 ? 1024u : 2048u) + (unsigned)C * 2u; u.va[1][k] = (unsigned)t1 * (MOE_FP8 ? 1024u : 2048u) + (unsigned)C * 2u; }
        return true;
    }
};
struct EpiMoe1 {
    static constexpr int NISS = 8; static constexpr bool IDEM = true; static constexpr bool PERM = true;
    bf16_t* HID;
    __device__ __forceinline__ void operator()(const f32x4 (&acc)[2][2][4][2], const pg8::Unit& u, int wr, int wc, int fr, int fq) const {
        const int row0 = u.pm * 256 + wr * 64 + fr, col0 = u.pn * 128 + wc * 32 + 8 * fq;
#pragma unroll
        for (int ai = 0; ai < 2; ++ai)
#pragma unroll
            for (int m = 0; m < 4; ++m) { const size_t row = row0 + ai * 128 + m * 16; float hv[8];
#pragma unroll
                for (int n = 0; n < 2; ++n)
#pragma unroll
                    for (int e = 0; e < 4; ++e) { const float a = acc[ai][0][m][n][e] * (MOE_FP8 ? 1.f / SC_W13 : 1.f), bq = acc[ai][1][m][n][e] * (MOE_FP8 ? (MOE2_FP8 ? SC_HID : 1.f) / SC_W13 : 1.f); hv[4 * n + e] = a * sigmoidf_(a) * bq; }
                if (MOE2_FP8) { u32x2 w8; w8.x = pk4_fp8(hv[0], hv[1], hv[2], hv[3]); w8.y = pk4_fp8(hv[4], hv[5], hv[6], hv[7]); *(u32x2*)((unsigned char*)HID + row * 512 + col0) = w8; }
                else { u32x4 w; w.x = cvt_pk_bf16(hv[0], hv[1]); w.y = cvt_pk_bf16(hv[2], hv[3]); w.z = cvt_pk_bf16(hv[4], hv[5]); w.w = cvt_pk_bf16(hv[6], hv[7]);
                    *(u32x4*)(HID + row * 512 + col0) = w; } }
    }
};
struct SchedMoe2 {
    static constexpr bool GATHER = false;
    const char* HID; const char* W2; const volatile LAS unsigned* M; int nunits, G, c;
    __device__ __forceinline__ bool next(int i, pg8::Unit& u) const {
        const int L = i * G + c; if (L >= nunits) return false;
        const int tile = L >> 2, pn = L & 3; const unsigned base = (unsigned)tile * 256u; int e = 0;
        for (int q = 1; q < 32; ++q) e += (M[16 + q] <= base) ? 1 : 0;
        e = __builtin_amdgcn_readfirstlane(e);
        u.pm = tile; u.pn = pn; u.aux = e; u.A = HID + (size_t)tile * 256 * (MOE2_FP8 ? 512 : 1024); u.B = W2 + ((size_t)e * 1024 + (size_t)pn * 256) * (MOE2_FP8 ? 512 : 1024);
        pg8::contig_va(u.va, MOE2_FP8 ? 512 : 1024); return true;
    }
};
struct EpiMoe2 {
    static constexpr int NISS = 16; static constexpr bool IDEM = true; static constexpr bool PERM = true;
    bf16_t* Y;
    __device__ __forceinline__ void operator()(const f32x4 (&acc)[2][2][4][2], const pg8::Unit& u, int wr, int wc, int fr, int fq) const {
        if (YOUT_FP8) {
            unsigned char* blk8 = (unsigned char*)Y + ((size_t)u.pm * 256 + wr * 64 + fr) * 1024 + u.pn * 256 + wc * 64 + 8 * fq; constexpr float sy = MOE2_FP8 ? 64.f / (SC_HID * SC_W2) : 64.f;
#pragma unroll
            for (int ai = 0; ai < 2; ++ai)
#pragma unroll
                for (int m = 0; m < 4; ++m)
#pragma unroll
                    for (int bj = 0; bj < 2; ++bj) { f32x4 v0 = acc[ai][bj][m][0], v1 = acc[ai][bj][m][1]; if constexpr (sy != 1.f) { v0 = v0 * sy; v1 = v1 * sy; }
                        *(u32x2*)(blk8 + (size_t)(ai * 128 + m * 16) * 1024 + 32 * bj) = (u32x2){pk4_fp8(v0[0], v0[1], v0[2], v0[3]), pk4_fp8(v1[0], v1[1], v1[2], v1[3])}; }
            return;
        }
        bf16_t* blk = Y + ((size_t)u.pm * 256 + wr * 64) * 1024 + u.pn * 256 + wc * 64;
#pragma unroll
        for (int ai = 0; ai < 2; ++ai)
#pragma unroll
            for (int m = 0; m < 4; ++m) st_lines(blk + (size_t)(ai * 128 + m * 16) * 1024, 1024, fr, fq, pack8(acc[ai][0][m][0], acc[ai][0][m][1]), pack8(acc[ai][1][m][0], acc[ai][1][m][1]));
    }
};

__device__ __forceinline__ void p_final(Frame& F) {
    const int gw = F.vcu * NWAVES + F.wave, NGW = F.G * NWAVES, lane = F.lane;
    const float* mod = (const float*)(F.ws + WS_MOD); const bf16_t* Y = (const bf16_t*)(F.ws + WS_Y); const bf16_t* X1 = (const bf16_t*)(F.ws + WS_X1);
    const int* EID = (const int*)(F.ws + WS_EID); const int* SLOT = (const int*)(F.ws + WS_POS); const float* EW = (const float*)(F.ws + WS_EW);
    const volatile LAS unsigned* M = (const volatile LAS unsigned*)(F.lds + MISC_OFF);
    for (int w = gw; w < 2048; w += NGW) {
        const int b = w >> 6; f32x4 g2[4], fg[4];
#pragma unroll
        for (int j = 0; j < 2; ++j)
#pragma unroll
            for (int hf = 0; hf < 2; ++hf) { const int c = 8 * lane + 512 * j + 4 * hf; g2[2 * j + hf] = *(const f32x4*)(mod + b * 6144 + 5 * 1024 + c); fg[2 * j + hf] = *(const f32x4*)(F.in[26] + c); }
        const size_t prow = (size_t)w * 32 + (lane & 31);
        const int p0v = (int)M[16 + EID[prow * 2]] + SLOT[prow * 2], p1v = (int)M[16 + EID[prow * 2 + 1]] + SLOT[prow * 2 + 1]; const float ysc = YOUT_FP8 ? 1.f / 64.f : (MOE2_FP8 ? 1.f / (SC_HID * SC_W2) : 1.f); const float w0v = EW[prow * 2] * ysc, w1v = EW[prow * 2 + 1] * ysc;
        u32x4 nxb[4][2]; u32x4 ny0b[4][2], ny1b[4][2];
#define P12_LOAD(pp, rr) do { const int _p0 = __builtin_amdgcn_readlane(p0v, (rr)), _p1 = __builtin_amdgcn_readlane(p1v, (rr)); const bf16_t* _xr = X1 + ((size_t)w * 32 + (rr)) * D; \
            _Pragma("unroll") for (int j = 0; j < 2; ++j) { const int c = 8 * lane + 512 * j; nxb[pp][j] = *(const u32x4*)(_xr + c); \
                if (YOUT_FP8) { const u32x2 _a = *(const u32x2*)((const unsigned char*)Y + (size_t)_p0 * 1024 + c), _b = *(const u32x2*)((const unsigned char*)Y + (size_t)_p1 * 1024 + c); ny0b[pp][j].x = _a.x; ny0b[pp][j].y = _a.y; ny1b[pp][j].x = _b.x; ny1b[pp][j].y = _b.y; } \
                else { ny0b[pp][j] = *(const u32x4*)(Y + (size_t)_p0 * 1024 + c); ny1b[pp][j] = *(const u32x4*)(Y + (size_t)_p1 * 1024 + c); } } } while (0)
        P12_LOAD(0, 0); P12_LOAD(1, 1); P12_LOAD(2, 2); P12_LOAD(3, 3);
        for (int r4 = 0; r4 < 32; r4 += 4)
#pragma unroll
        for (int p = 0; p < 4; ++p) {
            const int r = r4 + p;
            u32x4 xq[2], y0[2], y1[2];
#pragma unroll
            for (int j = 0; j < 2; ++j) { xq[j] = nxb[p][j]; y0[j] = ny0b[p][j]; y1[j] = ny1b[p][j]; }
            const float w0 = __builtin_bit_cast(float, __builtin_amdgcn_readlane(__builtin_bit_cast(int, w0v), r)), w1 = __builtin_bit_cast(float, __builtin_amdgcn_readlane(__builtin_bit_cast(int, w1v), r));
            if (r + 4 < 32) P12_LOAD(p, r + 4);
            float ss = 0.f; f32x4 v[4];
#pragma unroll
            for (int j = 0; j < 2; ++j) { float a[8], bq[8], xf[8]; unpack8(xq[j], xf);
                if (YOUT_FP8) { float t4[4]; unpack4_fp8(y0[j].x, t4); a[0] = t4[0]; a[1] = t4[1]; a[2] = t4[2]; a[3] = t4[3]; unpack4_fp8(y0[j].y, t4); a[4] = t4[0]; a[5] = t4[1]; a[6] = t4[2]; a[7] = t4[3];
                    unpack4_fp8(y1[j].x, t4); bq[0] = t4[0]; bq[1] = t4[1]; bq[2] = t4[2]; bq[3] = t4[3]; unpack4_fp8(y1[j].y, t4); bq[4] = t4[0]; bq[5] = t4[1]; bq[6] = t4[2]; bq[7] = t4[3]; }
                else { unpack8(y0[j], a); unpack8(y1[j], bq); }
#pragma unroll
                for (int hf = 0; hf < 2; ++hf) { f32x4 t;
#pragma unroll
                    for (int e = 0; e < 4; ++e) t[e] = xf[4 * hf + e] + g2[2 * j + hf][e] * (w0 * a[4 * hf + e] + w1 * bq[4 * hf + e]);
                    v[2 * j + hf] = t; ss += (t[0] * t[0] + t[1] * t[1]) + (t[2] * t[2] + t[3] * t[3]); } }
            const float rstd = 1.f / sqrtf(wave_sum(ss) * (1.f / D) + EPS);
            float* xo = F.out + ((size_t)w * 32 + r) * D;
#pragma unroll
            for (int j = 0; j < 2; ++j) { const int c = 8 * lane + 512 * j; *(f32x4*)(xo + c) = v[2 * j] * rstd * fg[2 * j]; *(f32x4*)(xo + c + 4) = v[2 * j + 1] * rstd * fg[2 * j + 1]; }
        }
#undef P12_LOAD
    }
}

__global__ void __launch_bounds__(NTHR, 2) fwd_kernel(Args args) {
    extern __shared__ __attribute__((aligned(16))) unsigned char lds_raw[];
    Frame F;
    F.lds = (LAS unsigned char*)lds_raw;
    F.tid = threadIdx.x; F.lane = F.tid & 63; F.wave = __builtin_amdgcn_readfirstlane(F.tid >> 6);
    F.G = gridDim.x; { const int bx = blockIdx.x; F.vcu = (F.G % 8 == 0) ? (bx % 8) * (F.G / 8) + bx / 8 : bx; }
    F.ws = args.ws; F.out = args.out; F.ctl = (unsigned*)(args.ws + WS_CTL);
#pragma unroll
    for (int i = 0; i < 27; ++i) F.in[i] = args.in[i];
    volatile LAS unsigned* MISC = (volatile LAS unsigned*)(F.lds + MISC_OFF);
    if (F.tid < 128) MISC[F.tid] = 0u;
    __syncthreads();
    XcdBarrier bar; bar.bar = F.ctl + CW_BAR; bar.x = 0; bar.st = nullptr;
    if (N_LAUNCHES != PER_PHASE) bar = xcd_barrier_post(F.ctl + CW_BAR, MISC + 8);
#define GRID_BAR() do { if (N_LAUNCHES != PER_PHASE) xcd_barrier(bar); } while (0)
#ifdef PROBE_A
    unsigned long long t_a0 = 0, t_a1 = 0, t_b0 = 0, t_b1 = 0;
#define STAMP(k) do { const unsigned long long _t = wall_clock64(); if ((k) == PROBE_A) t_a0 = _t; if ((k) == PROBE_A + 1) t_a1 = _t; if ((k) == PROBE_B) t_b0 = _t; if ((k) == PROBE_B + 1) t_b1 = _t; } while (0)
#else
#define STAMP(k) do {} while (0)
#endif
    const int lo = args.ph_lo, hi = args.ph_hi;
#define IN(k) (lo <= (k) && (k) < hi)
#define BOTH(k) (IN(k) && IN((k) + 1))
#define REP(k) for (int _r = 0; _r < ((k) == PROBE_REP ? 2 : 1); ++_r)
    unsigned char* ws = F.ws;

    STAMP(0);
    if (IN(0)) { REP(0) { p_adaln(F); for (int bq = (int)blockIdx.x - 192; bq >= 0 && bq < 32; bq += 64) p_wpeff_block(F, bq); if (F.G < 224 && blockIdx.x == 0) for (int bq = 0; bq < 32; ++bq) p_wpeff_block(F, bq); p_convert(F, true, CONV_OVERLAP == 0); } if (BOTH(0)) GRID_BAR(); }
    STAMP(1);
    if (IN(1)) { REP(1) p_norm1(F); if (BOTH(1)) GRID_BAR(); }
    STAMP(2);
    if (IN(2)) {
        SchedG1 S{(const char*)(ws + WS_HX), (const char*)(ws + WS_WIN), F.G, (int)blockIdx.x}; EpiG1 E{ws};
        const bool par = ((blockIdx.x >> 3) & 1) != 0;
        if (CONV_OVERLAP && par) { p_convert(F, false, true); __syncthreads(); }
        REP(2) pg8::gemm_phase<EpiG1, SchedG1, true>(F.lds, 1024, S, E);
        if (CONV_OVERLAP && !par) { __syncthreads(); p_convert(F, false, true); }
        if (BOTH(2)) GRID_BAR();
    }
    STAMP(3);
    if (IN(3)) {
        const bool par = ((blockIdx.x >> 3) & 1) != 0;
        if (POOL_OVERLAP && par) p_prep(F, false, true);
        REP(3) p_gla_chunk(F);
        if (POOL_OVERLAP && !par) p_prep(F, false, true);
        if (BOTH(3)) GRID_BAR();
    }
    STAMP(4);
    if (IN(4) && !(OG_OVERLAP && POOL_OVERLAP)) { REP(4) p_prep(F, OG_OVERLAP == 0, POOL_OVERLAP == 0); if (BOTH(4)) GRID_BAR(); }
    STAMP(5);
    if (IN(5)) {
        SchedSq S{(const char*)(ws + WS_PO), (const char*)(ws + WS_WP), 1024u, 512, F.G, (int)blockIdx.x}; EpiPool E{(const bf16_t*)(ws + WS_PGATES), (bf16_t*)(ws + WS_Z)};
        if (OG_OVERLAP && ((blockIdx.x >> 3) & 1)) p_prep(F, true, false);
        REP(5) pg8::gemm_phase<EpiPool, SchedSq, true>(F.lds, 512, S, E);
        if (OG_OVERLAP && !((blockIdx.x >> 3) & 1)) p_prep(F, true, false);
        asm volatile("s_waitcnt vmcnt(0)" ::: "memory"); __syncthreads();
        if (OG_OVERLAP && BOTH(5)) GRID_BAR();
    }
    STAMP(6);
    if (IN(6)) {
        SchedSq S{(const char*)(ws + WS_HX), (const char*)(ws + WS_WGLA), 2048u, 1024, F.G, (int)blockIdx.x}; EpiGla E{(const bf16_t*)(ws + WS_PGATES), (bf16_t*)(ws + WS_Z)};
        pg8::gemm_phase<EpiGla, SchedSq, true>(F.lds, 1024, S, E);
        if (BOTH(6)) GRID_BAR();
    }
    STAMP(7);
    if (IN(7)) {
        SchedSq S{(const char*)(ws + WS_Z), (const char*)(ws + WS_WO), 2048u, 1024, F.G, (int)blockIdx.x}; EpiWo E{F.in[0], (const float*)(ws + WS_MOD), (bf16_t*)(ws + WS_X1)};
        REP(7) pg8::gemm_phase<EpiWo, SchedSq, true>(F.lds, 1024, S, E);
        if (BOTH(7)) GRID_BAR();
    }
    STAMP(8);
    if (IN(8)) { if (PROBE_REP == 8) p_norm2_router<true>(F); p_norm2_router<false>(F); if (BOTH(8)) GRID_BAR(); }
    STAMP(9);
    if (IN(9)) {
        moe_tables(F);
        const volatile LAS unsigned* M = (const volatile LAS unsigned*)(F.lds + MISC_OFF); const int nt = (int)(M[48] >> 8);
        SchedMoe1 S{(const char*)(ws + WS_HX), (const char*)(ws + WS_W13), (const int*)(ws + WS_IDXE), M, nt * 4, F.G, F.vcu}; EpiMoe1 E{(bf16_t*)(ws + WS_HID)};
        REP(9) pg8::gemm_phase<EpiMoe1, SchedMoe1, true, MOE_FP8 != 0>(F.lds, MOE_FP8 ? 512 : 1024, S, E);
        if (BOTH(9)) GRID_BAR();
    }
    STAMP(10);
    if (IN(10)) {
        moe_tables(F);
        const volatile LAS unsigned* M = (const volatile LAS unsigned*)(F.lds + MISC_OFF); const int nt = (int)(M[48] >> 8);
        SchedMoe2 S{(const char*)(ws + WS_HID), (const char*)(ws + WS_W2), M, nt * 4, F.G, F.vcu}; EpiMoe2 E{(bf16_t*)(ws + WS_Y)};
        REP(10) pg8::gemm_phase<EpiMoe2, SchedMoe2, true, MOE2_FP8 != 0>(F.lds, MOE2_FP8 ? 256 : 512, S, E);
        if (BOTH(10)) GRID_BAR();
    }
    STAMP(11);
    if (IN(11)) { moe_tables(F); REP(11) p_final(F); }
    STAMP(12);
#ifdef PROBE_A
    {
        if (blockIdx.x == 0 && F.tid == 0) { float* pr = (float*)(F.ws + WS_TILEE + 4096); pr[0] = (float)(t_a1 - t_a0) * 0.01f; pr[1] = (float)(t_b1 - t_b0) * 0.01f; }
        GRID_BAR();
        const float* pr = (const float*)(F.ws + WS_TILEE + 4096); const float va = sqrtf(__hip_atomic_load(pr, __ATOMIC_RELAXED, __HIP_MEMORY_SCOPE_AGENT)), vb = __hip_atomic_load(pr + 1, __ATOMIC_RELAXED, __HIP_MEMORY_SCOPE_AGENT);
        for (size_t i = (size_t)blockIdx.x * NTHR + F.tid; i < (size_t)T * D; i += (size_t)F.G * NTHR) F.out[i] = (i == 0) ? vb : va;
    }
#endif
#undef IN
#undef BOTH
#undef GRID_BAR
}

extern "C" void kernel_launch(void* const* d_in, const int* in_sizes, int n_in, void* d_out, int out_size, void* d_ws, size_t ws_size, hipStream_t stream) {
    static int grid = 0;
    if (grid == 0) {
        if (n_in != 27 || in_sizes[0] != T * D || out_size != T * D || ws_size < WS_END) { fprintf(stderr, "kernel_launch: unexpected shapes: n_in %d in0 %d out %d ws %zu (need %zu); nothing launched\n", n_in, n_in > 0 ? in_sizes[0] : -1, out_size, ws_size, (size_t)WS_END); grid = -1; return; }
        int dev = 0, cus = 0, per_cu = 0;
        if (hipGetDevice(&dev) != hipSuccess || hipDeviceGetAttribute(&cus, hipDeviceAttributeMultiprocessorCount, dev) != hipSuccess) { grid = -1; return; }
        if (hipFuncSetAttribute((const void*)fwd_kernel, hipFuncAttributeMaxDynamicSharedMemorySize, LDS_BYTES) != hipSuccess) { fprintf(stderr, "kernel_launch: hipFuncSetAttribute failed\n"); grid = -1; return; }
        if (hipOccupancyMaxActiveBlocksPerMultiprocessor(&per_cu, (const void*)fwd_kernel, NTHR, LDS_BYTES) != hipSuccess || per_cu < 1) fprintf(stderr, "kernel_launch: occupancy query reports %d\n", per_cu);
        (void)hipGetLastError();
        grid = cus;
    }
    if (grid < 0) return;
    if (hipMemsetAsync((char*)d_ws + WS_CTL, 0, CTL_ZERO_BYTES, stream) != hipSuccess) return;
    Args a{};
    for (int i = 0; i < 27; ++i) a.in[i] = (const float*)d_in[i];
    a.out = (float*)d_out; a.ws = (unsigned char*)d_ws;
    if (N_LAUNCHES == 1) { a.ph_lo = 0; a.ph_hi = PER_PHASE; hipLaunchKernelGGL(fwd_kernel, dim3(grid), dim3(NTHR), LDS_BYTES, stream, a); }
    else for (int p = 0; p < PER_PHASE; ++p) { a.ph_lo = p; a.ph_hi = p + 1; hipLaunchKernelGGL(fwd_kernel, dim3(grid), dim3(NTHR), LDS_BYTES, stream, a); }
}
```

```cpp
#include <hip/hip_runtime.h>
#include <cstdio>
#include <cstdint>

#define PROBE_REP -1
#ifndef MK_N_LAUNCHES
#define MK_N_LAUNCHES 1
#endif

#ifndef MOE_FP8
#define MOE_FP8 1
#endif
#ifndef YOUT_FP8
#define YOUT_FP8 1
#endif
#ifndef OG_OVERLAP
#define OG_OVERLAP 1
#define POOL_OVERLAP 1
#define CONV_OVERLAP 1
#endif
#ifndef MOE2_FP8
#define MOE2_FP8 1
#endif
#define LAS __attribute__((address_space(3)))
#define GAS __attribute__((address_space(1)))
typedef unsigned short bf16_t;
typedef short bf16x8 __attribute__((ext_vector_type(8)));
typedef float f32x4 __attribute__((ext_vector_type(4)));
typedef float f32x2 __attribute__((ext_vector_type(2)));
typedef unsigned u32x4 __attribute__((ext_vector_type(4)));
typedef unsigned u32x2 __attribute__((ext_vector_type(2)));

constexpr int D = 1024, BATCH = 32, SEQ = 2048, T = BATCH * SEQ, CTXL = 256, TC = BATCH * CTXL;
constexpr int DIN = 5664, NPAD = 5888;
constexpr int NE = 32, DE = 512;
constexpr int MAXTILES = 544, NPMAX = MAXTILES * 256;
constexpr float EPS = 1e-6f;
constexpr float SC_W13 = 64.f, SC_W2 = 8.f, SC_HID = 8.f;
constexpr int NWAVES = 8, NTHR = 512;
constexpr int PER_PHASE = 12;
constexpr int N_LAUNCHES = MK_N_LAUNCHES;

constexpr size_t MiB = 1u << 20;
constexpr size_t WS_CTL = 0, CTL_ZERO_BYTES = 32768;
constexpr size_t WS_MOD = 1 * MiB;
constexpr size_t WS_EID = 2 * MiB;
constexpr size_t WS_EW = WS_EID + 512 * 1024;
constexpr size_t WS_POS = 3 * MiB;
constexpr size_t WS_IDX = WS_POS + 512 * 1024;
constexpr size_t WS_TILEE = 4 * MiB + 512 * 1024;
constexpr size_t WS_LR = 5 * MiB;
constexpr size_t WS_WIN = 14 * MiB;
constexpr size_t WS_WP = 26 * MiB;
constexpr size_t WS_WGLA = 27 * MiB;
constexpr size_t WS_WO = 29 * MiB;
constexpr size_t WS_W13 = 32 * MiB;
constexpr size_t WS_W2 = 96 * MiB;
constexpr size_t WS_HX = 128 * MiB;
constexpr size_t WS_PU = 272 * MiB;
constexpr size_t WS_PQKV = 336 * MiB;
constexpr size_t WS_PO = 272 * MiB;
constexpr size_t WS_Z = 400 * MiB;
constexpr size_t WS_HID = 272 * MiB;
constexpr size_t WS_PG = 592 * MiB;
constexpr size_t WS_PGATES = 720 * MiB;
constexpr size_t WS_Y = 592 * MiB;
constexpr size_t WS_PKVC = 976 * MiB;
constexpr size_t WS_X1 = 864 * MiB;
constexpr size_t WS_IDXE = 5 * MiB;
constexpr size_t WS_END = 1000 * MiB;
static_assert(WS_HID + (size_t)NPMAX * 512 * 2 <= WS_PG && WS_Y + (size_t)NPMAX * 1024 * 2 <= WS_PKVC, "ws map");
constexpr int CW_CNT = 64;
constexpr int CW_CUR = 128;
constexpr int CW_NT = 192;
constexpr int CW_BAR = 4096;

constexpr int LDS_BYTES = 163840;
constexpr int MISC_OFF = LDS_BYTES - 512;

__device__ __forceinline__ unsigned cvt_pk_bf16(float lo, float hi) { unsigned r; asm volatile("v_cvt_pk_bf16_f32 %0, %1, %2" : "=v"(r) : "v"(lo), "v"(hi)); return r; }
__device__ __forceinline__ float clamp_e4m3(float x) { return __builtin_amdgcn_fmed3f(x, -448.f, 448.f); }
__device__ __forceinline__ unsigned pk4_fp8(float a, float b, float c, float d) { int p = __builtin_amdgcn_cvt_pk_fp8_f32(clamp_e4m3(a), clamp_e4m3(b), 0, false); p = __builtin_amdgcn_cvt_pk_fp8_f32(clamp_e4m3(c), clamp_e4m3(d), p, true); return (unsigned)p; }
__device__ __forceinline__ void unpack4_fp8(unsigned w, float (&f)[4]) { const f32x2 lo = __builtin_amdgcn_cvt_pk_f32_fp8((int)w, false), hi = __builtin_amdgcn_cvt_pk_f32_fp8((int)w, true); f[0] = lo[0]; f[1] = lo[1]; f[2] = hi[0]; f[3] = hi[1]; }
__device__ __forceinline__ float bf_lo(unsigned w) { return __uint_as_float(w << 16); }
__device__ __forceinline__ float bf_hi(unsigned w) { return __uint_as_float(w & 0xffff0000u); }
__device__ __forceinline__ float bf2f(bf16_t h) { return __uint_as_float(((unsigned)h) << 16); }
template <int CTRL> __device__ __forceinline__ float dpp_mov(float v) { return __builtin_bit_cast(float, __builtin_amdgcn_update_dpp(0, __builtin_bit_cast(int, v), CTRL, 0xf, 0xf, false)); }
__device__ __forceinline__ float row_sum16(float v) { v += dpp_mov<0xB1>(v); v += dpp_mov<0x4E>(v); v += dpp_mov<0x124>(v); v += dpp_mov<0x128>(v); return v; }
__device__ __forceinline__ float rlane(float v, int l) { return __builtin_bit_cast(float, __builtin_amdgcn_readlane(__builtin_bit_cast(int, v), l)); }
__device__ __forceinline__ float wave_sum(float v) { v = row_sum16(v); return (rlane(v, 0) + rlane(v, 16)) + (rlane(v, 32) + rlane(v, 48)); }
__device__ __forceinline__ float half_sum(float v, int lane) { v = row_sum16(v); const float lo = rlane(v, 0) + rlane(v, 16), hi = rlane(v, 32) + rlane(v, 48); return lane < 32 ? lo : hi; }
__device__ __forceinline__ float xchg32(float v, int lane) { const auto r = __builtin_amdgcn_permlane32_swap(__builtin_bit_cast(unsigned, v), __builtin_bit_cast(unsigned, v), false, false); return __builtin_bit_cast(float, lane < 32 ? r[1] : r[0]); }
__device__ __forceinline__ void pswap32(float& a, float& b) { asm volatile("s_nop 1\n\tv_permlane32_swap_b32 %0, %1" : "+v"(a), "+v"(b)); }
__device__ __forceinline__ void pswap16(float& a, float& b) { asm volatile("s_nop 1\n\tv_permlane16_swap_b32 %0, %1" : "+v"(a), "+v"(b)); }
__device__ __forceinline__ float swap32_sum(float a, float b) { pswap32(a, b); return a + b; }
__device__ __forceinline__ float swap16_sum(float a, float b) { pswap16(a, b); return a + b; }
__device__ __forceinline__ float swap32_max(float a) { float b = a; pswap32(a, b); return fmaxf(a, b); }
__device__ __forceinline__ float swap16_max(float a) { float b = a; pswap16(a, b); return fmaxf(a, b); }
__device__ __forceinline__ float sigmoidf_(float x) { return __builtin_amdgcn_rcpf(1.f + __expf(-x)); }
#define LDS_WAIT() asm volatile("s_waitcnt lgkmcnt(0)" ::: "memory")
__device__ __forceinline__ void unpack8(const u32x4 w, float (&f)[8]) { f[0] = bf_lo(w.x); f[1] = bf_hi(w.x); f[2] = bf_lo(w.y); f[3] = bf_hi(w.y); f[4] = bf_lo(w.z); f[5] = bf_hi(w.z); f[6] = bf_lo(w.w); f[7] = bf_hi(w.w); }

#define XB_TMO      128
#define XB_XCNT(j)  (256  + 64 * (j))
#define XB_XSUB(j)  (1280 + 64 * (j))
#define XB_XGEN(j)  (2304 + 64 * (j))
#define XB_TOP      3328
#define XB_TOPGEN   3392
#define XCD_BAR_WORDS 3456
#define XB_SPIN_CAP (1u << 18)
__device__ __forceinline__ unsigned xb_ld(unsigned* p)              { return __hip_atomic_load(p, __ATOMIC_RELAXED, __HIP_MEMORY_SCOPE_AGENT); }
__device__ __forceinline__ unsigned xb_add(unsigned* p, unsigned v) { return __hip_atomic_fetch_add(p, v, __ATOMIC_RELAXED, __HIP_MEMORY_SCOPE_AGENT); }
__device__ __forceinline__ unsigned xb_xcc_id() { return (unsigned)__builtin_amdgcn_s_getreg((3 << 11) | 20) & 0xFu; }
#define XB_SPIN(cond, bar) do { unsigned _sp = 0; while (cond) { __builtin_amdgcn_s_sleep(1); \
    if ((++_sp & 255u) == 0u) { if (xb_ld(&(bar)[XB_TMO])) break; if (_sp > XB_SPIN_CAP) { atomicAdd(&(bar)[XB_TMO], 1u); break; } } } } while (0)
struct XcdBarrier { unsigned* bar; unsigned x; volatile LAS unsigned* st; };
__device__ __forceinline__ XcdBarrier xcd_barrier_post(unsigned* bar, volatile LAS unsigned* st) {
    XcdBarrier b; b.bar = bar; b.x = xb_xcc_id(); b.st = st;
    if (threadIdx.x == 0) (void)xb_add(&bar[XB_XCNT(b.x)], 1u);
    return b;
}
__device__ __forceinline__ void xcd_barrier_complete(unsigned* bar, unsigned x, unsigned& nloc, unsigned& nx) {
    const unsigned G = gridDim.x * gridDim.y * gridDim.z;
    unsigned sum, cnt, mine, sp = 0u;
    for (;;) {
        sum = 0u; cnt = 0u; mine = 0u;
#pragma unroll
        for (unsigned j = 0; j < 16; ++j) { const unsigned c = xb_ld(&bar[XB_XCNT(j)]); sum += c; cnt += (c > 0u) ? 1u : 0u; mine = (j == x) ? c : mine; }
        if (sum == G) break;
        __builtin_amdgcn_s_sleep(1);
        if ((++sp & 255u) == 0u) { if (xb_ld(&bar[XB_TMO])) break; if (sp > XB_SPIN_CAP) { atomicAdd(&bar[XB_TMO], 1u); break; } }
    }
    nloc = mine > 0u ? mine : 1u; nx = cnt > 0u ? cnt : 1u;
}
__device__ __forceinline__ void xcd_barrier(const XcdBarrier& b) {
    asm volatile("s_waitcnt vmcnt(0)" ::: "memory");
    __syncthreads();
    if (threadIdx.x == 0) {
        unsigned* bar = b.bar;
        __builtin_amdgcn_s_waitcnt(0);
        unsigned nloc = b.st[0], nx = b.st[1];
        if (nloc == 0u) { xcd_barrier_complete(bar, b.x, nloc, nx); b.st[0] = nloc; b.st[1] = nx; }
        const unsigned old = xb_add(&bar[XB_XSUB(b.x)], 1u);
        const unsigned gen = old / nloc;
        if (old + 1u == (gen + 1u) * nloc) {
            __builtin_amdgcn_fence(__ATOMIC_RELEASE, "agent");
            asm volatile("s_waitcnt vmcnt(0)" ::: "memory");
            const unsigned og = xb_add(&bar[XB_TOP], 1u);
            const unsigned tg = og / nx;
            if (og + 1u == (tg + 1u) * nx) xb_add(&bar[XB_TOPGEN], 1u);
            else XB_SPIN(xb_ld(&bar[XB_TOPGEN]) == tg, bar);
            __builtin_amdgcn_fence(__ATOMIC_ACQUIRE, "agent");
            xb_add(&bar[XB_XGEN(b.x)], 1u);
            asm volatile("s_waitcnt vmcnt(0)" ::: "memory");
        } else {
            XB_SPIN(xb_ld(&bar[XB_XGEN(b.x)]) == gen, bar);
            __builtin_amdgcn_fence(__ATOMIC_ACQUIRE, "agent");
            asm volatile("s_waitcnt vmcnt(0)" ::: "memory");
        }
    }
    __syncthreads();
}

namespace pg8 {
constexpr int BM = 256, BK = 64, HALF = 128, HTB = HALF * BK * 2, STAGE_BYTES = 8 * HTB, NXCD = 8, WGM = 8;
__host__ __device__ __forceinline__ int lds_byte(int r, int c) { const int st = (r >> 4) * 2 + (c >> 5), rr = r & 15, cc = c & 31, ob = rr * 64 + cc * 2; return st * 1024 + (ob ^ (((ob >> 9) & 1) << 5)); }
__host__ __device__ __forceinline__ void stage_rc(int b, int& R, int& C) { const int st = b / 1024, sb = b % 1024, swz = sb ^ (((sb >> 9) & 1) << 5); R = (st >> 1) * 16 + swz / 64; C = (st & 1) * 32 + (swz % 64) / 2; }
__host__ __device__ __forceinline__ int perm32(int rho) { const int n = rho >> 4, i = rho & 15; return 8 * (i >> 2) + 4 * n + (i & 3); }

typedef int v8i_t __attribute__((ext_vector_type(8)));
typedef int v4i_t __attribute__((ext_vector_type(4)));
__device__ __forceinline__ v8i_t mk8(const bf16x8 lo, const bf16x8 hi) { return __builtin_shufflevector(__builtin_bit_cast(v4i_t, lo), __builtin_bit_cast(v4i_t, hi), 0, 1, 2, 3, 4, 5, 6, 7); }
struct Unit { const char* A; const char* B; unsigned va[2][2]; int pm, pn, aux; };

__device__ __forceinline__ void static_tile(int L, int nM, int nN, int& pm, int& pn) {
    const int nwg = nM * nN; int wgid = L; { const int q = nwg / NXCD, r = nwg % NXCD, xcd = wgid % NXCD, off = wgid / NXCD; wgid = (xcd < r ? xcd * (q + 1) : r * (q + 1) + (xcd - r) * q) + off; }
    const int nig = WGM * nN, gid = wgid / nig, fm = gid * WGM, gsz = (nM - fm) < WGM ? (nM - fm) : WGM;
    pm = fm + ((wgid % nig) % gsz); pn = (wgid % nig) / gsz;
}

template <class Epi, class Sched, bool ALIGN_EPI = true, bool FP8 = false>
__device__ __forceinline__ void gemm_phase(LAS unsigned char* lds, const int K, const Sched& S, const Epi& E) {
    const int tid = threadIdx.x, wid = __builtin_amdgcn_readfirstlane(tid >> 6), lane = tid & 63, wr = wid >> 2, wc = wid & 3, fr = lane & 15, fq = lane >> 4;
    const int nt = K / BK;
    unsigned vb[2];
#pragma unroll
    for (int i = 0; i < 2; ++i) { int R, C; stage_rc(tid * 16 + i * 8192, R, C); const int Rb = Epi::PERM ? ((R >> 5) * 64 + perm32(R & 31)) : R; vb[i] = (unsigned)(Rb * K + C) * 2u; }
    const size_t kstep = (size_t)(BK * 2);
    const size_t hstep = Epi::PERM ? (size_t)32 * K * 2 : (size_t)HALF * K * 2;
    const unsigned ldsw = (unsigned)wid * 1024u;
    int aoffk[2], boffk[2];
#pragma unroll
    for (int k = 0; k < 2; ++k) { aoffk[k] = FP8 ? lds_byte(wr * 64 + fr, fq * 16 + 8 * k) : lds_byte(wr * 64 + fr, fq * 8) + k * 1024; boffk[k] = FP8 ? lds_byte(wc * 32 + fr, fq * 16 + 8 * k) : lds_byte(wc * 32 + fr, fq * 8) + k * 1024; }
#define PG8_SA(b, h) (((b) * 2 + (h)) * HTB)
#define PG8_SB(b, h) ((4 + (b) * 2 + (h)) * HTB)
#define PG8_STAGEA(bufoff, gbase, VA, h) do { _Pragma("unroll") for (int _i = 0; _i < 2; ++_i) \
        __builtin_amdgcn_global_load_lds((const unsigned*)((const char*)(gbase) + (VA)[h][_i]), (LAS unsigned*)(lds + (bufoff) + ldsw + _i * 8192), 16, 0, 0); } while (0)
#define PG8_STAGEB(bufoff, gbase) do { _Pragma("unroll") for (int _i = 0; _i < 2; ++_i) \
        __builtin_amdgcn_global_load_lds((const unsigned*)((const char*)(gbase) + vb[_i]), (LAS unsigned*)(lds + (bufoff) + ldsw + _i * 8192), 16, 0, 0); } while (0)
#define PG8_LDA(dst, b, h) do { _Pragma("unroll") for (int m = 0; m < 4; ++m) { if constexpr (FP8) { const v4i_t _lo = *(const LAS v4i_t*)(lds + PG8_SA(b, h) + aoffk[0] + m * 2048), _hi = *(const LAS v4i_t*)(lds + PG8_SA(b, h) + aoffk[1] + m * 2048); \
            dst##8[m] = __builtin_shufflevector(_lo, _hi, 0, 1, 2, 3, 4, 5, 6, 7); } else { _Pragma("unroll") for (int k = 0; k < 2; ++k) dst[m][k] = *(const LAS bf16x8*)(lds + PG8_SA(b, h) + aoffk[k] + m * 2048); } } } while (0)
#define PG8_LDB(dst, b, h) do { _Pragma("unroll") for (int n = 0; n < 2; ++n) { if constexpr (FP8) { const v4i_t _lo = *(const LAS v4i_t*)(lds + PG8_SB(b, h) + boffk[0] + n * 2048), _hi = *(const LAS v4i_t*)(lds + PG8_SB(b, h) + boffk[1] + n * 2048); \
            dst##8[n] = __builtin_shufflevector(_lo, _hi, 0, 1, 2, 3, 4, 5, 6, 7); } else { _Pragma("unroll") for (int k = 0; k < 2; ++k) dst[n][k] = *(const LAS bf16x8*)(lds + PG8_SB(b, h) + boffk[k] + n * 2048); } } } while (0)
#define PG8_MMA(ai, bj, At, Bt) do { if constexpr (FP8) __builtin_amdgcn_sched_barrier(0); __builtin_amdgcn_s_setprio(1); _Pragma("unroll") for (int m = 0; m < 4; ++m) _Pragma("unroll") for (int n = 0; n < 2; ++n) { \
        if constexpr (FP8) { acc[ai][bj][m][n] = __builtin_amdgcn_mfma_scale_f32_16x16x128_f8f6f4(Bt##8[n], At##8[m], acc[ai][bj][m][n], 0, 0, 0, 0x7F7F7F7F, 0, 0x7F7F7F7F); } \
        else { _Pragma("unroll") for (int k = 0; k < 2; ++k) acc[ai][bj][m][n] = __builtin_amdgcn_mfma_f32_16x16x32_bf16(Bt[n][k], At[m][k], acc[ai][bj][m][n], 0, 0, 0); } } __builtin_amdgcn_s_setprio(0); if constexpr (FP8) { asm volatile("" : "+v"(acc[ai][bj][0][0]), "+v"(acc[ai][bj][0][1]), "+v"(acc[ai][bj][1][0]), "+v"(acc[ai][bj][1][1]), "+v"(acc[ai][bj][2][0]), "+v"(acc[ai][bj][2][1]), "+v"(acc[ai][bj][3][0]), "+v"(acc[ai][bj][3][1])); __builtin_amdgcn_sched_barrier(0); } } while (0)
#define PG8_WAIT_V(n) asm volatile("s_waitcnt vmcnt(" #n ")" ::: "memory")
#define PG8_WAIT_VN(N) asm volatile("s_waitcnt vmcnt(%0)" :: "n"(N) : "memory")
#define PG8_WAIT_VR(flag, N) asm volatile("s_waitcnt vmcnt(%1)\n\ts_cmp_lg_u32 %0, 0\n\ts_cbranch_scc1 .Lrx%=\n\ts_waitcnt vmcnt(8)\n.Lrx%=:" :: "s"(flag), "n"(N) : "memory", "scc")
#define PG8_WAIT_L(n) asm volatile("s_waitcnt lgkmcnt(" #n ")" ::: "memory")
#define PG8_BAR __builtin_amdgcn_s_barrier()
#define PG8_SCHED __builtin_amdgcn_sched_barrier(0)
    Unit cur, nxt; int ui = 0;
    if (!S.next(0, cur)) return;
    f32x4 acc[2][2][4][2];
#pragma unroll
    for (int a = 0; a < 2; ++a)
#pragma unroll
        for (int b = 0; b < 2; ++b)
#pragma unroll
            for (int m = 0; m < 4; ++m)
#pragma unroll
                for (int n = 0; n < 2; ++n) acc[a][b][m][n] = (f32x4){0.f, 0.f, 0.f, 0.f};
    bf16x8 At[4][2], B0[2][2], B1[2][2];
    v8i_t At8[4], B08[2], B18[2];
    const char* cA = cur.A; const char* cB = cur.B;
    PG8_STAGEB(PG8_SB(0, 0), cB); PG8_STAGEB(PG8_SB(0, 1), cB + hstep); PG8_STAGEA(PG8_SA(0, 0), cA, cur.va, 0); PG8_STAGEA(PG8_SA(0, 1), cA, cur.va, 1);
    if (wr == 1) PG8_BAR;
    PG8_WAIT_V(2); PG8_BAR;
    PG8_STAGEB(PG8_SB(1, 0), cB + kstep); PG8_STAGEA(PG8_SA(1, 0), cA + kstep, cur.va, 0); PG8_STAGEB(PG8_SB(1, 1), cB + hstep + kstep);
    PG8_WAIT_V(6); PG8_BAR;
    for (;;) {
#ifdef PROBE_KDUP
        const bool has_next = S.next((ui + 1) >> 1, nxt);
#else
        const bool has_next = S.next(ui + 1, nxt);
#endif
        if (!has_next) { nxt.A = cA; nxt.B = cB; if constexpr (Sched::GATHER) { nxt.va[0][0] = cur.va[0][0]; nxt.va[0][1] = cur.va[0][1]; nxt.va[1][0] = cur.va[1][0]; nxt.va[1][1] = cur.va[1][1]; } }
        const char* nA = nxt.A; const char* nB = nxt.B;
#pragma unroll 1
        for (int t = 0; t < nt; t += 2) {
            const bool last = (t == nt - 2);
#ifdef PROBE_KDUP
            const int relax = __builtin_amdgcn_readfirstlane(((t == 0) && (ui > 0) && ((ui & 1) == 0)) ? 1 : 0);
#else
            const int relax = __builtin_amdgcn_readfirstlane(((t == 0) && (ui > 0)) ? 1 : 0);
#endif
            const char* a1 = cA + (size_t)(t + 1) * kstep;
            const char* a2 = last ? nA : cA + (size_t)(t + 2) * kstep; const char* b2 = last ? nB : cB + (size_t)(t + 2) * kstep;
            const char* a3 = a2 + kstep; const char* b3 = b2 + kstep;
            if constexpr (FP8) { asm volatile("" : "+s"(a1), "+s"(a2), "+s"(b2), "+s"(a3), "+s"(b3)); }
            unsigned v2[2][2];
            if constexpr (Sched::GATHER) { v2[0][0] = last ? nxt.va[0][0] : cur.va[0][0]; v2[0][1] = last ? nxt.va[0][1] : cur.va[0][1]; v2[1][0] = last ? nxt.va[1][0] : cur.va[1][0]; v2[1][1] = last ? nxt.va[1][1] : cur.va[1][1]; }
            else { v2[0][0] = cur.va[0][0]; v2[0][1] = cur.va[0][1]; v2[1][0] = cur.va[1][0]; v2[1][1] = cur.va[1][1]; }
            PG8_LDB(B0, 0, 0); PG8_LDB(B1, 0, 1); PG8_SCHED; PG8_LDA(At, 0, 0);
            PG8_STAGEA(PG8_SA(1, 1), a1, cur.va, 1); PG8_WAIT_VR(relax, 8 + Epi::NISS);
            PG8_WAIT_L(0); PG8_BAR; PG8_MMA(0, 0, At, B0); PG8_MMA(0, 1, At, B1); PG8_BAR; PG8_SCHED;
            PG8_LDA(At, 0, 1); PG8_STAGEB(PG8_SB(0, 0), b2); PG8_STAGEB(PG8_SB(0, 1), b2 + hstep); PG8_STAGEA(PG8_SA(0, 0), a2, v2, 0);
            PG8_WAIT_V(8);
            PG8_WAIT_L(0); PG8_BAR; PG8_MMA(1, 0, At, B0); PG8_MMA(1, 1, At, B1); PG8_BAR; PG8_SCHED;
            PG8_LDB(B0, 1, 0); PG8_LDB(B1, 1, 1); PG8_SCHED; PG8_LDA(At, 1, 0); PG8_STAGEA(PG8_SA(0, 1), a2, v2, 1);
            PG8_WAIT_V(8);
            PG8_WAIT_L(0); PG8_BAR; PG8_MMA(0, 0, At, B0); PG8_MMA(0, 1, At, B1); PG8_BAR; PG8_SCHED;
            PG8_LDA(At, 1, 1); PG8_STAGEB(PG8_SB(1, 0), b3); PG8_STAGEB(PG8_SB(1, 1), b3 + hstep); PG8_STAGEA(PG8_SA(1, 0), a3, v2, 0);
            PG8_WAIT_V(8); PG8_WAIT_L(0); PG8_BAR; PG8_MMA(1, 0, At, B0); PG8_MMA(1, 1, At, B1); PG8_BAR; PG8_SCHED;
        }
        if constexpr (ALIGN_EPI) { if (wr == 0) PG8_BAR; }
        asm volatile("" ::: "memory");
#ifdef PROBE_KDUP
        if (ui & 1)
#endif
        E(acc, cur, wr, wc, fr, fq);
#ifdef PROBE_DRAIN
        asm volatile("s_waitcnt vmcnt(0)" ::: "memory");
#endif
#ifdef PROBE_EPI2
        if constexpr (Epi::IDEM) { asm volatile("" ::: "memory"); E(acc, cur, wr, wc, fr, fq); }
#endif
        if (!has_next) break;
#pragma unroll
        for (int a = 0; a < 2; ++a)
#pragma unroll
            for (int b = 0; b < 2; ++b)
#pragma unroll
                for (int m = 0; m < 4; ++m)
#pragma unroll
                    for (int n = 0; n < 2; ++n) acc[a][b][m][n] = (f32x4){0.f, 0.f, 0.f, 0.f};
        if constexpr (Sched::GATHER) cur = nxt; else { cur.A = nxt.A; cur.B = nxt.B; cur.pm = nxt.pm; cur.pn = nxt.pn; cur.aux = nxt.aux; }
        cA = nA; cB = nB; ++ui;
        if constexpr (ALIGN_EPI) { if (wr == 1) PG8_BAR; }
    }
    PG8_WAIT_V(0);
    if constexpr (!ALIGN_EPI) { if (wr == 0) PG8_BAR; }
    PG8_BAR;
#undef PG8_SA
#undef PG8_SB
#undef PG8_STAGEA
#undef PG8_STAGEB
#undef PG8_LDA
#undef PG8_LDB
#undef PG8_MMA
#undef PG8_WAIT_V
#undef PG8_WAIT_L
#undef PG8_BAR
#undef PG8_SCHED
}
__device__ __forceinline__ void contig_va(unsigned (&va)[2][2], unsigned lda) {
    const int tid = threadIdx.x;
#pragma unroll
    for (int i = 0; i < 2; ++i) { int R, C; stage_rc(tid * 16 + i * 8192, R, C); va[0][i] = (unsigned)R * lda + (unsigned)C * 2u; va[1][i] = (unsigned)(R + HALF) * lda + (unsigned)C * 2u; }
}
}


template <int BM> __device__ __forceinline__ u32x4 sel_ror8(const u32x4 keep, const u32x4 src) { u32x4 r;
    r.x = (unsigned)__builtin_amdgcn_update_dpp((int)keep.x, (int)src.x, 0x128, 0xf, BM, false); r.y = (unsigned)__builtin_amdgcn_update_dpp((int)keep.y, (int)src.y, 0x128, 0xf, BM, false);
    r.z = (unsigned)__builtin_amdgcn_update_dpp((int)keep.z, (int)src.z, 0x128, 0xf, BM, false); r.w = (unsigned)__builtin_amdgcn_update_dpp((int)keep.w, (int)src.w, 0x128, 0xf, BM, false); return r; }
__device__ __forceinline__ void st_lines(bf16_t* line0, size_t pitch  , int fr, int fq, const u32x4 p0, const u32x4 p1) {
    const bool lo = fr < 8;
    const u32x4 d0 = sel_ror8<0xC>(p0, p1);
    const u32x4 d1 = sel_ror8<0x3>(p1, p0);
    bf16_t* a = line0 + (size_t)(fr & 7) * pitch + (lo ? 0 : 32) + 8 * fq; bf16_t* a2 = a + 8 * pitch;
    asm volatile("global_store_dwordx4 %0, %1, off sc1\n\ts_nop 1" :: "v"(a), "v"(d0) : "memory");
    asm volatile("global_store_dwordx4 %0, %1, off sc1\n\ts_nop 1" :: "v"(a2), "v"(d1) : "memory");
}
__device__ __forceinline__ void ld_lines(const bf16_t* line0, size_t pitch, int fr, int fq, u32x4& p0, u32x4& p1) {
    const bool lo = fr < 8; const bf16_t* a = line0 + (size_t)(fr & 7) * pitch + (lo ? 0 : 32) + 8 * fq;
    const u32x4 l1 = *(const u32x4*)a, l2 = *(const u32x4*)(a + 8 * pitch);
    p0 = sel_ror8<0xC>(l1, l2);
    p1 = sel_ror8<0x3>(l2, l1);
}
__device__ __forceinline__ u32x4 pack8(const f32x4 v0, const f32x4 v1) { u32x4 w; w.x = cvt_pk_bf16(v0[0], v0[1]); w.y = cvt_pk_bf16(v0[2], v0[3]); w.z = cvt_pk_bf16(v1[0], v1[1]); w.w = cvt_pk_bf16(v1[2], v1[3]); return w; }

struct Frame {
    LAS unsigned char* lds;
    unsigned* ctl;
    int tid, lane, wave, vcu, G;
    const float* in[27];
    float* out;
    unsigned char* ws;
};
struct Args { const float* in[27]; float* out; unsigned char* ws; int ph_lo, ph_hi; };

__device__ __forceinline__ void p_adaln(Frame& F) {
    const int wg = blockIdx.x, tid = F.tid;
    if (wg >= 192) return;
    const float* c = F.in[1]; const float* cctx = F.in[3]; const float* wmod = F.in[4]; const float* bmod = F.in[5];
    float* mod = (float*)(F.ws + WS_MOD);
    LAS float* sc = (LAS float*)F.lds;
    for (int i = tid; i < 33 * 1024; i += NTHR) { const int r = i >> 10, k = i & 1023; const float v = (r < 32) ? c[r * 1024 + k] : cctx[k]; sc[k * 36 + r] = v / (1.f + expf(-v)); }
    __syncthreads();
    const int col = tid & 31, kq = tid >> 5, j = wg * 32 + col;
    float acc[33];
#pragma unroll
    for (int r = 0; r < 33; ++r) acc[r] = 0.f;
    for (int kk = 0; kk < 64; ++kk) {
        const int k = kq * 64 + kk; const float w = wmod[(size_t)k * 6144 + j];
        const LAS f32x4* sp = (const LAS f32x4*)(sc + k * 36);
#pragma unroll
        for (int q = 0; q < 8; ++q) { const f32x4 s4 = sp[q]; acc[4 * q] += s4[0] * w; acc[4 * q + 1] += s4[1] * w; acc[4 * q + 2] += s4[2] * w; acc[4 * q + 3] += s4[3] * w; }
        acc[32] += sc[k * 36 + 32] * w;
    }
    __syncthreads();
    LAS float* red = (LAS float*)F.lds;
#pragma unroll
    for (int r = 0; r < 33; ++r) red[(kq * 33 + r) * 32 + col] = acc[r];
    __syncthreads();
    for (int o = tid; o < 33 * 32; o += NTHR) { const int r = o >> 5, cc = o & 31; float s = 0.f;
#pragma unroll
        for (int q = 0; q < 16; ++q) s += red[(q * 33 + r) * 32 + cc];
        mod[r * 6144 + wg * 32 + cc] = s + bmod[wg * 32 + cc]; }
    __syncthreads();
}
__device__ __forceinline__ void transpose_item(const float* W, int ldw, int k0, int n0, bf16_t* WT, int ldk, int dst_row0, LAS float* scr, int lane, float scale = 1.f) {
    float tv[32];
#pragma unroll
    for (int i = 0; i < 32; ++i) { const int kk = 2 * i + (lane >> 5); tv[i] = W[(size_t)(k0 + kk) * ldw + n0 + (lane & 31)]; }
#pragma unroll
    for (int i = 0; i < 32; ++i) { const int kk = 2 * i + (lane >> 5); scr[kk * 33 + (lane & 31)] = tv[i]; }
    LDS_WAIT(); asm volatile("" ::: "memory");
    const int c = lane & 7;
#pragma unroll
    for (int j = 0; j < 4; ++j) { const int n = (lane >> 3) + 8 * j; const LAS float* s = scr + (8 * c) * 33 + n;
        u32x4 o; o.x = cvt_pk_bf16(s[0 * 33] * scale, s[1 * 33] * scale); o.y = cvt_pk_bf16(s[2 * 33] * scale, s[3 * 33] * scale); o.z = cvt_pk_bf16(s[4 * 33] * scale, s[5 * 33] * scale); o.w = cvt_pk_bf16(s[6 * 33] * scale, s[7 * 33] * scale);
        *(u32x4*)(WT + (size_t)(dst_row0 + n) * ldk + k0 + 8 * c) = o; }
    LDS_WAIT(); asm volatile("" ::: "memory");
}
__device__ __forceinline__ void transpose_item8(const float* W, int ldw, int k0, int n0, unsigned char* WT8, int ldk, int dst_row0, LAS float* scr, int lane, float scale) {
    float tv[32];
#pragma unroll
    for (int i = 0; i < 32; ++i) { const int kk = 2 * i + (lane >> 5); tv[i] = W[(size_t)(k0 + kk) * ldw + n0 + (lane & 31)]; }
#pragma unroll
    for (int i = 0; i < 32; ++i) { const int kk = 2 * i + (lane >> 5); scr[kk * 33 + (lane & 31)] = tv[i]; }
    LDS_WAIT(); asm volatile("" ::: "memory");
    const int c = lane & 7;
#pragma unroll
    for (int j = 0; j < 4; ++j) { const int n = (lane >> 3) + 8 * j; const LAS float* sp = scr + (8 * c) * 33 + n;
        u32x2 o; o.x = pk4_fp8(sp[0 * 33] * scale, sp[1 * 33] * scale, sp[2 * 33] * scale, sp[3 * 33] * scale); o.y = pk4_fp8(sp[4 * 33] * scale, sp[5 * 33] * scale, sp[6 * 33] * scale, sp[7 * 33] * scale);
        *(u32x2*)(WT8 + (size_t)(dst_row0 + n) * ldk + k0 + 8 * c) = o; }
    LDS_WAIT(); asm volatile("" ::: "memory");
}
__device__ __forceinline__ void p_wpeff_block(Frame& F, int blk) {
    const int tid = F.tid, gi = blk >> 3, eb = blk & 7;
    const float* pw = F.in[14] + (size_t)gi * 128 * 128; const float* ps = F.in[15] + gi * 128; const float* wbr = F.in[16] + (size_t)(gi * 128) * 1024 + eb * 128;
    bf16_t* WP = (bf16_t*)(F.ws + WS_WP);
    LAS float* At = (LAS float*)F.lds;
    LAS float* Bs = At + 128 * 128;
    for (int i = tid; i < 128 * 32; i += NTHR) { const int c = i & 127, j4 = (i >> 7) * 4; const f32x4 v = *(const f32x4*)(pw + c * 128 + j4);     At[(j4 + 0) * 128 + c] = v[0]; At[(j4 + 1) * 128 + c] = v[1]; At[(j4 + 2) * 128 + c] = v[2]; At[(j4 + 3) * 128 + c] = v[3]; }
    for (int i = tid; i < 128 * 32; i += NTHR) { const int j = i >> 5, e4 = (i & 31) * 4; const f32x4 v = *(const f32x4*)(wbr + (size_t)j * 1024 + e4); *(LAS f32x4*)(Bs + j * 128 + e4) = v * ps[j]; }
    __syncthreads();
    const int c0 = (tid >> 4) * 4, e0 = (tid & 15) * 8;
    f32x4 acc[4][2];
#pragma unroll
    for (int q = 0; q < 4; ++q) { acc[q][0] = (f32x4){0.f, 0.f, 0.f, 0.f}; acc[q][1] = (f32x4){0.f, 0.f, 0.f, 0.f}; }
#pragma unroll 4
    for (int j = 0; j < 128; ++j) { const f32x4 a = *(const LAS f32x4*)(At + j * 128 + c0), b0 = *(const LAS f32x4*)(Bs + j * 128 + e0), b1 = *(const LAS f32x4*)(Bs + j * 128 + e0 + 4);
#pragma unroll
        for (int q = 0; q < 4; ++q) { acc[q][0] += b0 * a[q]; acc[q][1] += b1 * a[q]; } }
#pragma unroll
    for (int h2 = 0; h2 < 2; ++h2)
#pragma unroll
        for (int x = 0; x < 4; ++x) { const int e = eb * 128 + e0 + 4 * h2 + x;
            *(u32x2*)(WP + (size_t)e * 512 + gi * 128 + c0) = (u32x2){cvt_pk_bf16(acc[0][h2][x], acc[1][h2][x]), cvt_pk_bf16(acc[2][h2][x], acc[3][h2][x])}; }
    __syncthreads();
}
__device__ __forceinline__ void p_convert(Frame& F, const bool do_base, const bool do_moe) {
    LAS float* scr = (LAS float*)(F.lds + F.wave * 16384);
    const int gw = F.vcu * NWAVES + F.wave, NGW = F.G * NWAVES, lane = F.lane;
    bf16_t* WIN = (bf16_t*)(F.ws + WS_WIN); bf16_t* WGLA = (bf16_t*)(F.ws + WS_WGLA); bf16_t* WO = (bf16_t*)(F.ws + WS_WO);
    bf16_t* W13 = (bf16_t*)(F.ws + WS_W13); bf16_t* W2 = (bf16_t*)(F.ws + WS_W2); bf16_t* WP = (bf16_t*)(F.ws + WS_WP);
    constexpr int I_IN = 16 * 177, I_SQ = 16 * 32, I_13 = 64 * 256, I_2 = 32 * 256;
    constexpr int NITEMS = I_IN + 2 * I_SQ + I_13 + I_2;
    for (int it = gw + (do_base ? 0 : I_IN + 2 * I_SQ); it < (do_moe ? NITEMS : I_IN + 2 * I_SQ); it += NGW) {
        int r = it;
        if (r < I_IN) { const int kb = r / 177, nb = r % 177; transpose_item(F.in[8], DIN, 64 * kb, 32 * nb, WIN, 1024, 32 * nb, scr, lane, (nb >= 16 && nb < 32) ? 0.08838834764831845f : 1.f); continue; }   r -= I_IN;
        if (r < I_SQ) { const int kb = r / 32, nb = r % 32; transpose_item(F.in[17], 1024, 64 * kb, 32 * nb, WGLA, 1024, 32 * nb, scr, lane); continue; } r -= I_SQ;
        if (r < I_SQ) { const int kb = r / 32, nb = r % 32; transpose_item(F.in[18], 1024, 64 * kb, 32 * nb, WO, 1024, 32 * nb, scr, lane); continue; } r -= I_SQ;
        if (r < I_13) { const int mat = r / 256, e = mat >> 1, which = mat & 1, rr = r % 256, kb = rr / 16, nb = rr % 16, n0 = 32 * nb;
            const float* src = (which ? F.in[24] : F.in[23]) + (size_t)e * 1024 * 512;
            if (MOE_FP8) transpose_item8(src, 512, 64 * kb, n0, (unsigned char*)W13 + (size_t)e * 1024 * 1024, 1024, (n0 / 128) * 256 + ((n0 % 128) / 32) * 64 + which * 32, scr, lane, SC_W13);
            else transpose_item(src, 512, 64 * kb, n0, W13 + (size_t)e * 1024 * 1024, 1024, (n0 / 128) * 256 + ((n0 % 128) / 32) * 64 + which * 32, scr, lane);
            continue; } r -= I_13;
        { const int e = r / 256, rr = r % 256, kb = rr / 32, nb = rr % 32;
            if (MOE2_FP8) transpose_item8(F.in[25] + (size_t)e * 512 * 1024, 1024, 64 * kb, 32 * nb, (unsigned char*)W2 + (size_t)e * 1024 * 512, 512, 32 * nb, scr, lane, SC_W2);
            else transpose_item(F.in[25] + (size_t)e * 512 * 1024, 1024, 64 * kb, 32 * nb, W2 + (size_t)e * 1024 * 512, 512, 32 * nb, scr, lane); }
    }
}

__device__ __forceinline__ void norm_rows(const float* src, bf16_t* dst, int row0, int nrows  , const float* gain, const float* scv, const float* shv, int lane) {
    f32x4 Av[4], Bv[4];
#pragma unroll
    for (int q = 0; q < 4; ++q) { const int c = 8 * lane + 512 * (q >> 1) + 4 * (q & 1); const f32x4 g = *(const f32x4*)(gain + c), sc = *(const f32x4*)(scv + c); Av[q] = g * (sc + 1.f); Bv[q] = *(const f32x4*)(shv + c); }
    f32x4 buf[4][4];
#pragma unroll
    for (int p = 0; p < 4; ++p)
#pragma unroll
        for (int q = 0; q < 4; ++q) buf[p][q] = *(const f32x4*)(src + (size_t)(row0 + p) * D + 8 * lane + 512 * (q >> 1) + 4 * (q & 1));
    for (int r = 0; r < nrows; r += 4) {
#pragma unroll
        for (int p = 0; p < 4; ++p) {
            f32x4 v[4]; float ss = 0.f;
#pragma unroll
            for (int q = 0; q < 4; ++q) v[q] = buf[p][q];
            if (r + 4 + p < nrows) {
#pragma unroll
                for (int q = 0; q < 4; ++q) buf[p][q] = *(const f32x4*)(src + (size_t)(row0 + r + 4 + p) * D + 8 * lane + 512 * (q >> 1) + 4 * (q & 1)); }
#pragma unroll
            for (int q = 0; q < 4; ++q) ss += (v[q][0] * v[q][0] + v[q][1] * v[q][1]) + (v[q][2] * v[q][2] + v[q][3] * v[q][3]);
            const float rstd = 1.f / sqrtf(wave_sum(ss) * (1.f / D) + EPS);
            bf16_t* orow = dst + (size_t)(row0 + r + p) * D;
#pragma unroll
            for (int j = 0; j < 2; ++j) { const f32x4 h0 = v[2 * j] * rstd * Av[2 * j] + Bv[2 * j], h1 = v[2 * j + 1] * rstd * Av[2 * j + 1] + Bv[2 * j + 1]; *(u32x4*)(orow + 8 * lane + 512 * j) = pack8(h0, h1); }
        }
    }
}
#define LDS_BARRIER() asm volatile("s_waitcnt lgkmcnt(0)\n\ts_barrier" ::: "memory")
template <bool LOADN>
__device__ __forceinline__ void norm1_step(const Frame& F, f32x4 (&cur)[4][4], f32x4 (&nxt)[4][4], const float* nsrc, bf16_t* drow, const f32x4 (&Av)[4], const f32x4 (&Bv)[4], const bf16x8 (&wf)[2][4],
                                           float* lrbase, const int lrmul) {
    const int lane = F.lane, wave = F.wave, tid = F.tid;
    constexpr int SROW = 2064;
    LAS unsigned char* stage = F.lds;
    LAS float* part = (LAS float*)(F.lds + 66560);
#pragma unroll
    for (int p = 0; p < 4; ++p) {
        float ss = 0.f;
        if (LOADN) {
#pragma unroll
            for (int q = 0; q < 4; ++q) nxt[p][q] = *(const f32x4*)(nsrc + (size_t)p * D + 8 * lane + 512 * (q >> 1) + 4 * (q & 1)); }
#pragma unroll
        for (int q = 0; q < 4; ++q) ss += (cur[p][q][0] * cur[p][q][0] + cur[p][q][1] * cur[p][q][1]) + (cur[p][q][2] * cur[p][q][2] + cur[p][q][3] * cur[p][q][3]);
        const float rstd = 1.f / sqrtf(wave_sum(ss) * (1.f / D) + EPS);
#pragma unroll
        for (int j = 0; j < 2; ++j) { const f32x4 h0 = cur[p][2 * j] * rstd * Av[2 * j] + Bv[2 * j], h1 = cur[p][2 * j + 1] * rstd * Av[2 * j + 1] + Bv[2 * j + 1]; const u32x4 h = pack8(h0, h1);
            *(u32x4*)(drow + (size_t)p * D + 8 * lane + 512 * j) = h; *(LAS u32x4*)(stage + (4 * wave + p) * SROW + (8 * lane + 512 * j) * 2) = h; }
    }
    LDS_BARRIER();
    f32x4 acc[2][2];
#pragma unroll
    for (int nb = 0; nb < 2; ++nb)
#pragma unroll
        for (int nh = 0; nh < 2; ++nh) acc[nb][nh] = (f32x4){0.f, 0.f, 0.f, 0.f};
#pragma unroll
    for (int nb = 0; nb < 2; ++nb)
#pragma unroll
        for (int ks = 0; ks < 4; ++ks) { const bf16x8 bfr = *(LAS bf16x8*)(stage + (16 * nb + (lane & 15)) * SROW + (128 * wave + 32 * ks + 8 * (lane >> 4)) * 2);
#pragma unroll
            for (int nh = 0; nh < 2; ++nh) acc[nb][nh] = __builtin_amdgcn_mfma_f32_16x16x32_bf16(wf[nh][ks], bfr, acc[nb][nh], 0, 0, 0); }
#pragma unroll
    for (int nb = 0; nb < 2; ++nb)
#pragma unroll
        for (int nh = 0; nh < 2; ++nh) *(LAS f32x4*)(part + ((wave * 4 + nb * 2 + nh) * 64 + lane) * 4) = acc[nb][nh];
    LDS_BARRIER();
    {
        const int q = tid >> 7, ln = (tid & 127) >> 1, ip = tid & 1;
        f32x2 sum = (f32x2){0.f, 0.f};
#pragma unroll
        for (int w8 = 0; w8 < 8; ++w8) sum += *(LAS f32x2*)(part + ((w8 * 4 + q) * 64 + ln) * 4 + 2 * ip);
        const int slot = 16 * (q >> 1) + (ln & 15), n = 16 * (q & 1) + 4 * (ln >> 4) + 2 * ip;
        *(f32x2*)(lrbase + ((size_t)lrmul * (slot >> 2) + (slot & 3)) * 32 + n) = sum; }
}
__device__ __forceinline__ void p_norm1(Frame& F) {
    const int lane = F.lane, wave = F.wave;
    const float* mod = (const float*)(F.ws + WS_MOD); bf16_t* HX = (bf16_t*)(F.ws + WS_HX); float* LR = (float*)(F.ws + WS_LR);
    const bf16_t* WIN = (const bf16_t*)(F.ws + WS_WIN);
    bf16x8 wf[2][4];
#pragma unroll
    for (int nh = 0; nh < 2; ++nh)
#pragma unroll
        for (int ks = 0; ks < 4; ++ks) wf[nh][ks] = *(const bf16x8*)(WIN + (size_t)(5632 + 16 * nh + (lane & 15)) * 1024 + 128 * wave + 32 * ks + 8 * (lane >> 4));
    for (int wv = F.vcu; wv < 256; wv += F.G) {
        const int gw = wv * NWAVES + wave, b = wv >> 3;
        f32x4 Av[4], Bv[4];
#pragma unroll
        for (int q = 0; q < 4; ++q) { const int c = 8 * lane + 512 * (q >> 1) + 4 * (q & 1); const f32x4 g = *(const f32x4*)(F.in[6] + c), sc = *(const f32x4*)(mod + b * 6144 + 1024 + c); Av[q] = g * (sc + 1.f); Bv[q] = *(const f32x4*)(mod + b * 6144 + c); }
        f32x4 bufA[4][4], bufB[4][4];
        const float* xr = F.in[0] + (size_t)32 * gw * D; bf16_t* hr = HX + (size_t)32 * gw * D; float* lr = LR + (size_t)32 * wv * NWAVES * 32;
#pragma unroll
        for (int p = 0; p < 4; ++p)
#pragma unroll
            for (int q = 0; q < 4; ++q) bufA[p][q] = *(const f32x4*)(xr + (size_t)p * D + 8 * lane + 512 * (q >> 1) + 4 * (q & 1));
#pragma unroll 1
        for (int i2 = 0; i2 < 3; ++i2) {
            norm1_step<true>(F, bufA, bufB, xr + (size_t)(8 * i2 + 4) * D, hr + (size_t)(8 * i2) * D, Av, Bv, wf, lr + (size_t)(8 * i2) * 32, 32);
            norm1_step<true>(F, bufB, bufA, xr + (size_t)(8 * i2 + 8) * D, hr + (size_t)(8 * i2 + 4) * D, Av, Bv, wf, lr + (size_t)(8 * i2 + 4) * 32, 32);
        }
        norm1_step<true>(F, bufA, bufB, xr + (size_t)28 * D, hr + (size_t)24 * D, Av, Bv, wf, lr + (size_t)24 * 32, 32);
        norm1_step<true>(F, bufB, bufA, F.in[2] + (size_t)4 * gw * D, hr + (size_t)28 * D, Av, Bv, wf, lr + (size_t)28 * 32, 32);
#pragma unroll
        for (int q = 0; q < 4; ++q) { const int c = 8 * lane + 512 * (q >> 1) + 4 * (q & 1); const f32x4 g = *(const f32x4*)(F.in[6] + c), sc = *(const f32x4*)(mod + 32 * 6144 + 1024 + c); Av[q] = g * (sc + 1.f); Bv[q] = *(const f32x4*)(mod + 32 * 6144 + c); }
        norm1_step<false>(F, bufA, bufB, nullptr, HX + ((size_t)T + 4 * gw) * D, Av, Bv, wf, LR + ((size_t)T + 4 * wv * NWAVES) * 32, 4);
    }
    __syncthreads();
}

struct SchedG1 {
    static constexpr bool GATHER = false;
    const char* HX; const char* WIN; int G, c;
    __device__ __forceinline__ bool next(int i, pg8::Unit& u) const {
        const int L = i * G + c; constexpr int NL = 256 * 22, NC = 32 * 6;
        if (L >= NL + NC) return false;
        int pm, pn, ctx = 0;
        if (L < NL) pg8::static_tile(L, 256, 22, pm, pn);
        else { const int j = L - NL; pm = j & 31; pn = 4 + (j >> 5); ctx = 1; }
        u.pm = pm; u.pn = pn; u.aux = ctx;
        u.A = HX + ((size_t)(ctx ? T : 0) + (size_t)pm * 256) * (D * 2); u.B = WIN + (size_t)pn * 256 * (D * 2);
        pg8::contig_va(u.va, D * 2);
        return true;
    }
};
struct EpiG1 {
    static constexpr int NISS = 16; static constexpr bool IDEM = true; static constexpr bool PERM = true;
    unsigned char* ws;
    __device__ __forceinline__ void operator()(const f32x4 (&acc)[2][2][4][2], const pg8::Unit& u, int wr, int wc, int fr, int fq) const {
        const int pn = u.pn, ctx = u.aux; const int rowg = u.pm * 256 + wr * 64;
        bf16_t* base; int ldc, colt;
        if (ctx) { base = (bf16_t*)(ws + WS_PKVC); ldc = 1536; colt = (pn - 4) * 256; }
        else if (pn < 2) { base = (bf16_t*)(ws + WS_PU); ldc = 512; colt = pn * 256; }
        else if (pn < 10) { base = (bf16_t*)(ws + WS_PQKV); ldc = 2048; colt = (pn - 2) * 256; }
        else if (pn < 14) { base = (bf16_t*)(ws + WS_PG); ldc = 1024; colt = (pn - 10) * 256; }
        else { base = (bf16_t*)(ws + WS_PGATES); ldc = 2048; colt = (pn - 14) * 256; }
        bf16_t* blk = base + (size_t)rowg * ldc + colt + wc * 64;
#pragma unroll
        for (int ai = 0; ai < 2; ++ai)
#pragma unroll
            for (int m = 0; m < 4; ++m)
                st_lines(blk + (size_t)(ai * 128 + m * 16) * ldc, (size_t)ldc, fr, fq, pack8(acc[ai][0][m][0], acc[ai][0][m][1]), pack8(acc[ai][1][m][0], acc[ai][1][m][1]));
    }
};

typedef float f32x16 __attribute__((ext_vector_type(16)));
typedef short s16x4 __attribute__((ext_vector_type(4)));
typedef __bf16 bf16v2_t __attribute__((ext_vector_type(2)));
__device__ __forceinline__ unsigned pkbf(float a, float b) { bf16v2_t v; v[0] = (__bf16)a; v[1] = (__bf16)b; return __builtin_bit_cast(unsigned, v); }
__device__ __forceinline__ unsigned off_b(unsigned row, unsigned ch) { return 256u * row + 16u * (ch ^ (((row & 3u) << 2) | ((row >> 2) & 3u))); }
__device__ __forceinline__ unsigned tr_addr_b(unsigned lane, unsigned c, unsigned ks, unsigned t) {
    const unsigned h = lane >> 5, blk = (lane >> 4) & 1u, q = (lane & 15u) >> 2, pp = lane & 3u;
    return off_b(16u * ks + 8u * h + 4u * t + q, 4u * c + 2u * blk + (pp >> 1)) + 8u * (pp & 1u);
}
constexpr int GL_V = 0, GL_QD = 32768, GL_KI = 49152, GL_KR = 65536, GL_PM = 81920, GL_CUM = 90112, GL_DEC = 122880, GL_OT = 123392;
#define MFMA32(a, b, c) __builtin_amdgcn_mfma_f32_32x32x16_bf16((a), (b), (c), 0, 0, 0)
__device__ __forceinline__ void p_gla_chunk(Frame& F) {
    const int w = F.wave;
    LAS unsigned char* L = F.lds;
    const bf16_t* PQKV = (const bf16_t*)(F.ws + WS_PQKV); const bf16_t* PKVC = (const bf16_t*)(F.ws + WS_PKVC); const float* LR = (const float*)(F.ws + WS_LR);
    LAS float* CUM = (LAS float*)(L + GL_CUM); LAS float* DEC = (LAS float*)(L + GL_DEC);
    const int tid0 = F.tid;
    const int ib = w >> 2, db = w & 3;
    const unsigned A_vw = GL_V + (unsigned)((tid0 & 31) >> 4) * 16384u + off_b((unsigned)(tid0 >> 5), (unsigned)(tid0 & 15));
    const unsigned A_kr = off_b((unsigned)(tid0 >> 4), (unsigned)(tid0 & 15));
    const unsigned A_a0 = off_b((unsigned)(tid0 >> 4), (unsigned)(tid0 & 14)) + 8u * (unsigned)(tid0 & 1);
    unsigned RB, TB, PB, WB;
    { const unsigned lane0 = tid0 & 63, hh0 = lane0 >> 5, l310 = lane0 & 31; const unsigned tq = (lane0 & 15) >> 2, tp = lane0 & 3, tblk = (lane0 >> 4) & 1;
      RB = 256u * l310 + 16u * (((l310 & 3u) << 2) | ((l310 >> 2) & 3u));
      TB = 256u * (8u * hh0 + tq) + 8u * (tp & 1u) + 16u * ((2u * tblk + (tp >> 1)) ^ ((tq << 2) | (2u * hh0)));
      PB = 128u * l310 + 16u * (hh0 ^ ((l310 >> 1) & 7u));
      WB = 128u * l310 + 16u * ((l310 >> 1) & 7u) + 8u * hh0; }
    for (int wgi = blockIdx.x; wgi < 256; wgi += F.G) {
        const int b = wgi >> 3, h = (wgi >> 1) & 3, dir = wgi & 1;
        bf16_t* OD = (bf16_t*)F.out + (size_t)dir * T * D;
        const float* a2 = dir ? F.in[11] : F.in[9]; const float* ab = dir ? F.in[12] : F.in[10];
        float a2r[8];
#pragma unroll
        for (int kk = 0; kk < 8; ++kk) a2r[kk] = a2[(kk + 8 * ((tid0 >> 5) & 1)) * 512 + h * 128 + 32 * db + (tid0 & 31)];
        const float abd2 = -1.44269504089f * ab[h * 128 + 32 * db + (tid0 & 31)];
        unsigned vo = (unsigned)(dir ? 63 - (tid0 >> 5) : (tid0 >> 5)) * 3072u + 16u * (unsigned)(tid0 & 31);
        unsigned ko = (unsigned)(dir ? 63 - (tid0 >> 4) : (tid0 >> 4)) * 3072u + 16u * (unsigned)(tid0 & 15);
        const unsigned lvo = (unsigned)(dir ? 63 - (32 * ib + (tid0 & 31)) : (32 * ib + (tid0 & 31))) * 128u + 32u * (unsigned)((tid0 >> 5) & 1);
        f32x16 S[4];
#pragma unroll
        for (int q = 0; q < 4; ++q)
#pragma unroll
            for (int r = 0; r < 16; ++r) S[q][r] = 0.f;
        f32x4 lv[2]; u32x4 vreg[4], qreg[2], kreg[2];
#define GLA_LOAD(CH) do { const int _ch = (CH); const bool _ic = _ch < 4; const int _ci = _ic ? _ch : _ch - 4, _N = _ic ? CTXL : SEQ; const unsigned _rp2 = _ic ? 3072u : 4096u; \
            if (_ch == 4) { int _t = tid0; asm volatile("" : "+v"(_t)); vo = (unsigned)(dir ? 63 - (_t >> 5) : (_t >> 5)) * 4096u + 16u * (unsigned)(_t & 31); ko = (unsigned)(dir ? 63 - (_t >> 4) : (_t >> 4)) * 4096u + 16u * (unsigned)(_t & 15); } \
            const int _tok0 = dir ? (_N - 64 - 64 * _ci) : 64 * _ci; \
            const char* _gb = (const char*)(_ic ? PKVC + (size_t)b * CTXL * 1536 : PQKV + (size_t)b * SEQ * 2048) + (size_t)_tok0 * _rp2; \
            const int _qc = h * 128, _kc = _ic ? h * 128 : 512 + h * 128, _vc = _ic ? 512 + h * 256 : 1024 + h * 256; \
            const char* _lrb = (const char*)(LR + ((_ic ? (size_t)T + (size_t)b * CTXL : (size_t)b * SEQ) + _tok0) * 32 + dir * 16); \
            lv[0] = *(const f32x4*)(_lrb + (size_t)lvo); lv[1] = *(const f32x4*)(_lrb + 16 + (size_t)lvo); \
            const unsigned _vs = dir ? 0u - 16u * _rp2 : 16u * _rp2, _ks = dir ? 0u - 32u * _rp2 : 32u * _rp2;        \
            _Pragma("unroll") for (int q = 0; q < 4; ++q) vreg[q] = *(const u32x4*)(_gb + _vc * 2 + (size_t)(vo + (unsigned)q * _vs)); \
            _Pragma("unroll") for (int q = 0; q < 2; ++q) { kreg[q] = *(const u32x4*)(_gb + _kc * 2 + (size_t)(ko + (unsigned)q * _ks)); qreg[q] = *(const u32x4*)(_gb + _qc * 2 + (size_t)(ko + (unsigned)q * _ks)); } } while (0)
#define GLA_FLUSH(CI) do { const int _ci = (CI); const int _tok0 = dir ? (SEQ - 64 - 64 * _ci) : 64 * _ci; char* _ob = (char*)(OD + ((size_t)b * SEQ + _tok0) * D + h * 256); \
            const unsigned _fo = (unsigned)(dir ? 63 - (tid >> 5) : (tid >> 5)) * 2048u + 16u * (unsigned)(tid & 31), _fs = dir ? 0u - 16u * 2048u : 16u * 2048u; \
            const unsigned _fl = GL_OT + (unsigned)(tid >> 5) * 528u + (unsigned)(tid & 31) * 16u; \
            _Pragma("unroll") for (int q = 0; q < 4; ++q) *(u32x4*)(_ob + (size_t)(_fo + (unsigned)q * _fs)) = *(const LAS u32x4*)(L + _fl + 8448 * q); } while (0)
        GLA_LOAD(0);
        for (int ch = 0; ch < 36; ++ch) {
            const bool isctx = ch < 4;
            int tid = tid0; asm volatile("" : "+v"(tid), "+v"(RB), "+v"(TB), "+v"(PB), "+v"(WB));
            const int lane0 = tid & 63, hh = lane0 >> 5, l31 = lane0 & 31;
            f32x16 g;
#pragma unroll
            for (int r = 0; r < 16; ++r) g[r] = 0.f;
#pragma unroll
            for (int kk = 0; kk < 8; ++kk) g = __builtin_amdgcn_mfma_f32_32x32x2f32(lv[kk >> 2][kk & 3], a2r[kk], g, 0, 0, 0);
            float cum[16], gs[4], pg[4];
#pragma unroll
            for (int r = 0; r < 16; ++r) { const float a = __builtin_fmaf(g[r], -1.44269504089f, abd2);
                cum[r] = (fmaxf(a, 0.f) + __builtin_amdgcn_logf(1.f + __builtin_amdgcn_exp2f(-fabsf(a)))) * -0.0625f; }
#pragma unroll
            for (int q = 0; q < 4; ++q) { cum[4 * q + 1] += cum[4 * q]; cum[4 * q + 2] += cum[4 * q + 1]; cum[4 * q + 3] += cum[4 * q + 2]; gs[q] = cum[4 * q + 3]; }
#pragma unroll
            for (int q = 0; q < 4; ++q) pg[q] = xchg32(gs[q], lane0);
            { float run = 0.f;
#pragma unroll
                for (int q = 0; q < 4; ++q) { const float offq = run + (hh ? pg[q] : 0.f);
#pragma unroll
                    for (int e = 0; e < 4; ++e) cum[4 * q + e] += offq;
                    run += gs[q] + pg[q]; } }
            __syncthreads();
            if (ch >= 5) GLA_FLUSH(ch - 5);
            { LAS float* cw = (LAS float*)(L + GL_CUM) + (32 * ib + 4 * hh) * 128 + 32 * db + l31;
#pragma unroll
                for (int r = 0; r < 16; ++r) cw[((r & 3) + 8 * (r >> 2)) * 128] = cum[r]; }
#pragma unroll
            for (int q = 0; q < 4; ++q) *(LAS u32x4*)(L + A_vw + 4096 * q) = vreg[q];
            __syncthreads();
            {
                const unsigned A_tb = GL_CUM + 32u * (unsigned)(tid & 15), A_cb = A_tb + (unsigned)(tid >> 4) * 512u;
                const f32x4 t0 = *(const LAS f32x4*)(L + A_tb + 31 * 512), t1 = *(const LAS f32x4*)(L + A_tb + 31 * 512 + 16);
                const f32x4 l0 = *(const LAS f32x4*)(L + A_tb + 63 * 512) + t0, l1 = *(const LAS f32x4*)(L + A_tb + 63 * 512 + 16) + t1;
                float el8[8];
#pragma unroll
                for (int e = 0; e < 4; ++e) { el8[e] = __builtin_amdgcn_exp2f(l0[e]); el8[4 + e] = __builtin_amdgcn_exp2f(l1[e]); }
#pragma unroll
                for (int q = 0; q < 2; ++q) {
                    f32x4 c0 = *(const LAS f32x4*)(L + A_cb + 16384 * q), c1 = *(const LAS f32x4*)(L + A_cb + 16384 * q + 16);
                    if (q == 1) { c0 += t0; c1 += t1; }
                    float kf[8], qf[8], cc[8]; unpack8(kreg[q], kf); unpack8(qreg[q], qf);
#pragma unroll
                    for (int e = 0; e < 4; ++e) { cc[e] = c0[e]; cc[4 + e] = c1[e]; }
                    float kr[8], kiv[8], qd[8];
#pragma unroll
                    for (int e = 0; e < 8; ++e) { const float ex = __builtin_amdgcn_exp2f(cc[e]), inv = __builtin_amdgcn_exp2f(-cc[e]); qd[e] = qf[e] * ex; kiv[e] = kf[e] * inv; kr[e] = kiv[e] * el8[e]; }
                    u32x4 wk; wk.x = pkbf(kr[0], kr[1]); wk.y = pkbf(kr[2], kr[3]); wk.z = pkbf(kr[4], kr[5]); wk.w = pkbf(kr[6], kr[7]);
                    *(LAS u32x4*)(L + GL_KR + 8192 * q + A_kr) = wk;
                    if (!isctx) {
                        *(LAS u32x2*)(L + GL_QD + 8192 * q + A_a0) = (u32x2){pkbf(qd[0], qd[1]), pkbf(qd[2], qd[3])}; *(LAS u32x2*)(L + GL_QD + 8192 * q + (A_a0 ^ 16u)) = (u32x2){pkbf(qd[4], qd[5]), pkbf(qd[6], qd[7])};
                        *(LAS u32x2*)(L + GL_KI + 8192 * q + A_a0) = (u32x2){pkbf(kiv[0], kiv[1]), pkbf(kiv[2], kiv[3])}; *(LAS u32x2*)(L + GL_KI + 8192 * q + (A_a0 ^ 16u)) = (u32x2){pkbf(kiv[4], kiv[5]), pkbf(kiv[6], kiv[7])};
                    }
                }
            }
            if (w < 2) DEC[tid] = __builtin_amdgcn_exp2f(CUM[63 * 128 + tid] + CUM[31 * 128 + tid]);
            if (ch + 1 < 36) GLA_LOAD(ch + 1);
            __syncthreads();
            bf16x8 vb[4];
            { LAS unsigned char* vbase = L + GL_V + (w >> 2) * 16384; const unsigned c4 = (unsigned)(w & 3) << 2;
#pragma unroll
                for (int ks = 0; ks < 4; ++ks) { const s16x4 lo = __builtin_amdgcn_ds_read_tr16_b64_v4i16((LAS s16x4*)(vbase + (TB ^ (c4 << 4)) + 256 * (16 * ks)));
                    const s16x4 hi = __builtin_amdgcn_ds_read_tr16_b64_v4i16((LAS s16x4*)(vbase + (TB ^ ((c4 ^ 1u) << 4)) + 256 * (16 * ks + 4)));
                    vb[ks] = __builtin_shufflevector(lo, hi, 0, 1, 2, 3, 4, 5, 6, 7); } }
            f32x16 o[2];
            if (!isctx) {
                if (w < 3) {
                    const int jb = (w == 2) ? 1 : 0, ibs = (w == 0) ? 0 : 1;
                    f32x16 sc;
#pragma unroll
                    for (int r = 0; r < 16; ++r) sc[r] = 0.f;
                    bf16x8 kf2[2], qf2[2];
                    { const unsigned ro = RB ^ (unsigned)(hh << 4); kf2[0] = *(const LAS bf16x8*)(L + GL_KI + 8192 * jb + ro); qf2[0] = *(const LAS bf16x8*)(L + GL_QD + 8192 * ibs + ro); }
#pragma unroll
                    for (int s8 = 0; s8 < 8; ++s8) {
                        if (s8 + 1 < 8) { const unsigned ro = RB ^ (unsigned)((2 * (s8 + 1) + hh) << 4); kf2[(s8 + 1) & 1] = *(const LAS bf16x8*)(L + GL_KI + 8192 * jb + ro); qf2[(s8 + 1) & 1] = *(const LAS bf16x8*)(L + GL_QD + 8192 * ibs + ro); }
                        __builtin_amdgcn_sched_barrier(0);
                        sc = MFMA32(kf2[s8 & 1], qf2[s8 & 1], sc); }
                    const int mlim = (jb == ibs) ? l31 : 64;
#pragma unroll
                    for (int q = 0; q < 4; ++q) { float pv[4];
#pragma unroll
                        for (int e = 0; e < 4; ++e) { const int jl = e + 8 * q + 4 * hh; pv[e] = (jl > mlim) ? 0.f : sc[4 * q + e]; }
                        *(LAS u32x2*)(L + GL_PM + 4096 * ibs + (WB ^ (unsigned)((4 * jb + q) << 4))) = (u32x2){pkbf(pv[0], pv[1]), pkbf(pv[2], pv[3])}; }
                }
#pragma unroll
                for (int i2 = 0; i2 < 2; ++i2)
#pragma unroll
                    for (int r = 0; r < 16; ++r) o[i2][r] = 0.f;
                { bf16x8 qf[2][2];
                    { const unsigned ro = RB ^ (unsigned)(hh << 4); qf[0][0] = *(const LAS bf16x8*)(L + GL_QD + ro); qf[0][1] = *(const LAS bf16x8*)(L + GL_QD + 8192 + ro); }
#pragma unroll
                    for (int st = 0; st < 8; ++st) { const int q = st >> 1, s2 = st & 1;
                        if (st + 1 < 8) { const unsigned ro = RB ^ (unsigned)((2 * (st + 1) + hh) << 4); qf[(st + 1) & 1][0] = *(const LAS bf16x8*)(L + GL_QD + ro); qf[(st + 1) & 1][1] = *(const LAS bf16x8*)(L + GL_QD + 8192 + ro); }
                        u32x4 pb; pb.x = pkbf(S[q][8 * s2], S[q][8 * s2 + 1]); pb.y = pkbf(S[q][8 * s2 + 2], S[q][8 * s2 + 3]); pb.z = pkbf(S[q][8 * s2 + 4], S[q][8 * s2 + 5]); pb.w = pkbf(S[q][8 * s2 + 6], S[q][8 * s2 + 7]);
                        const bf16x8 sfr = __builtin_bit_cast(bf16x8, pb);
                        __builtin_amdgcn_sched_barrier(0);
                        o[0] = MFMA32(sfr, qf[st & 1][0], o[0]); o[1] = MFMA32(sfr, qf[st & 1][1], o[1]); } }
                __syncthreads();
                { bf16x8 pf[6];
#pragma unroll
                    for (int st = 0; st < 6; ++st) { const int i2 = st < 2 ? 0 : 1, ks = st < 2 ? st : st - 2; pf[st] = *(const LAS bf16x8*)(L + GL_PM + 4096 * i2 + (PB ^ (unsigned)((2 * ks) << 4))); }
                    __builtin_amdgcn_sched_barrier(0);
#pragma unroll
                    for (int st = 0; st < 6; ++st) { const int i2 = st < 2 ? 0 : 1, ks = st < 2 ? st : st - 2; o[i2] = MFMA32(vb[ks], pf[st], o[i2]); } }
            }
            {
#define KR_FRAG(Q, KS) __builtin_shufflevector(__builtin_amdgcn_ds_read_tr16_b64_v4i16((LAS s16x4*)(L + GL_KR + (TB ^ (unsigned)((4 * (Q)) << 4)) + 256 * (16 * (KS)))), \
                                               __builtin_amdgcn_ds_read_tr16_b64_v4i16((LAS s16x4*)(L + GL_KR + (TB ^ (unsigned)(((4 * (Q)) ^ 1) << 4)) + 256 * (16 * (KS) + 4))), 0, 1, 2, 3, 4, 5, 6, 7)
                bf16x8 kf[2]; kf[0] = KR_FRAG(0, 0);
#pragma unroll
                for (int q = 0; q < 4; ++q) {
                    f32x4 dv[4];
#pragma unroll
                    for (int g4 = 0; g4 < 4; ++g4) dv[g4] = *(const LAS f32x4*)(DEC + 32 * q + 8 * g4 + 4 * hh);
#pragma unroll
                    for (int g4 = 0; g4 < 4; ++g4)
#pragma unroll
                        for (int e = 0; e < 4; ++e) S[q][4 * g4 + e] *= dv[g4][e];
#pragma unroll
                    for (int ks = 0; ks < 4; ++ks) { const int st = 4 * q + ks;
                        if (st + 1 < 16) kf[(st + 1) & 1] = KR_FRAG((st + 1) >> 2, (st + 1) & 3);
                        S[q] = MFMA32(kf[st & 1], vb[ks], S[q]); }
                }
#undef KR_FRAG
            }
            if (!isctx) {
                const unsigned A_ot = GL_OT + (unsigned)l31 * 528u + (unsigned)(32 * w + 4 * hh) * 2u;
#pragma unroll
                for (int i2 = 0; i2 < 2; ++i2)
#pragma unroll
                    for (int rq = 0; rq < 4; ++rq) *(LAS u32x2*)(L + A_ot + (32 * i2) * 528 + 16 * rq) = (u32x2){pkbf(o[i2][4 * rq], o[i2][4 * rq + 1]), pkbf(o[i2][4 * rq + 2], o[i2][4 * rq + 3])};
            }
        }
        __syncthreads();
        { const int tid = tid0; GLA_FLUSH(31); }
#undef GLA_FLUSH
#undef GLA_LOAD
    }
    __syncthreads();
}

template <bool LOADN>
__device__ __forceinline__ void og_rows2(const bf16_t* OF, const bf16_t* OB, const bf16_t* PG, bf16_t* OG, const size_t off0, const u32x4 (&cur)[3][2][2], u32x4 (&nxt)[3][2][2], const float (&gn)[8]) {
    if (LOADN) {
#pragma unroll
        for (int rr = 0; rr < 2; ++rr)
#pragma unroll
            for (int j = 0; j < 2; ++j) { const size_t off = off0 + (size_t)(2 + rr) * D + 512 * j; nxt[0][rr][j] = *(const u32x4*)(OF + off); nxt[1][rr][j] = *(const u32x4*)(OB + off); nxt[2][rr][j] = *(const u32x4*)(PG + off); }
    }
#pragma unroll
    for (int rr = 0; rr < 2; ++rr)
#pragma unroll
        for (int j = 0; j < 2; ++j) {
            float o[8], ob[8], g[8]; unpack8(cur[0][rr][j], o); unpack8(cur[1][rr][j], ob); unpack8(cur[2][rr][j], g);
            float ss = 0.f;
#pragma unroll
            for (int e = 0; e < 8; ++e) { o[e] += ob[e]; ss += o[e] * o[e]; }
            ss = row_sum16(ss); ss = swap16_sum(ss, ss);
            const float rstd = __builtin_amdgcn_rsqf(ss * (1.f / 256.f) + EPS);
            float y[8];
#pragma unroll
            for (int e = 0; e < 8; ++e) y[e] = (o[e] * (rstd * gn[e])) * (g[e] * sigmoidf_(g[e]));
            u32x4 wv; wv.x = cvt_pk_bf16(y[0], y[1]); wv.y = cvt_pk_bf16(y[2], y[3]); wv.z = cvt_pk_bf16(y[4], y[5]); wv.w = cvt_pk_bf16(y[6], y[7]);
            *(u32x4*)(OG + off0 + (size_t)rr * D + 512 * j) = wv; }
}
__device__ __forceinline__ void p_prep(Frame& F, const bool do_og, const bool do_pool) {
    const int gw = F.vcu * NWAVES + F.wave, NGW = F.G * NWAVES, lane = F.lane;
    const bf16_t* OF = (const bf16_t*)F.out; const bf16_t* OB = OF + (size_t)T * D; const bf16_t* PG = (const bf16_t*)(F.ws + WS_PG);
    bf16_t* OG = (bf16_t*)(F.ws + WS_HX);
    float gn[8];
    { const f32x4 g0 = *(const f32x4*)(F.in[13] + 8 * (lane & 31)), g1 = *(const f32x4*)(F.in[13] + 8 * (lane & 31) + 4);
#pragma unroll
        for (int e = 0; e < 4; ++e) { gn[e] = g0[e]; gn[4 + e] = g1[e]; } }
    if (do_og)
    for (int w = gw; w < 2048; w += NGW) {
        u32x4 bufA[3][2][2], bufB[3][2][2];
        const size_t base = (size_t)w * 32 * D + 8 * lane;
#pragma unroll
        for (int rr = 0; rr < 2; ++rr)
#pragma unroll
            for (int j = 0; j < 2; ++j) { const size_t off = base + (size_t)rr * D + 512 * j; bufA[0][rr][j] = *(const u32x4*)(OF + off); bufA[1][rr][j] = *(const u32x4*)(OB + off); bufA[2][rr][j] = *(const u32x4*)(PG + off); }
#pragma unroll 1
        for (int r = 0; r < 32; r += 4) {
            og_rows2<true>(OF, OB, PG, OG, base + (size_t)r * D, bufA, bufB, gn);
            if (r + 4 < 32) og_rows2<true>(OF, OB, PG, OG, base + (size_t)(r + 2) * D, bufB, bufA, gn);
            else og_rows2<false>(OF, OB, PG, OG, base + (size_t)(r + 2) * D, bufB, bufA, gn);
        }
    }
    if (!do_pool) return;
    const bf16_t* PU = (const bf16_t*)(F.ws + WS_PU); bf16_t* PO = (bf16_t*)(F.ws + WS_PO);
    LAS unsigned* uL = (LAS unsigned*)F.lds;
    u32x4 upf[8];
    if (F.vcu < T / 64) {
#pragma unroll
        for (int q = 0; q < 8; ++q) upf[q] = *(const u32x4*)(PU + (size_t)F.vcu * 64 * 512 + (size_t)(F.tid + NTHR * q) * 8); }
    for (int tt = F.vcu; tt < T / 64; tt += F.G) {
        __syncthreads();
#pragma unroll
        for (int q = 0; q < 8; ++q) *(LAS u32x4*)(uL + (F.tid + NTHR * q) * 4) = upf[q];
        if (tt + F.G < T / 64) {
#pragma unroll
            for (int q = 0; q < 8; ++q) upf[q] = *(const u32x4*)(PU + (size_t)(tt + F.G) * 64 * 512 + (size_t)(F.tid + NTHR * q) * 8); }
        __syncthreads();
        const int cp = F.tid & 255, half = F.tid >> 8, gi = cp >> 6, hw = 1 << gi;
        const int p0 = half * 32;
        float s0 = 0.f, s1 = 0.f;
        { const int lo = (p0 - hw) < 0 ? 0 : (p0 - hw), hi = p0 + hw;
            for (int q = lo; q < hi; ++q) { const unsigned wv = uL[q * 256 + cp]; s0 += bf_lo(wv); s1 += bf_hi(wv); } }
        bf16_t* po = PO + ((size_t)tt * 64 + p0) * 512 + 2 * cp;
#pragma unroll 8
        for (int i = 0; i < 32; ++i) {
            const int p = p0 + i; const int lo = (p - hw) < 0 ? 0 : (p - hw), hi = (p + hw) > 64 ? 64 : (p + hw);
            const unsigned self = uL[p * 256 + cp]; const float inv = 1.f / (float)(hi - lo);
            *(unsigned*)(po + (size_t)i * 512) = cvt_pk_bf16(s0 * inv - bf_lo(self), s1 * inv - bf_hi(self));
            const int qa = p + hw, qd = p - hw;
            const unsigned wa = uL[(qa < 64 ? qa : 63) * 256 + cp], wd = uL[(qd >= 0 ? qd : 0) * 256 + cp];
            const float fa = qa < 64 ? 1.f : 0.f, fd = qd >= 0 ? 1.f : 0.f;
            s0 += fa * bf_lo(wa) - fd * bf_lo(wd); s1 += fa * bf_hi(wa) - fd * bf_hi(wd);
        }
    }
    __syncthreads();
}

struct SchedSq {
    static constexpr bool GATHER = false;
    const char* A; const char* B; unsigned lda; int K, G, c;
    __device__ __forceinline__ bool next(int i, pg8::Unit& u) const {
        const int L = i * G + c; if (L >= 1024) return false;
        int pm, pn; pg8::static_tile(L, 256, 4, pm, pn); u.pm = pm; u.pn = pn; u.aux = 0;
        u.A = A + (size_t)pm * 256 * lda; u.B = B + (size_t)pn * 256 * (K * 2); pg8::contig_va(u.va, lda); return true;
    }
};
struct EpiPool {
    static constexpr int NISS = 32; static constexpr bool IDEM = true; static constexpr bool PERM = true;
    const bf16_t* GATES; bf16_t* Z;
    __device__ __forceinline__ void operator()(const f32x4 (&acc)[2][2][4][2], const pg8::Unit& u, int wr, int wc, int fr, int fq) const {
        const size_t rowg = (size_t)u.pm * 256 + wr * 64; const int colb = u.pn * 256 + wc * 64;
        u32x4 gq[2][4][2];
#pragma unroll
        for (int ai = 0; ai < 2; ++ai)
#pragma unroll
            for (int m = 0; m < 4; ++m) ld_lines(GATES + (rowg + ai * 128 + m * 16) * 2048 + colb, 2048, fr, fq, gq[ai][m][0], gq[ai][m][1]);
        asm volatile("" ::: "memory");
#pragma unroll
        for (int ai = 0; ai < 2; ++ai)
#pragma unroll
            for (int m = 0; m < 4; ++m) { const size_t rg = rowg + ai * 128 + m * 16; u32x4 wv[2];
#pragma unroll
                for (int bj = 0; bj < 2; ++bj) { float g[8]; unpack8(gq[ai][m][bj], g); const f32x4 a0 = acc[ai][bj][m][0], a1 = acc[ai][bj][m][1]; f32x4 z0, z1;
#pragma unroll
                    for (int e = 0; e < 4; ++e) { z0[e] = a0[e] * sigmoidf_(g[e]); z1[e] = a1[e] * sigmoidf_(g[4 + e]); }
                    wv[bj] = pack8(z0, z1); }
                st_lines(Z + rg * 1024 + colb, 1024, fr, fq, wv[0], wv[1]); }
    }
};
struct EpiGla {
    static constexpr int NISS = 48; static constexpr bool IDEM = false; static constexpr bool PERM = true;
    const bf16_t* GATES; bf16_t* Z;
    __device__ __forceinline__ void operator()(const f32x4 (&acc)[2][2][4][2], const pg8::Unit& u, int wr, int wc, int fr, int fq) const {
        const size_t rowg = (size_t)u.pm * 256 + wr * 64; const int colb = u.pn * 256 + wc * 64;
#pragma unroll
        for (int ai = 0; ai < 2; ++ai) {
            u32x4 gq[4][2], zq[4][2];
#pragma unroll
            for (int m = 0; m < 4; ++m) { const size_t rg = rowg + ai * 128 + m * 16; ld_lines(GATES + rg * 2048 + 1024 + colb, 2048, fr, fq, gq[m][0], gq[m][1]); ld_lines(Z + rg * 1024 + colb, 1024, fr, fq, zq[m][0], zq[m][1]); }
            asm volatile("" ::: "memory");
#pragma unroll
            for (int m = 0; m < 4; ++m) { const size_t rg = rowg + ai * 128 + m * 16; u32x4 wv[2];
#pragma unroll
                for (int bj = 0; bj < 2; ++bj) { float g[8], zp[8]; unpack8(gq[m][bj], g); unpack8(zq[m][bj], zp); const f32x4 a0 = acc[ai][bj][m][0], a1 = acc[ai][bj][m][1]; f32x4 z0, z1;
#pragma unroll
                    for (int e = 0; e < 4; ++e) { z0[e] = zp[e] + a0[e] * sigmoidf_(g[e]); z1[e] = zp[4 + e] + a1[e] * sigmoidf_(g[4 + e]); }
                    wv[bj] = pack8(z0, z1); }
                st_lines(Z + rg * 1024 + colb, 1024, fr, fq, wv[0], wv[1]); }
        }
    }
};
struct EpiWo {
    static constexpr int NISS = 52; static constexpr bool IDEM = true; static constexpr bool PERM = true;
    const float* X; const float* MOD; bf16_t* X1;
    __device__ __forceinline__ void operator()(const f32x4 (&acc)[2][2][4][2], const pg8::Unit& u, int wr, int wc, int fr, int fq) const {
        const size_t rowg = (size_t)u.pm * 256 + wr * 64; const int colb = u.pn * 256 + wc * 64, col0 = colb + 8 * fq; const int b = u.pm >> 3;
        f32x4 gv[2][2];
#pragma unroll
        for (int bj = 0; bj < 2; ++bj)
#pragma unroll
            for (int n = 0; n < 2; ++n) gv[bj][n] = *(const f32x4*)(MOD + b * 6144 + 2048 + col0 + bj * 32 + n * 4);
#pragma unroll
        for (int ai = 0; ai < 2; ++ai) {
            f32x4 xq[4][2][2];
#pragma unroll
            for (int m = 0; m < 4; ++m) { const float* xr = X + (rowg + ai * 128 + m * 16 + fr) * D + col0;
#pragma unroll
                for (int bj = 0; bj < 2; ++bj) { xq[m][bj][0] = *(const f32x4*)(xr + bj * 32); xq[m][bj][1] = *(const f32x4*)(xr + bj * 32 + 4); } }
            asm volatile("" ::: "memory");
#pragma unroll
            for (int m = 0; m < 4; ++m) { const size_t rg = rowg + ai * 128 + m * 16; u32x4 wv[2];
#pragma unroll
                for (int bj = 0; bj < 2; ++bj) wv[bj] = pack8(xq[m][bj][0] + gv[bj][0] * acc[ai][bj][m][0], xq[m][bj][1] + gv[bj][1] * acc[ai][bj][m][1]);
                st_lines(X1 + rg * D + colb, D, fr, fq, wv[0], wv[1]); }
        }
    }
};

__device__ __forceinline__ float reduce4_rows(float p0, float p1, float p2, float p3) { return row_sum16(swap16_sum(swap32_sum(p0, p2), swap32_sum(p1, p3))); }
__device__ __forceinline__ float reduce8_groups(const float (&p)[8]) {
    const float t0 = swap16_sum(swap32_sum(p[0], p[4]), swap32_sum(p[2], p[6]));
    const float t1 = swap16_sum(swap32_sum(p[1], p[5]), swap32_sum(p[3], p[7]));
    int u = __builtin_bit_cast(int, 0.f);
    const float s0 = t0 + __builtin_bit_cast(float, __builtin_amdgcn_update_dpp(0, __builtin_bit_cast(int, t0), 0x128, 0xf, 0xf, false));
    const float s1 = t1 + __builtin_bit_cast(float, __builtin_amdgcn_update_dpp(0, __builtin_bit_cast(int, t1), 0x128, 0xf, 0xf, false));
    u = __builtin_amdgcn_update_dpp(u, __builtin_bit_cast(int, s0), 0xE4, 0xf, 0x3, false);
    u = __builtin_amdgcn_update_dpp(u, __builtin_bit_cast(int, s1), 0xE4, 0xf, 0xC, false);
    float v = __builtin_bit_cast(float, u);
    v += dpp_mov<0x141>(v); v += dpp_mov<0xB1>(v); v += dpp_mov<0x4E>(v);
    return v;
}
__device__ __forceinline__ float dot16(const f32x4 (&h)[4], const LAS float* wl) {
    f32x2 acc = (f32x2){0.f, 0.f};
#pragma unroll
    for (int q = 0; q < 4; ++q) { const f32x4 wv = *(const LAS f32x4*)(wl + 512 * (q >> 1) + 4 * (q & 1)); acc += (f32x2){h[q][0], h[q][1]} * (f32x2){wv[0], wv[1]}; acc += (f32x2){h[q][2], h[q][3]} * (f32x2){wv[2], wv[3]}; }
    return acc[0] + acc[1];
}
template <bool DRY>
__device__ __forceinline__ void p_norm2_router(Frame& F) {
    const int tid = F.tid, lane = F.lane;
    constexpr int WS = 1028;
    LAS float* WR = (LAS float*)F.lds;
    LAS float* LGT = WR + 36 * WS;
    LAS unsigned* hist = (LAS unsigned*)(LGT + 256 * 12);
    LAS unsigned* baseL = hist + 32;
    LAS float* rebL = (LAS float*)(baseL + 32);
    LAS unsigned char* eidL = (LAS unsigned char*)(rebL + 32);
    LAS unsigned short* rankL = (LAS unsigned short*)(eidL + 512);
    const float* rgw = F.in[19]; const float* rew = F.in[21];
    for (int i = tid; i < 1024 * 4; i += NTHR) WR[(i & 3) * WS + (i >> 2)] = rgw[i];
    for (int i = tid; i < 1024 * 32; i += NTHR) WR[(4 + (i & 31)) * WS + (i >> 5)] = rew[i];
    if (tid < 32) rebL[tid] = F.in[22][tid];
    const float rgbl = F.in[20][lane >> 4];
    const float* mod = (const float*)(F.ws + WS_MOD); const bf16_t* X1 = (const bf16_t*)(F.ws + WS_X1); bf16_t* H2 = (bf16_t*)(F.ws + WS_HX);
    int* EID = (int*)(F.ws + WS_EID); float* EW = (float*)(F.ws + WS_EW); int* SLOT = (int*)(F.ws + WS_POS); int* IDXE = (int*)(F.ws + WS_IDXE);
    for (int blk = F.vcu; blk < T / 256; blk += F.G) {
        __syncthreads();
        if (tid < 32) hist[tid] = 0u;
        __syncthreads();
        const int b = blk >> 3; const size_t row0 = (size_t)blk * 256 + F.wave * 32;
        f32x4 Av[4], Bv[4];
#pragma unroll
        for (int q = 0; q < 4; ++q) { const int c = 8 * lane + 512 * (q >> 1) + 4 * (q & 1); const f32x4 g = *(const f32x4*)(F.in[7] + c), sc = *(const f32x4*)(mod + b * 6144 + 4 * 1024 + c); Av[q] = g * (sc + 1.f); Bv[q] = *(const f32x4*)(mod + b * 6144 + 3 * 1024 + c); }
        u32x4 nxb[4][2];
#pragma unroll
        for (int p = 0; p < 4; ++p)
#pragma unroll
            for (int j = 0; j < 2; ++j) nxb[p][j] = *(const u32x4*)(X1 + (row0 + p) * D + 8 * lane + 512 * j);
        for (int r4 = 0; r4 < 32; r4 += 4)
#pragma unroll
        for (int p = 0; p < 4; ++p) {
            const int r = r4 + p, rl = F.wave * 32 + r;
            const size_t row = row0 + r; f32x4 v[4]; float ss = 0.f;
#pragma unroll
            for (int j = 0; j < 2; ++j) { float f[8]; unpack8(nxb[p][j], f); v[2 * j] = (f32x4){f[0], f[1], f[2], f[3]}; v[2 * j + 1] = (f32x4){f[4], f[5], f[6], f[7]}; }
            if (r + 4 < 32) {
#pragma unroll
                for (int j = 0; j < 2; ++j) nxb[p][j] = *(const u32x4*)(X1 + (row + 4) * D + 8 * lane + 512 * j); }
#pragma unroll
            for (int q = 0; q < 4; ++q) ss += (v[q][0] * v[q][0] + v[q][1] * v[q][1]) + (v[q][2] * v[q][2] + v[q][3] * v[q][3]);
            const float rstd = __builtin_amdgcn_rsqf(wave_sum(ss) * (1.f / D) + EPS);
#pragma unroll
            for (int q = 0; q < 4; ++q) v[q] = v[q] * rstd * Av[q] + Bv[q];
#pragma unroll
            for (int j = 0; j < 2; ++j) {
                if (MOE_FP8) { u32x2 w8; w8.x = pk4_fp8(v[2 * j][0], v[2 * j][1], v[2 * j][2], v[2 * j][3]); w8.y = pk4_fp8(v[2 * j + 1][0], v[2 * j + 1][1], v[2 * j + 1][2], v[2 * j + 1][3]);
                    *(u32x2*)((unsigned char*)H2 + row * D + 8 * lane + 512 * j) = w8; }
                else { u32x4 wv; wv.x = cvt_pk_bf16(v[2 * j][0], v[2 * j][1]); wv.y = cvt_pk_bf16(v[2 * j][2], v[2 * j][3]); wv.z = cvt_pk_bf16(v[2 * j + 1][0], v[2 * j + 1][1]); wv.w = cvt_pk_bf16(v[2 * j + 1][2], v[2 * j + 1][3]);
                    *(u32x4*)(H2 + row * D + 8 * lane + 512 * j) = wv; } }
            const float gx = reduce4_rows(dot16(v, WR + 0 * WS + 8 * lane), dot16(v, WR + 1 * WS + 8 * lane), dot16(v, WR + 2 * WS + 8 * lane), dot16(v, WR + 3 * WS + 8 * lane)) + rgbl;
            if ((lane & 15) == 0) LGT[rl * 12 + (lane >> 4)] = gx;
            const float gmx = swap32_max(swap16_max(gx));
            const unsigned long long gmask = __builtin_amdgcn_ballot_w64(gx == gmx);
            const int gsel = gmask ? (int)(__builtin_ctzll(gmask) >> 4) : 0;
            if (lane == 0) eidL[rl * 2] = (unsigned char)gsel;
            float ep[8];
            { const LAS float* wg = WR + (4 + gsel * 8) * WS + 8 * lane;
#pragma unroll
                for (int o = 0; o < 8; ++o) ep[o] = dot16(v, wg + o * WS); }
            const float ex = reduce8_groups(ep);
            if ((lane & 7) == 0) LGT[rl * 12 + 4 + (lane >> 3)] = ex;
        }
        if (lane < 32) {
            const int rl = F.wave * 32 + lane; const size_t row = row0 + lane;
            const f32x4 gl = *(const LAS f32x4*)(LGT + rl * 12), e0 = *(const LAS f32x4*)(LGT + rl * 12 + 4), e1 = *(const LAS f32x4*)(LGT + rl * 12 + 8);
            const int gsel = eidL[rl * 2];
            const float gmax = fmaxf(fmaxf(gl[0], gl[1]), fmaxf(gl[2], gl[3]));
            const float pgrp = 1.f / (expf(gl[0] - gmax) + expf(gl[1] - gmax) + expf(gl[2] - gmax) + expf(gl[3] - gmax));
            const f32x4 b0 = *(const LAS f32x4*)(rebL + gsel * 8), b1 = *(const LAS f32x4*)(rebL + gsel * 8 + 4);
            float el[8];
#pragma unroll
            for (int o = 0; o < 4; ++o) { el[o] = e0[o] + b0[o]; el[4 + o] = e1[o] + b1[o]; }
            int i0 = 0; float m0 = el[0];
#pragma unroll
            for (int o = 1; o < 8; ++o) if (el[o] > m0) { m0 = el[o]; i0 = o; }
            int i1 = -1; float m1 = -3.0e38f;
#pragma unroll
            for (int o = 0; o < 8; ++o) if (o != i0 && el[o] > m1) { m1 = el[o]; i1 = o; }
            if (i1 < 0) { i1 = (i0 + 1) & 7; m1 = el[0];
#pragma unroll
                for (int o = 1; o < 8; ++o) if (o == i1) m1 = el[o]; }
            const float e1x = expf(m1 - m0), w0 = pgrp / (1.f + e1x), w1 = pgrp * e1x / (1.f + e1x);
            const int x0 = gsel * 8 + i0, x1 = gsel * 8 + i1;
            *(u32x2*)(EID + row * 2) = (u32x2){(unsigned)x0, (unsigned)x1}; *(f32x2*)(EW + row * 2) = (f32x2){w0, w1};
            eidL[rl * 2] = (unsigned char)x0; eidL[rl * 2 + 1] = (unsigned char)x1;
            rankL[rl * 2] = (unsigned short)atomicAdd((unsigned*)&hist[x0], 1u); rankL[rl * 2 + 1] = (unsigned short)atomicAdd((unsigned*)&hist[x1], 1u);
        }
        __syncthreads();
        if (!DRY) {
        if (tid < 32) baseL[tid] = hist[tid] ? __hip_atomic_fetch_add(F.ctl + CW_CNT + tid, hist[tid], __ATOMIC_RELAXED, __HIP_MEMORY_SCOPE_AGENT) : 0u;
        __syncthreads();
        { const int e = eidL[tid]; const unsigned slot = baseL[e] + rankL[tid]; const int token = blk * 256 + (tid >> 1);
            IDXE[(size_t)e * 65536 + slot] = token; SLOT[token * 2 + (tid & 1)] = (int)slot; }
        }
    }
    __syncthreads();
}
__device__ __forceinline__ void moe_tables(Frame& F) {
    volatile LAS unsigned* M = (volatile LAS unsigned*)(F.lds + MISC_OFF);
    __syncthreads();
    if (F.tid < 32) { const unsigned c = __hip_atomic_load(F.ctl + CW_CNT + F.tid, __ATOMIC_RELAXED, __HIP_MEMORY_SCOPE_AGENT); M[64 + F.tid] = c; M[96 + F.tid] = (c + 255u) & ~255u; }
    __syncthreads();
    if (F.tid < 33) { unsigned o = 0;
#pragma unroll
        for (int q = 0; q < 32; ++q) { const unsigned pq = M[96 + q]; o += (q < F.tid) ? pq : 0u; }
        M[16 + F.tid] = o; }
    __syncthreads();
}

struct SchedMoe1 {
    static constexpr bool GATHER = true;
    const char* H2; const char* W13; const int* IDXE; const volatile LAS unsigned* M; int nunits, G, c;
    __device__ __forceinline__ bool next(int i, pg8::Unit& u) const {
        const int L = i * G + c; if (L >= nunits) return false;
        const int tile = L >> 2, pn = L & 3; const unsigned base = (unsigned)tile * 256u; int e = 0;
        for (int q = 1; q < 32; ++q) e += (M[16 + q] <= base) ? 1 : 0;
        e = __builtin_amdgcn_readfirstlane(e);
        const unsigned lb = base - M[16 + e], cnt = M[64 + e];
        u.pm = tile; u.pn = pn; u.aux = e; u.A = H2; u.B = W13 + ((size_t)e * 1024 + (size_t)pn * 256) * (MOE_FP8 ? 1024 : 2048);
        const int tid = threadIdx.x; const int* ie = IDXE + (size_t)e * 65536;
#pragma unroll
        for (int k = 0; k < 2; ++k) { int R, C; pg8::stage_rc(tid * 16 + k * 8192, R, C);
            const unsigned s0 = lb + R, s1 = lb + 128 + R; const int t0 = s0 < cnt ? ie[s0] : 0, t1 = s1 < cnt ? ie[s1] : 0;
            u.va[0][k] = (unsigned)t0 * (MOE_FP8 ? 1024u : 2048u) + (unsigned)C * 2u; u.va[1][k] = (unsigned)t1 * (MOE_FP8 ? 1024u : 2048u) + (unsigned)C * 2u; }
        return true;
    }
};
struct EpiMoe1 {
    static constexpr int NISS = 8; static constexpr bool IDEM = true; static constexpr bool PERM = true;
    bf16_t* HID;
    __device__ __forceinline__ void operator()(const f32x4 (&acc)[2][2][4][2], const pg8::Unit& u, int wr, int wc, int fr, int fq) const {
        const int row0 = u.pm * 256 + wr * 64 + fr, col0 = u.pn * 128 + wc * 32 + 8 * fq;
#pragma unroll
        for (int ai = 0; ai < 2; ++ai)
#pragma unroll
            for (int m = 0; m < 4; ++m) { const size_t row = row0 + ai * 128 + m * 16; float hv[8];
#pragma unroll
                for (int n = 0; n < 2; ++n)
#pragma unroll
                    for (int e = 0; e < 4; ++e) { const float a = acc[ai][0][m][n][e] * (MOE_FP8 ? 1.f / SC_W13 : 1.f), bq = acc[ai][1][m][n][e] * (MOE_FP8 ? (MOE2_FP8 ? SC_HID : 1.f) / SC_W13 : 1.f); hv[4 * n + e] = a * sigmoidf_(a) * bq; }
                if (MOE2_FP8) { u32x2 w8; w8.x = pk4_fp8(hv[0], hv[1], hv[2], hv[3]); w8.y = pk4_fp8(hv[4], hv[5], hv[6], hv[7]); *(u32x2*)((unsigned char*)HID + row * 512 + col0) = w8; }
                else { u32x4 w; w.x = cvt_pk_bf16(hv[0], hv[1]); w.y = cvt_pk_bf16(hv[2], hv[3]); w.z = cvt_pk_bf16(hv[4], hv[5]); w.w = cvt_pk_bf16(hv[6], hv[7]);
                    *(u32x4*)(HID + row * 512 + col0) = w; } }
    }
};
struct SchedMoe2 {
    static constexpr bool GATHER = false;
    const char* HID; const char* W2; const volatile LAS unsigned* M; int nunits, G, c;
    __device__ __forceinline__ bool next(int i, pg8::Unit& u) const {
        const int L = i * G + c; if (L >= nunits) return false;
        const int tile = L >> 2, pn = L & 3; const unsigned base = (unsigned)tile * 256u; int e = 0;
        for (int q = 1; q < 32; ++q) e += (M[16 + q] <= base) ? 1 : 0;
        e = __builtin_amdgcn_readfirstlane(e);
        u.pm = tile; u.pn = pn; u.aux = e; u.A = HID + (size_t)tile * 256 * (MOE2_FP8 ? 512 : 1024); u.B = W2 + ((size_t)e * 1024 + (size_t)pn * 256) * (MOE2_FP8 ? 512 : 1024);
        pg8::contig_va(u.va, MOE2_FP8 ? 512 : 1024); return true;
    }
};
struct EpiMoe2 {
    static constexpr int NISS = 16; static constexpr bool IDEM = true; static constexpr bool PERM = true;
    bf16_t* Y;
    __device__ __forceinline__ void operator()(const f32x4 (&acc)[2][2][4][2], const pg8::Unit& u, int wr, int wc, int fr, int fq) const {
        if (YOUT_FP8) {
            unsigned char* blk8 = (unsigned char*)Y + ((size_t)u.pm * 256 + wr * 64 + fr) * 1024 + u.pn * 256 + wc * 64 + 8 * fq; constexpr float sy = MOE2_FP8 ? 64.f / (SC_HID * SC_W2) : 64.f;
#pragma unroll
            for (int ai = 0; ai < 2; ++ai)
#pragma unroll
                for (int m = 0; m < 4; ++m)
#pragma unroll
                    for (int bj = 0; bj < 2; ++bj) { f32x4 v0 = acc[ai][bj][m][0], v1 = acc[ai][bj][m][1]; if constexpr (sy != 1.f) { v0 = v0 * sy; v1 = v1 * sy; }
                        *(u32x2*)(blk8 + (size_t)(ai * 128 + m * 16) * 1024 + 32 * bj) = (u32x2){pk4_fp8(v0[0], v0[1], v0[2], v0[3]), pk4_fp8(v1[0], v1[1], v1[2], v1[3])}; }
            return;
        }
        bf16_t* blk = Y + ((size_t)u.pm * 256 + wr * 64) * 1024 + u.pn * 256 + wc * 64;
#pragma unroll
        for (int ai = 0; ai < 2; ++ai)
#pragma unroll
            for (int m = 0; m < 4; ++m) st_lines(blk + (size_t)(ai * 128 + m * 16) * 1024, 1024, fr, fq, pack8(acc[ai][0][m][0], acc[ai][0][m][1]), pack8(acc[ai][1][m][0], acc[ai][1][m][1]));
    }
};

__device__ __forceinline__ void p_final(Frame& F) {
    const int gw = F.vcu * NWAVES + F.wave, NGW = F.G * NWAVES, lane = F.lane;
    const float* mod = (const float*)(F.ws + WS_MOD); const bf16_t* Y = (const bf16_t*)(F.ws + WS_Y); const bf16_t* X1 = (const bf16_t*)(F.ws + WS_X1);
    const int* EID = (const int*)(F.ws + WS_EID); const int* SLOT = (const int*)(F.ws + WS_POS); const float* EW = (const float*)(F.ws + WS_EW);
    const volatile LAS unsigned* M = (const volatile LAS unsigned*)(F.lds + MISC_OFF);
    for (int w = gw; w < 2048; w += NGW) {
        const int b = w >> 6; f32x4 g2[4], fg[4];
#pragma unroll
        for (int j = 0; j < 2; ++j)
#pragma unroll
            for (int hf = 0; hf < 2; ++hf) { const int c = 8 * lane + 512 * j + 4 * hf; g2[2 * j + hf] = *(const f32x4*)(mod + b * 6144 + 5 * 1024 + c); fg[2 * j + hf] = *(const f32x4*)(F.in[26] + c); }
        const size_t prow = (size_t)w * 32 + (lane & 31);
        const int p0v = (int)M[16 + EID[prow * 2]] + SLOT[prow * 2], p1v = (int)M[16 + EID[prow * 2 + 1]] + SLOT[prow * 2 + 1]; const float ysc = YOUT_FP8 ? 1.f / 64.f : (MOE2_FP8 ? 1.f / (SC_HID * SC_W2) : 1.f); const float w0v = EW[prow * 2] * ysc, w1v = EW[prow * 2 + 1] * ysc;
        u32x4 nxb[4][2]; u32x4 ny0b[4][2], ny1b[4][2];
#define P12_LOAD(pp, rr) do { const int _p0 = __builtin_amdgcn_readlane(p0v, (rr)), _p1 = __builtin_amdgcn_readlane(p1v, (rr)); const bf16_t* _xr = X1 + ((size_t)w * 32 + (rr)) * D; \
            _Pragma("unroll") for (int j = 0; j < 2; ++j) { const int c = 8 * lane + 512 * j; nxb[pp][j] = *(const u32x4*)(_xr + c); \
                if (YOUT_FP8) { const u32x2 _a = *(const u32x2*)((const unsigned char*)Y + (size_t)_p0 * 1024 + c), _b = *(const u32x2*)((const unsigned char*)Y + (size_t)_p1 * 1024 + c); ny0b[pp][j].x = _a.x; ny0b[pp][j].y = _a.y; ny1b[pp][j].x = _b.x; ny1b[pp][j].y = _b.y; } \
                else { ny0b[pp][j] = *(const u32x4*)(Y + (size_t)_p0 * 1024 + c); ny1b[pp][j] = *(const u32x4*)(Y + (size_t)_p1 * 1024 + c); } } } while (0)
        P12_LOAD(0, 0); P12_LOAD(1, 1); P12_LOAD(2, 2); P12_LOAD(3, 3);
        for (int r4 = 0; r4 < 32; r4 += 4)
#pragma unroll
        for (int p = 0; p < 4; ++p) {
            const int r = r4 + p;
            u32x4 xq[2], y0[2], y1[2];
#pragma unroll
            for (int j = 0; j < 2; ++j) { xq[j] = nxb[p][j]; y0[j] = ny0b[p][j]; y1[j] = ny1b[p][j]; }
            const float w0 = __builtin_bit_cast(float, __builtin_amdgcn_readlane(__builtin_bit_cast(int, w0v), r)), w1 = __builtin_bit_cast(float, __builtin_amdgcn_readlane(__builtin_bit_cast(int, w1v), r));
            if (r + 4 < 32) P12_LOAD(p, r + 4);
            float ss = 0.f; f32x4 v[4];
#pragma unroll
            for (int j = 0; j < 2; ++j) { float a[8], bq[8], xf[8]; unpack8(xq[j], xf);
                if (YOUT_FP8) { float t4[4]; unpack4_fp8(y0[j].x, t4); a[0] = t4[0]; a[1] = t4[1]; a[2] = t4[2]; a[3] = t4[3]; unpack4_fp8(y0[j].y, t4); a[4] = t4[0]; a[5] = t4[1]; a[6] = t4[2]; a[7] = t4[3];
                    unpack4_fp8(y1[j].x, t4); bq[0] = t4[0]; bq[1] = t4[1]; bq[2] = t4[2]; bq[3] = t4[3]; unpack4_fp8(y1[j].y, t4); bq[4] = t4[0]; bq[5] = t4[1]; bq[6] = t4[2]; bq[7] = t4[3]; }
                else { unpack8(y0[j], a); unpack8(y1[j], bq); }
#pragma unroll
                for (int hf = 0; hf < 2; ++hf) { f32x4 t;
#pragma unroll
                    for (int e = 0; e < 4; ++e) t[e] = xf[4 * hf + e] + g2[2 * j + hf][e] * (w0 * a[4 * hf + e] + w1 * bq[4 * hf + e]);
                    v[2 * j + hf] = t; ss += (t[0] * t[0] + t[1] * t[1]) + (t[2] * t[2] + t[3] * t[3]); } }
            const float rstd = 1.f / sqrtf(wave_sum(ss) * (1.f / D) + EPS);
            float* xo = F.out + ((size_t)w * 32 + r) * D;
#pragma unroll
            for (int j = 0; j < 2; ++j) { const int c = 8 * lane + 512 * j; *(f32x4*)(xo + c) = v[2 * j] * rstd * fg[2 * j]; *(f32x4*)(xo + c + 4) = v[2 * j + 1] * rstd * fg[2 * j + 1]; }
        }
#undef P12_LOAD
    }
}

__global__ void __launch_bounds__(NTHR, 2) fwd_kernel(Args args) {
    extern __shared__ __attribute__((aligned(16))) unsigned char lds_raw[];
    Frame F;
    F.lds = (LAS unsigned char*)lds_raw;
    F.tid = threadIdx.x; F.lane = F.tid & 63; F.wave = __builtin_amdgcn_readfirstlane(F.tid >> 6);
    F.G = gridDim.x; { const int bx = blockIdx.x; F.vcu = (F.G % 8 == 0) ? (bx % 8) * (F.G / 8) + bx / 8 : bx; }
    F.ws = args.ws; F.out = args.out; F.ctl = (unsigned*)(args.ws + WS_CTL);
#pragma unroll
    for (int i = 0; i < 27; ++i) F.in[i] = args.in[i];
    volatile LAS unsigned* MISC = (volatile LAS unsigned*)(F.lds + MISC_OFF);
    if (F.tid < 128) MISC[F.tid] = 0u;
    __syncthreads();
    XcdBarrier bar; bar.bar = F.ctl + CW_BAR; bar.x = 0; bar.st = nullptr;
    if (N_LAUNCHES != PER_PHASE) bar = xcd_barrier_post(F.ctl + CW_BAR, MISC + 8);
#define GRID_BAR() do { if (N_LAUNCHES != PER_PHASE) xcd_barrier(bar); } while (0)
#ifdef PROBE_A
    unsigned long long t_a0 = 0, t_a1 = 0, t_b0 = 0, t_b1 = 0;
#define STAMP(k) do { const unsigned long long _t = wall_clock64(); if ((k) == PROBE_A) t_a0 = _t; if ((k) == PROBE_A + 1) t_a1 = _t; if ((k) == PROBE_B) t_b0 = _t; if ((k) == PROBE_B + 1) t_b1 = _t; } while (0)
#else
#define STAMP(k) do {} while (0)
#endif
    const int lo = args.ph_lo, hi = args.ph_hi;
#define IN(k) (lo <= (k) && (k) < hi)
#define BOTH(k) (IN(k) && IN((k) + 1))
#define REP(k) for (int _r = 0; _r < ((k) == PROBE_REP ? 2 : 1); ++_r)
    unsigned char* ws = F.ws;

    STAMP(0);
    if (IN(0)) { REP(0) { p_adaln(F); for (int bq = (int)blockIdx.x - 192; bq >= 0 && bq < 32; bq += 64) p_wpeff_block(F, bq); if (F.G < 224 && blockIdx.x == 0) for (int bq = 0; bq < 32; ++bq) p_wpeff_block(F, bq); p_convert(F, true, CONV_OVERLAP == 0); } if (BOTH(0)) GRID_BAR(); }
    STAMP(1);
    if (IN(1)) { REP(1) p_norm1(F); if (BOTH(1)) GRID_BAR(); }
    STAMP(2);
    if (IN(2)) {
        SchedG1 S{(const char*)(ws + WS_HX), (const char*)(ws + WS_WIN), F.G, (int)blockIdx.x}; EpiG1 E{ws};
        const bool par = ((blockIdx.x >> 3) & 1) != 0;
        if (CONV_OVERLAP && par) { p_convert(F, false, true); __syncthreads(); }
        REP(2) pg8::gemm_phase<EpiG1, SchedG1, true>(F.lds, 1024, S, E);
        if (CONV_OVERLAP && !par) { __syncthreads(); p_convert(F, false, true); }
        if (BOTH(2)) GRID_BAR();
    }
    STAMP(3);
    if (IN(3)) {
        const bool par = ((blockIdx.x >> 3) & 1) != 0;
        if (POOL_OVERLAP && par) p_prep(F, false, true);
        REP(3) p_gla_chunk(F);
        if (POOL_OVERLAP && !par) p_prep(F, false, true);
        if (BOTH(3)) GRID_BAR();
    }
    STAMP(4);
    if (IN(4) && !(OG_OVERLAP && POOL_OVERLAP)) { REP(4) p_prep(F, OG_OVERLAP == 0, POOL_OVERLAP == 0); if (BOTH(4)) GRID_BAR(); }
    STAMP(5);
    if (IN(5)) {
        SchedSq S{(const char*)(ws + WS_PO), (const char*)(ws + WS_WP), 1024u, 512, F.G, (int)blockIdx.x}; EpiPool E{(const bf16_t*)(ws + WS_PGATES), (bf16_t*)(ws + WS_Z)};
        if (OG_OVERLAP && ((blockIdx.x >> 3) & 1)) p_prep(F, true, false);
        REP(5) pg8::gemm_phase<EpiPool, SchedSq, true>(F.lds, 512, S, E);
        if (OG_OVERLAP && !((blockIdx.x >> 3) & 1)) p_prep(F, true, false);
        asm volatile("s_waitcnt vmcnt(0)" ::: "memory"); __syncthreads();
        if (OG_OVERLAP && BOTH(5)) GRID_BAR();
    }
    STAMP(6);
    if (IN(6)) {
        SchedSq S{(const char*)(ws + WS_HX), (const char*)(ws + WS_WGLA), 2048u, 1024, F.G, (int)blockIdx.x}; EpiGla E{(const bf16_t*)(ws + WS_PGATES), (bf16_t*)(ws + WS_Z)};
        pg8::gemm_phase<EpiGla, SchedSq, true>(F.lds, 1024, S, E);
        if (BOTH(6)) GRID_BAR();
    }
    STAMP(7);
    if (IN(7)) {
        SchedSq S{(const char*)(ws + WS_Z), (const char*)(ws + WS_WO), 2048u, 1024, F.G, (int)blockIdx.x}; EpiWo E{F.in[0], (const float*)(ws + WS_MOD), (bf16_t*)(ws + WS_X1)};
        REP(7) pg8::gemm_phase<EpiWo, SchedSq, true>(F.lds, 1024, S, E);
        if (BOTH(7)) GRID_BAR();
    }
    STAMP(8);
    if (IN(8)) { if (PROBE_REP == 8) p_norm2_router<true>(F); p_norm2_router<false>(F); if (BOTH(8)) GRID_BAR(); }
    STAMP(9);
    if (IN(9)) {
        moe_tables(F);
        const volatile LAS unsigned* M = (const volatile LAS unsigned*)(F.lds + MISC_OFF); const int nt = (int)(M[48] >> 8);
        SchedMoe1 S{(const char*)(ws + WS_HX), (const char*)(ws + WS_W13), (const int*)(ws + WS_IDXE), M, nt * 4, F.G, F.vcu}; EpiMoe1 E{(bf16_t*)(ws + WS_HID)};
        REP(9) pg8::gemm_phase<EpiMoe1, SchedMoe1, true, MOE_FP8 != 0>(F.lds, MOE_FP8 ? 512 : 1024, S, E);
        if (BOTH(9)) GRID_BAR();
    }
    STAMP(10);
    if (IN(10)) {
        moe_tables(F);
        const volatile LAS unsigned* M = (const volatile LAS unsigned*)(F.lds + MISC_OFF); const int nt = (int)(M[48] >> 8);
        SchedMoe2 S{(const char*)(ws + WS_HID), (const char*)(ws + WS_W2), M, nt * 4, F.G, F.vcu}; EpiMoe2 E{(bf16_t*)(ws + WS_Y)};
        REP(10) pg8::gemm_phase<EpiMoe2, SchedMoe2, true, MOE2_FP8 != 0>(F.lds, MOE2_FP8 ? 256 : 512, S, E);
        if (BOTH(10)) GRID_BAR();
    }
    STAMP(11);
    if (IN(11)) { moe_tables(F); REP(11) p_final(F); }
    STAMP(12);
#ifdef PROBE_A
    {
        if (blockIdx.x == 0 && F.tid == 0) { float* pr = (float*)(F.ws + WS_TILEE + 4096); pr[0] = (float)(t_a1 - t_a0) * 0.01f; pr[1] = (float)(t_b1 - t_b0) * 0.01f; }
        GRID_BAR();
        const float* pr = (const float*)(F.ws + WS_TILEE + 4096); const float va = sqrtf(__hip_atomic_load(pr, __ATOMIC_RELAXED, __HIP_MEMORY_SCOPE_AGENT)), vb = __hip_atomic_load(pr + 1, __ATOMIC_RELAXED, __HIP_MEMORY_SCOPE_AGENT);
        for (size_t i = (size_t)blockIdx.x * NTHR + F.tid; i < (size_t)T * D; i += (size_t)F.G * NTHR) F.out[i] = (i == 0) ? vb : va;
    }
#endif
#undef IN
#undef BOTH
#undef GRID_BAR
}

extern "C" void kernel_launch(void* const* d_in, const int* in_sizes, int n_in, void* d_out, int out_size, void* d_ws, size_t ws_size, hipStream_t stream) {
    static int grid = 0;
    if (grid == 0) {
        if (n_in != 27 || in_sizes[0] != T * D || out_size != T * D || ws_size < WS_END) { fprintf(stderr, "kernel_launch: unexpected shapes: n_in %d in0 %d out %d ws %zu (need %zu); nothing launched\n", n_in, n_in > 0 ? in_sizes[0] : -1, out_size, ws_size, (size_t)WS_END); grid = -1; return; }
        int dev = 0, cus = 0, per_cu = 0;
        if (hipGetDevice(&dev) != hipSuccess || hipDeviceGetAttribute(&cus, hipDeviceAttributeMultiprocessorCount, dev) != hipSuccess) { grid = -1; return; }
        if (hipFuncSetAttribute((const void*)fwd_kernel, hipFuncAttributeMaxDynamicSharedMemorySize, LDS_BYTES) != hipSuccess) { fprintf(stderr, "kernel_launch: hipFuncSetAttribute failed\n"); grid = -1; return; }
        if (hipOccupancyMaxActiveBlocksPerMultiprocessor(&per_cu, (const void*)fwd_kernel, NTHR, LDS_BYTES) != hipSuccess || per_cu < 1) fprintf(stderr, "kernel_launch: occupancy query reports %d\n", per_cu);
        (void)hipGetLastError();
        grid = cus;
    }
    if (grid < 0) return;
    if (hipMemsetAsync((char*)d_ws + WS_CTL, 0, CTL_ZERO_BYTES, stream) != hipSuccess) return;
    Args a{};
    for (int i = 0; i < 27; ++i) a.in[i] = (const float*)d_in[i];
    a.out = (float*)d_out; a.ws = (unsigned char*)d_ws;
    if (N_LAUNCHES == 1) { a.ph_lo = 0; a.ph_hi = PER_PHASE; hipLaunchKernelGGL(fwd_kernel, dim3(grid), dim3(NTHR), LDS_BYTES, stream, a); }
    else for (int p = 0; p < PER_PHASE; ++p) { a.ph_lo = p; a.ph_hi = p + 1; hipLaunchKernelGGL(fwd_kernel, dim3(grid), dim3(NTHR), LDS_BYTES, stream, a); }
}
```

```cpp
#include <hip/hip_runtime.h>
#include <cstdio>
#include <cstdint>

#define PROBE_REP -1
#ifndef MK_N_LAUNCHES
#define MK_N_LAUNCHES 1
#endif

#ifndef MOE_FP8
#define MOE_FP8 1
#endif
#ifndef YOUT_FP8
#define YOUT_FP8 1
#endif
#ifndef OG_OVERLAP
#define OG_OVERLAP 1
#define POOL_OVERLAP 1
#define CONV_OVERLAP 1
#endif
#ifndef MOE2_FP8
#define MOE2_FP8 1
#endif
#define LAS __attribute__((address_space(3)))
#define GAS __attribute__((address_space(1)))
typedef unsigned short bf16_t;
typedef short bf16x8 __attribute__((ext_vector_type(8)));
typedef float f32x4 __attribute__((ext_vector_type(4)));
typedef float f32x2 __attribute__((ext_vector_type(2)));
typedef unsigned u32x4 __attribute__((ext_vector_type(4)));
typedef unsigned u32x2 __attribute__((ext_vector_type(2)));

constexpr int D = 1024, BATCH = 32, SEQ = 2048, T = BATCH * SEQ, CTXL = 256, TC = BATCH * CTXL;
constexpr int DIN = 5664, NPAD = 5888;
constexpr int NE = 32, DE = 512;
constexpr int MAXTILES = 544, NPMAX = MAXTILES * 256;
constexpr float EPS = 1e-6f;
constexpr float SC_W13 = 64.f, SC_W2 = 8.f, SC_HID = 8.f;
constexpr int NWAVES = 8, NTHR = 512;
constexpr int PER_PHASE = 12;
constexpr int N_LAUNCHES = MK_N_LAUNCHES;

constexpr size_t MiB = 1u << 20;
constexpr size_t WS_CTL = 0, CTL_ZERO_BYTES = 32768;
constexpr size_t WS_MOD = 1 * MiB;
constexpr size_t WS_EID = 2 * MiB;
constexpr size_t WS_EW = WS_EID + 512 * 1024;
constexpr size_t WS_POS = 3 * MiB;
constexpr size_t WS_IDX = WS_POS + 512 * 1024;
constexpr size_t WS_TILEE = 4 * MiB + 512 * 1024;
constexpr size_t WS_LR = 5 * MiB;
constexpr size_t WS_WIN = 14 * MiB;
constexpr size_t WS_WP = 26 * MiB;
constexpr size_t WS_WGLA = 27 * MiB;
constexpr size_t WS_WO = 29 * MiB;
constexpr size_t WS_W13 = 32 * MiB;
constexpr size_t WS_W2 = 96 * MiB;
constexpr size_t WS_HX = 128 * MiB;
constexpr size_t WS_PU = 272 * MiB;
constexpr size_t WS_PQKV = 336 * MiB;
constexpr size_t WS_PO = 272 * MiB;
constexpr size_t WS_Z = 400 * MiB;
constexpr size_t WS_HID = 272 * MiB;
constexpr size_t WS_PG = 592 * MiB;
constexpr size_t WS_PGATES = 720 * MiB;
constexpr size_t WS_Y = 592 * MiB;
constexpr size_t WS_PKVC = 976 * MiB;
constexpr size_t WS_X1 = 864 * MiB;
constexpr size_t WS_IDXE = 5 * MiB;
constexpr size_t WS_END = 1000 * MiB;
static_assert(WS_HID + (size_t)NPMAX * 512 * 2 <= WS_PG && WS_Y + (size_t)NPMAX * 1024 * 2 <= WS_PKVC, "ws map");
constexpr int CW_CNT = 64;
constexpr int CW_CUR = 128;
constexpr int CW_NT = 192;
constexpr int CW_BAR = 4096;

constexpr int LDS_BYTES = 163840;
constexpr int MISC_OFF = LDS_BYTES - 512;

__device__ __forceinline__ unsigned cvt_pk_bf16(float lo, float hi) { unsigned r; asm volatile("v_cvt_pk_bf16_f32 %0, %1, %2" : "=v"(r) : "v"(lo), "v"(hi)); return r; }
__device__ __forceinline__ float clamp_e4m3(float x) { return __builtin_amdgcn_fmed3f(x, -448.f, 448.f); }
__device__ __forceinline__ unsigned pk4_fp8(float a, float b, float c, float d) { int p = __builtin_amdgcn_cvt_pk_fp8_f32(clamp_e4m3(a), clamp_e4m3(b), 0, false); p = __builtin_amdgcn_cvt_pk_fp8_f32(clamp_e4m3(c), clamp_e4m3(d), p, true); return (unsigned)p; }
__device__ __forceinline__ void unpack4_fp8(unsigned w, float (&f)[4]) { const f32x2 lo = __builtin_amdgcn_cvt_pk_f32_fp8((int)w, false), hi = __builtin_amdgcn_cvt_pk_f32_fp8((int)w, true); f[0] = lo[0]; f[1] = lo[1]; f[2] = hi[0]; f[3] = hi[1]; }
__device__ __forceinline__ float bf_lo(unsigned w) { return __uint_as_float(w << 16); }
__device__ __forceinline__ float bf_hi(unsigned w) { return __uint_as_float(w & 0xffff0000u); }
__device__ __forceinline__ float bf2f(bf16_t h) { return __uint_as_float(((unsigned)h) << 16); }
template <int CTRL> __device__ __forceinline__ float dpp_mov(float v) { return __builtin_bit_cast(float, __builtin_amdgcn_update_dpp(0, __builtin_bit_cast(int, v), CTRL, 0xf, 0xf, false)); }
__device__ __forceinline__ float row_sum16(float v) { v += dpp_mov<0xB1>(v); v += dpp_mov<0x4E>(v); v += dpp_mov<0x124>(v); v += dpp_mov<0x128>(v); return v; }
__device__ __forceinline__ float rlane(float v, int l) { return __builtin_bit_cast(float, __builtin_amdgcn_readlane(__builtin_bit_cast(int, v), l)); }
__device__ __forceinline__ float wave_sum(float v) { v = row_sum16(v); return (rlane(v, 0) + rlane(v, 16)) + (rlane(v, 32) + rlane(v, 48)); }
__device__ __forceinline__ float half_sum(float v, int lane) { v = row_sum16(v); const float lo = rlane(v, 0) + rlane(v, 16), hi = rlane(v, 32) + rlane(v, 48); return lane < 32 ? lo : hi; }
__device__ __forceinline__ float xchg32(float v, int lane) { const auto r = __builtin_amdgcn_permlane32_swap(__builtin_bit_cast(unsigned, v), __builtin_bit_cast(unsigned, v), false, false); return __builtin_bit_cast(float, lane < 32 ? r[1] : r[0]); }
__device__ __forceinline__ void pswap32(float& a, float& b) { asm volatile("s_nop 1\n\tv_permlane32_swap_b32 %0, %1" : "+v"(a), "+v"(b)); }
__device__ __forceinline__ void pswap16(float& a, float& b) { asm volatile("s_nop 1\n\tv_permlane16_swap_b32 %0, %1" : "+v"(a), "+v"(b)); }
__device__ __forceinline__ float swap32_sum(float a, float b) { pswap32(a, b); return a + b; }
__device__ __forceinline__ float swap16_sum(float a, float b) { pswap16(a, b); return a + b; }
__device__ __forceinline__ float swap32_max(float a) { float b = a; pswap32(a, b); return fmaxf(a, b); }
__device__ __forceinline__ float swap16_max(float a) { float b = a; pswap16(a, b); return fmaxf(a, b); }
__device__ __forceinline__ float sigmoidf_(float x) { return __builtin_amdgcn_rcpf(1.f + __expf(-x)); }
#define LDS_WAIT() asm volatile("s_waitcnt lgkmcnt(0)" ::: "memory")
__device__ __forceinline__ void unpack8(const u32x4 w, float (&f)[8]) { f[0] = bf_lo(w.x); f[1] = bf_hi(w.x); f[2] = bf_lo(w.y); f[3] = bf_hi(w.y); f[4] = bf_lo(w.z); f[5] = bf_hi(w.z); f[6] = bf_lo(w.w); f[7] = bf_hi(w.w); }

#define XB_TMO      128
#define XB_XCNT(j)  (256  + 64 * (j))
#define XB_XSUB(j)  (1280 + 64 * (j))
#define XB_XGEN(j)  (2304 + 64 * (j))
#define XB_TOP      3328
#define XB_TOPGEN   3392
#define XCD_BAR_WORDS 3456
#define XB_SPIN_CAP (1u << 18)
__device__ __forceinline__ unsigned xb_ld(unsigned* p)              { return __hip_atomic_load(p, __ATOMIC_RELAXED, __HIP_MEMORY_SCOPE_AGENT); }
__device__ __forceinline__ unsigned xb_add(unsigned* p, unsigned v) { return __hip_atomic_fetch_add(p, v, __ATOMIC_RELAXED, __HIP_MEMORY_SCOPE_AGENT); }
__device__ __forceinline__ unsigned xb_xcc_id() { return (unsigned)__builtin_amdgcn_s_getreg((3 << 11) | 20) & 0xFu; }
#define XB_SPIN(cond, bar) do { unsigned _sp = 0; while (cond) { __builtin_amdgcn_s_sleep(1); \
    if ((++_sp & 255u) == 0u) { if (xb_ld(&(bar)[XB_TMO])) break; if (_sp > XB_SPIN_CAP) { atomicAdd(&(bar)[XB_TMO], 1u); break; } } } } while (0)
struct XcdBarrier { unsigned* bar; unsigned x; volatile LAS unsigned* st; };
__device__ __forceinline__ XcdBarrier xcd_barrier_post(unsigned* bar, volatile LAS unsigned* st) {
    XcdBarrier b; b.bar = bar; b.x = xb_xcc_id(); b.st = st;
    if (threadIdx.x == 0) (void)xb_add(&bar[XB_XCNT(b.x)], 1u);
    return b;
}
__device__ __forceinline__ void xcd_barrier_complete(unsigned* bar, unsigned x, unsigned& nloc, unsigned& nx) {
    const unsigned G = gridDim.x * gridDim.y * gridDim.z;
    unsigned sum, cnt, mine, sp = 0u;
    for (;;) {
        sum = 0u; cnt = 0u; mine = 0u;
#pragma unroll
        for (unsigned j = 0; j < 16; ++j) { const unsigned c = xb_ld(&bar[XB_XCNT(j)]); sum += c; cnt += (c > 0u) ? 1u : 0u; mine = (j == x) ? c : mine; }
        if (sum == G) break;
        __builtin_amdgcn_s_sleep(1);
        if ((++sp & 255u) == 0u) { if (xb_ld(&bar[XB_TMO])) break; if (sp > XB_SPIN_CAP) { atomicAdd(&bar[XB_TMO], 1u); break; } }
    }
    nloc = mine > 0u ? mine : 1u; nx = cnt > 0u ? cnt : 1u;
}
__device__ __forceinline__ void xcd_barrier(const XcdBarrier& b) {
    asm volatile("s_waitcnt vmcnt(0)" ::: "memory");
    __syncthreads();
    if (threadIdx.x == 0) {
        unsigned* bar = b.bar;
        __builtin_amdgcn_s_waitcnt(0);
        unsigned nloc = b.st[0], nx = b.st[1];
        if (nloc == 0u) { xcd_barrier_complete(bar, b.x, nloc, nx); b.st[0] = nloc; b.st[1] = nx; }
        const unsigned old = xb_add(&bar[XB_XSUB(b.x)], 1u);
        const unsigned gen = old / nloc;
        if (old + 1u == (gen + 1u) * nloc) {
            __builtin_amdgcn_fence(__ATOMIC_RELEASE, "agent");
            asm volatile("s_waitcnt vmcnt(0)" ::: "memory");
            const unsigned og = xb_add(&bar[XB_TOP], 1u);
            const unsigned tg = og / nx;
            if (og + 1u == (tg + 1u) * nx) xb_add(&bar[XB_TOPGEN], 1u);
            else XB_SPIN(xb_ld(&bar[XB_TOPGEN]) == tg, bar);
            __builtin_amdgcn_fence(__ATOMIC_ACQUIRE, "agent");
            xb_add(&bar[XB_XGEN(b.x)], 1u);
            asm volatile("s_waitcnt vmcnt(0)" ::: "memory");
        } else {
            XB_SPIN(xb_ld(&bar[XB_XGEN(b.x)]) == gen, bar);
            __builtin_amdgcn_fence(__ATOMIC_ACQUIRE, "agent");
            asm volatile("s_waitcnt vmcnt(0)" ::: "memory");
        }
    }
    __syncthreads();
}

namespace pg8 {
constexpr int BM = 256, BK = 64, HALF = 128, HTB = HALF * BK * 2, STAGE_BYTES = 8 * HTB, NXCD = 8, WGM = 8;
__host__ __device__ __forceinline__ int lds_byte(int r, int c) { const int st = (r >> 4) * 2 + (c >> 5), rr = r & 15, cc = c & 31, ob = rr * 64 + cc * 2; return st * 1024 + (ob ^ (((ob >> 9) & 1) << 5)); }
__host__ __device__ __forceinline__ void stage_rc(int b, int& R, int& C) { const int st = b / 1024, sb = b % 1024, swz = sb ^ (((sb >> 9) & 1) << 5); R = (st >> 1) * 16 + swz / 64; C = (st & 1) * 32 + (swz % 64) / 2; }
__host__ __device__ __forceinline__ int perm32(int rho) { const int n = rho >> 4, i = rho & 15; return 8 * (i >> 2) + 4 * n + (i & 3); }

typedef int v8i_t __attribute__((ext_vector_type(8)));
typedef int v4i_t __attribute__((ext_vector_type(4)));
__device__ __forceinline__ v8i_t mk8(const bf16x8 lo, const bf16x8 hi) { return __builtin_shufflevector(__builtin_bit_cast(v4i_t, lo), __builtin_bit_cast(v4i_t, hi), 0, 1, 2, 3, 4, 5, 6, 7); }
struct Unit { const char* A; const char* B; unsigned va[2][2]; int pm, pn, aux; };

__device__ __forceinline__ void static_tile(int L, int nM, int nN, int& pm, int& pn) {
    const int nwg = nM * nN; int wgid = L; { const int q = nwg / NXCD, r = nwg % NXCD, xcd = wgid % NXCD, off = wgid / NXCD; wgid = (xcd < r ? xcd * (q + 1) : r * (q + 1) + (xcd - r) * q) + off; }
    const int nig = WGM * nN, gid = wgid / nig, fm = gid * WGM, gsz = (nM - fm) < WGM ? (nM - fm) : WGM;
    pm = fm + ((wgid % nig) % gsz); pn = (wgid % nig) / gsz;
}

template <class Epi, class Sched, bool ALIGN_EPI = true, bool FP8 = false>
__device__ __forceinline__ void gemm_phase(LAS unsigned char* lds, const int K, const Sched& S, const Epi& E) {
    const int tid = threadIdx.x, wid = __builtin_amdgcn_readfirstlane(tid >> 6), lane = tid & 63, wr = wid >> 2, wc = wid & 3, fr = lane & 15, fq = lane >> 4;
    const int nt = K / BK;
    unsigned vb[2];
#pragma unroll
    for (int i = 0; i < 2; ++i) { int R, C; stage_rc(tid * 16 + i * 8192, R, C); const int Rb = Epi::PERM ? ((R >> 5) * 64 + perm32(R & 31)) : R; vb[i] = (unsigned)(Rb * K + C) * 2u; }
    const size_t kstep = (size_t)(BK * 2);
    const size_t hstep = Epi::PERM ? (size_t)32 * K * 2 : (size_t)HALF * K * 2;
    const unsigned ldsw = (unsigned)wid * 1024u;
    int aoffk[2], boffk[2];
#pragma unroll
    for (int k = 0; k < 2; ++k) { aoffk[k] = FP8 ? lds_byte(wr * 64 + fr, fq * 16 + 8 * k) : lds_byte(wr * 64 + fr, fq * 8) + k * 1024; boffk[k] = FP8 ? lds_byte(wc * 32 + fr, fq * 16 + 8 * k) : lds_byte(wc * 32 + fr, fq * 8) + k * 1024; }
#define PG8_SA(b, h) (((b) * 2 + (h)) * HTB)
#define PG8_SB(b, h) ((4 + (b) * 2 + (h)) * HTB)
#define PG8_STAGEA(bufoff, gbase, VA, h) do { _Pragma("unroll") for (int _i = 0; _i < 2; ++_i) \
        __builtin_amdgcn_global_load_lds((const unsigned*)((const char*)(gbase) + (VA)[h][_i]), (LAS unsigned*)(lds + (bufoff) + ldsw + _i * 8192), 16, 0, 0); } while (0)
#define PG8_STAGEB(bufoff, gbase) do { _Pragma("unroll") for (int _i = 0; _i < 2; ++_i) \
        __builtin_amdgcn_global_load_lds((const unsigned*)((const char*)(gbase) + vb[_i]), (LAS unsigned*)(lds + (bufoff) + ldsw + _i * 8192), 16, 0, 0); } while (0)
#define PG8_LDA(dst, b, h) do { _Pragma("unroll") for (int m = 0; m < 4; ++m) { if constexpr (FP8) { const v4i_t _lo = *(const LAS v4i_t*)(lds + PG8_SA(b, h) + aoffk[0] + m * 2048), _hi = *(const LAS v4i_t*)(lds + PG8_SA(b, h) + aoffk[1] + m * 2048); \
            dst##8[m] = __builtin_shufflevector(_lo, _hi, 0, 1, 2, 3, 4, 5, 6, 7); } else { _Pragma("unroll") for (int k = 0; k < 2; ++k) dst[m][k] = *(const LAS bf16x8*)(lds + PG8_SA(b, h) + aoffk[k] + m * 2048); } } } while (0)
#define PG8_LDB(dst, b, h) do { _Pragma("unroll") for (int n = 0; n < 2; ++n) { if constexpr (FP8) { const v4i_t _lo = *(const LAS v4i_t*)(lds + PG8_SB(b, h) + boffk[0] + n * 2048), _hi = *(const LAS v4i_t*)(lds + PG8_SB(b, h) + boffk[1] + n * 2048); \
            dst##8[n] = __builtin_shufflevector(_lo, _hi, 0, 1, 2, 3, 4, 5, 6, 7); } else { _Pragma("unroll") for (int k = 0; k < 2; ++k) dst[n][k] = *(const LAS bf16x8*)(lds + PG8_SB(b, h) + boffk[k] + n * 2048); } } } while (0)
#define PG8_MMA(ai, bj, At, Bt) do { if constexpr (FP8) __builtin_amdgcn_sched_barrier(0); __builtin_amdgcn_s_setprio(1); _Pragma("unroll") for (int m = 0; m < 4; ++m) _Pragma("unroll") for (int n = 0; n < 2; ++n) { \
        if constexpr (FP8) { acc[ai][bj][m][n] = __builtin_amdgcn_mfma_scale_f32_16x16x128_f8f6f4(Bt##8[n], At##8[m], acc[ai][bj][m][n], 0, 0, 0, 0x7F7F7F7F, 0, 0x7F7F7F7F); } \
        else { _Pragma("unroll") for (int k = 0; k < 2; ++k) acc[ai][bj][m][n] = __builtin_amdgcn_mfma_f32_16x16x32_bf16(Bt[n][k], At[m][k], acc[ai][bj][m][n], 0, 0, 0); } } __builtin_amdgcn_s_setprio(0); if constexpr (FP8) { asm volatile("" : "+v"(acc[ai][bj][0][0]), "+v"(acc[ai][bj][0][1]), "+v"(acc[ai][bj][1][0]), "+v"(acc[ai][bj][1][1]), "+v"(acc[ai][bj][2][0]), "+v"(acc[ai][bj][2][1]), "+v"(acc[ai][bj][3][0]), "+v"(acc[ai][bj][3][1])); __builtin_amdgcn_sched_barrier(0); } } while (0)
#define PG8_WAIT_V(n) asm volatile("s_waitcnt vmcnt(" #n ")" ::: "memory")
#define PG8_WAIT_VN(N) asm volatile("s_waitcnt vmcnt(%0)" :: "n"(N) : "memory")
#define PG8_WAIT_VR(flag, N) asm volatile("s_waitcnt vmcnt(%1)\n\ts_cmp_lg_u32 %0, 0\n\ts_cbranch_scc1 .Lrx%=\n\ts_waitcnt vmcnt(8)\n.Lrx%=:" :: "s"(flag), "n"(N) : "memory", "scc")
#define PG8_WAIT_L(n) asm volatile("s_waitcnt lgkmcnt(" #n ")" ::: "memory")
#define PG8_BAR __builtin_amdgcn_s_barrier()
#define PG8_SCHED __builtin_amdgcn_sched_barrier(0)
    Unit cur, nxt; int ui = 0;
    if (!S.next(0, cur)) return;
    f32x4 acc[2][2][4][2];
#pragma unroll
    for (int a = 0; a < 2; ++a)
#pragma unroll
        for (int b = 0; b < 2; ++b)
#pragma unroll
            for (int m = 0; m < 4; ++m)
#pragma unroll
                for (int n = 0; n < 2; ++n) acc[a][b][m][n] = (f32x4){0.f, 0.f, 0.f, 0.f};
    bf16x8 At[4][2], B0[2][2], B1[2][2];
    v8i_t At8[4], B08[2], B18[2];
    const char* cA = cur.A; const char* cB = cur.B;
    PG8_STAGEB(PG8_SB(0, 0), cB); PG8_STAGEB(PG8_SB(0, 1), cB + hstep); PG8_STAGEA(PG8_SA(0, 0), cA, cur.va, 0); PG8_STAGEA(PG8_SA(0, 1), cA, cur.va, 1);
    if (wr == 1) PG8_BAR;
    PG8_WAIT_V(2); PG8_BAR;
    PG8_STAGEB(PG8_SB(1, 0), cB + kstep); PG8_STAGEA(PG8_SA(1, 0), cA + kstep, cur.va, 0); PG8_STAGEB(PG8_SB(1, 1), cB + hstep + kstep);
    PG8_WAIT_V(6); PG8_BAR;
    for (;;) {
#ifdef PROBE_KDUP
        const bool has_next = S.next((ui + 1) >> 1, nxt);
#else
        const bool has_next = S.next(ui + 1, nxt);
#endif
        if (!has_next) { nxt.A = cA; nxt.B = cB; if constexpr (Sched::GATHER) { nxt.va[0][0] = cur.va[0][0]; nxt.va[0][1] = cur.va[0][1]; nxt.va[1][0] = cur.va[1][0]; nxt.va[1][1] = cur.va[1][1]; } }
        const char* nA = nxt.A; const char* nB = nxt.B;
#pragma unroll 1
        for (int t = 0; t < nt; t += 2) {
            const bool last = (t == nt - 2);
#ifdef PROBE_KDUP
            const int relax = __builtin_amdgcn_readfirstlane(((t == 0) && (ui > 0) && ((ui & 1) == 0)) ? 1 : 0);
#else
            const int relax = __builtin_amdgcn_readfirstlane(((t == 0) && (ui > 0)) ? 1 : 0);
#endif
            const char* a1 = cA + (size_t)(t + 1) * kstep;
            const char* a2 = last ? nA : cA + (size_t)(t + 2) * kstep; const char* b2 = last ? nB : cB + (size_t)(t + 2) * kstep;
            const char* a3 = a2 + kstep; const char* b3 = b2 + kstep;
            if constexpr (FP8) { asm volatile("" : "+s"(a1), "+s"(a2), "+s"(b2), "+s"(a3), "+s"(b3)); }
            unsigned v2[2][2];
            if constexpr (Sched::GATHER) { v2[0][0] = last ? nxt.va[0][0] : cur.va[0][0]; v2[0][1] = last ? nxt.va[0][1] : cur.va[0][1]; v2[1][0] = last ? nxt.va[1][0] : cur.va[1][0]; v2[1][1] = last ? nxt.va[1][1] : cur.va[1][1]; }
            else { v2[0][0] = cur.va[0][0]; v2[0][1] = cur.va[0][1]; v2[1][0] = cur.va[1][0]; v2[1][1] = cur.va[1][1]; }
            PG8_LDB(B0, 0, 0); PG8_LDB(B1, 0, 1); PG8_SCHED; PG8_LDA(At, 0, 0);
            PG8_STAGEA(PG8_SA(1, 1), a1, cur.va, 1); PG8_WAIT_VR(relax, 8 + Epi::NISS);
            PG8_WAIT_L(0); PG8_BAR; PG8_MMA(0, 0, At, B0); PG8_MMA(0, 1, At, B1); PG8_BAR; PG8_SCHED;
            PG8_LDA(At, 0, 1); PG8_STAGEB(PG8_SB(0, 0), b2); PG8_STAGEB(PG8_SB(0, 1), b2 + hstep); PG8_STAGEA(PG8_SA(0, 0), a2, v2, 0);
            PG8_WAIT_V(8);
            PG8_WAIT_L(0); PG8_BAR; PG8_MMA(1, 0, At, B0); PG8_MMA(1, 1, At, B1); PG8_BAR; PG8_SCHED;
            PG8_LDB(B0, 1, 0); PG8_LDB(B1, 1, 1); PG8_SCHED; PG8_LDA(At, 1, 0); PG8_STAGEA(PG8_SA(0, 1), a2, v2, 1);
            PG8_WAIT_V(8);
            PG8_WAIT_L(0); PG8_BAR; PG8_MMA(0, 0, At, B0); PG8_MMA(0, 1, At, B1); PG8_BAR; PG8_SCHED;
            PG8_LDA(At, 1, 1); PG8_STAGEB(PG8_SB(1, 0), b3); PG8_STAGEB(PG8_SB(1, 1), b3 + hstep); PG8_STAGEA(PG8_SA(1, 0), a3, v2, 0);
            PG8_WAIT_V(8); PG8_WAIT_L(0); PG8_BAR; PG8_MMA(1, 0, At, B0); PG8_MMA(1, 1, At, B1); PG8_BAR; PG8_SCHED;
        }
        if constexpr (ALIGN_EPI) { if (wr == 0) PG8_BAR; }
        asm volatile("" ::: "memory");
#ifdef PROBE_KDUP
        if (ui & 1)
#endif
        E(acc, cur, wr, wc, fr, fq);
#ifdef PROBE_DRAIN
        asm volatile("s_waitcnt vmcnt(0)" ::: "memory");
#endif
#ifdef PROBE_EPI2
        if constexpr (Epi::IDEM) { asm volatile("" ::: "memory"); E(acc, cur, wr, wc, fr, fq); }
#endif
        if (!has_next) break;
#pragma unroll
        for (int a = 0; a < 2; ++a)
#pragma unroll
            for (int b = 0; b < 2; ++b)
#pragma unroll
                for (int m = 0; m < 4; ++m)
#pragma unroll
                    for (int n = 0; n < 2; ++n) acc[a][b][m][n] = (f32x4){0.f, 0.f, 0.f, 0.f};
        if constexpr (Sched::GATHER) cur = nxt; else { cur.A = nxt.A; cur.B = nxt.B; cur.pm = nxt.pm; cur.pn = nxt.pn; cur.aux = nxt.aux; }
        cA = nA; cB = nB; ++ui;
        if constexpr (ALIGN_EPI) { if (wr == 1) PG8_BAR; }
    }
    PG8_WAIT_V(0);
    if constexpr (!ALIGN_EPI) { if (wr == 0) PG8_BAR; }
    PG8_BAR;
#undef PG8_SA
#undef PG8_SB
#undef PG8_STAGEA
#undef PG8_STAGEB
#undef PG8_LDA
#undef PG8_LDB
#undef PG8_MMA
#undef PG8_WAIT_V
#undef PG8_WAIT_L
#undef PG8_BAR
#undef PG8_SCHED
}
__device__ __forceinline__ void contig_va(unsigned (&va)[2][2], unsigned lda) {
    const int tid = threadIdx.x;
#pragma unroll
    for (int i = 0; i < 2; ++i) { int R, C; stage_rc(tid * 16 + i * 8192, R, C); va[0][i] = (unsigned)R * lda + (unsigned)C * 2u; va[1][i] = (unsigned)(R + HALF) * lda + (unsigned)C * 2u; }
}
}


template <int BM> __device__ __forceinline__ u32x4 sel_ror8(const u32x4 keep, const u32x4 src) { u32x4 r;
    r.x = (unsigned)__builtin_amdgcn_update_dpp((int)keep.x, (int)src.x, 0x128, 0xf, BM, false); r.y = (unsigned)__builtin_amdgcn_update_dpp((int)keep.y, (int)src.y, 0x128, 0xf, BM, false);
    r.z = (unsigned)__builtin_amdgcn_update_dpp((int)keep.z, (int)src.z, 0x128, 0xf, BM, false); r.w = (unsigned)__builtin_amdgcn_update_dpp((int)keep.w, (int)src.w, 0x128, 0xf, BM, false); return r; }
__device__ __forceinline__ void st_lines(bf16_t* line0, size_t pitch  , int fr, int fq, const u32x4 p0, const u32x4 p1) {
    const bool lo = fr < 8;
    const u32x4 d0 = sel_ror8<0xC>(p0, p1);
    const u32x4 d1 = sel_ror8<0x3>(p1, p0);
    bf16_t* a = line0 + (size_t)(fr & 7) * pitch + (lo ? 0 : 32) + 8 * fq; bf16_t* a2 = a + 8 * pitch;
    asm volatile("global_store_dwordx4 %0, %1, off sc1\n\ts_nop 1" :: "v"(a), "v"(d0) : "memory");
    asm volatile("global_store_dwordx4 %0, %1, off sc1\n\ts_nop 1" :: "v"(a2), "v"(d1) : "memory");
}
__device__ __forceinline__ void ld_lines(const bf16_t* line0, size_t pitch, int fr, int fq, u32x4& p0, u32x4& p1) {
    const bool lo = fr < 8; const bf16_t* a = line0 + (size_t)(fr & 7) * pitch + (lo ? 0 : 32) + 8 * fq;
    const u32x4 l1 = *(const u32x4*)a, l2 = *(const u32x4*)(a + 8 * pitch);
    p0 = sel_ror8<0xC>(l1, l2);
    p1 = sel_ror8<0x3>(l2, l1);
}
__device__ __forceinline__ u32x4 pack8(const f32x4 v0, const f32x4 v1) { u32x4 w; w.x = cvt_pk_bf16(v0[0], v0[1]); w.y = cvt_pk_bf16(v0[2], v0[3]); w.z = cvt_pk_bf16(v1[0], v1[1]); w.w = cvt_pk_bf16(v1[2], v1[3]); return w; }

struct Frame {
    LAS unsigned char* lds;
    unsigned* ctl;
    int tid, lane, wave, vcu, G;
    const float* in[27];
    float* out;
    unsigned char* ws;
};
struct Args { const float* in[27]; float* out; unsigned char* ws; int ph_lo, ph_hi; };

__device__ __forceinline__ void p_adaln(Frame& F) {
    const int wg = blockIdx.x, tid = F.tid;
    if (wg >= 192) return;
    const float* c = F.in[1]; const float* cctx = F.in[3]; const float* wmod = F.in[4]; const float* bmod = F.in[5];
    float* mod = (float*)(F.ws + WS_MOD);
    LAS float* sc = (LAS float*)F.lds;
    for (int i = tid; i < 33 * 1024; i += NTHR) { const int r = i >> 10, k = i & 1023; const float v = (r < 32) ? c[r * 1024 + k] : cctx[k]; sc[k * 36 + r] = v / (1.f + expf(-v)); }
    __syncthreads();
    const int col = tid & 31, kq = tid >> 5, j = wg * 32 + col;
    float acc[33];
#pragma unroll
    for (int r = 0; r < 33; ++r) acc[r] = 0.f;
    for (int kk = 0; kk < 64; ++kk) {
        const int k = kq * 64 + kk; const float w = wmod[(size_t)k * 6144 + j];
        const LAS f32x4* sp = (const LAS f32x4*)(sc + k * 36);
#pragma unroll
        for (int q = 0; q < 8; ++q) { const f32x4 s4 = sp[q]; acc[4 * q] += s4[0] * w; acc[4 * q + 1] += s4[1] * w; acc[4 * q + 2] += s4[2] * w; acc[4 * q + 3] += s4[3] * w; }
        acc[32] += sc[k * 36 + 32] * w;
    }
    __syncthreads();
    LAS float* red = (LAS float*)F.lds;
#pragma unroll
    for (int r = 0; r < 33; ++r) red[(kq * 33 + r) * 32 + col] = acc[r];
    __syncthreads();
    for (int o = tid; o < 33 * 32; o += NTHR) { const int r = o >> 5, cc = o & 31; float s = 0.f;
#pragma unroll
        for (int q = 0; q < 16; ++q) s += red[(q * 33 + r) * 32 + cc];
        mod[r * 6144 + wg * 32 + cc] = s + bmod[wg * 32 + cc]; }
    __syncthreads();
}
__device__ __forceinline__ void transpose_item(const float* W, int ldw, int k0, int n0, bf16_t* WT, int ldk, int dst_row0, LAS float* scr, int lane, float scale = 1.f) {
    float tv[32];
#pragma unroll
    for (int i = 0; i < 32; ++i) { const int kk = 2 * i + (lane >> 5); tv[i] = W[(size_t)(k0 + kk) * ldw + n0 + (lane & 31)]; }
#pragma unroll
    for (int i = 0; i < 32; ++i) { const int kk = 2 * i + (lane >> 5); scr[kk * 33 + (lane & 31)] = tv[i]; }
    LDS_WAIT(); asm volatile("" ::: "memory");
    const int c = lane & 7;
#pragma unroll
    for (int j = 0; j < 4; ++j) { const int n = (lane >> 3) + 8 * j; const LAS float* s = scr + (8 * c) * 33 + n;
        u32x4 o; o.x = cvt_pk_bf16(s[0 * 33] * scale, s[1 * 33] * scale); o.y = cvt_pk_bf16(s[2 * 33] * scale, s[3 * 33] * scale); o.z = cvt_pk_bf16(s[4 * 33] * scale, s[5 * 33] * scale); o.w = cvt_pk_bf16(s[6 * 33] * scale, s[7 * 33] * scale);
        *(u32x4*)(WT + (size_t)(dst_row0 + n) * ldk + k0 + 8 * c) = o; }
    LDS_WAIT(); asm volatile("" ::: "memory");
}
__device__ __forceinline__ void transpose_item8(const float* W, int ldw, int k0, int n0, unsigned char* WT8, int ldk, int dst_row0, LAS float* scr, int lane, float scale) {
    float tv[32];
#pragma unroll
    for (int i = 0; i < 32; ++i) { const int kk = 2 * i + (lane >> 5); tv[i] = W[(size_t)(k0 + kk) * ldw + n0 + (lane & 31)]; }
#pragma unroll
    for (int i = 0; i < 32; ++i) { const int kk = 2 * i + (lane >> 5); scr[kk * 33 + (lane & 31)] = tv[i]; }
    LDS_WAIT(); asm volatile("" ::: "memory");
    const int c = lane & 7;
#pragma unroll
    for (int j = 0; j < 4; ++j) { const int n = (lane >> 3) + 8 * j; const LAS float* sp = scr + (8 * c) * 33 + n;
        u32x2 o; o.x = pk4_fp8(sp[0 * 33] * scale, sp[1 * 33] * scale, sp[2 * 33] * scale, sp[3 * 33] * scale); o.y = pk4_fp8(sp[4 * 33] * scale, sp[5 * 33] * scale, sp[6 * 33] * scale, sp[7 * 33] * scale);
        *(u32x2*)(WT8 + (size_t)(dst_row0 + n) * ldk + k0 + 8 * c) = o; }
    LDS_WAIT(); asm volatile("" ::: "memory");
}
__device__ __forceinline__ void p_wpeff_block(Frame& F, int blk) {
    const int tid = F.tid, gi = blk >> 3, eb = blk & 7;
    const float* pw = F.in[14] + (size_t)gi * 128 * 128; const float* ps = F.in[15] + gi * 128; const float* wbr = F.in[16] + (size_t)(gi * 128) * 1024 + eb * 128;
    bf16_t* WP = (bf16_t*)(F.ws + WS_WP);
    LAS float* At = (LAS float*)F.lds;
    LAS float* Bs = At + 128 * 128;
    for (int i = tid; i < 128 * 32; i += NTHR) { const int c = i & 127, j4 = (i >> 7) * 4; const f32x4 v = *(const f32x4*)(pw + c * 128 + j4);     At[(j4 + 0) * 128 + c] = v[0]; At[(j4 + 1) * 128 + c] = v[1]; At[(j4 + 2) * 128 + c] = v[2]; At[(j4 + 3) * 128 + c] = v[3]; }
    for (int i = tid; i < 128 * 32; i += NTHR) { const int j = i >> 5, e4 = (i & 31) * 4; const f32x4 v = *(const f32x4*)(wbr + (size_t)j * 1024 + e4); *(LAS f32x4*)(Bs + j * 128 + e4) = v * ps[j]; }
    __syncthreads();
    const int c0 = (tid >> 4) * 4, e0 = (tid & 15) * 8;
    f32x4 acc[4][2];
#pragma unroll
    for (int q = 0; q < 4; ++q) { acc[q][0] = (f32x4){0.f, 0.f, 0.f, 0.f}; acc[q][1] = (f32x4){0.f, 0.f, 0.f, 0.f}; }
#pragma unroll 4
    for (int j = 0; j < 128; ++j) { const f32x4 a = *(const LAS f32x4*)(At + j * 128 + c0), b0 = *(const LAS f32x4*)(Bs + j * 128 + e0), b1 = *(const LAS f32x4*)(Bs + j * 128 + e0 + 4);
#pragma unroll
        for (int q = 0; q < 4; ++q) { acc[q][0] += b0 * a[q]; acc[q][1] += b1 * a[q]; } }
#pragma unroll
    for (int h2 = 0; h2 < 2; ++h2)
#pragma unroll
        for (int x = 0; x < 4; ++x) { const int e = eb * 128 + e0 + 4 * h2 + x;
            *(u32x2*)(WP + (size_t)e * 512 + gi * 128 + c0) = (u32x2){cvt_pk_bf16(acc[0][h2][x], acc[1][h2][x]), cvt_pk_bf16(acc[2][h2][x], acc[3][h2][x])}; }
    __syncthreads();
}
__device__ __forceinline__ void p_convert(Frame& F, const bool do_base, const bool do_moe) {
    LAS float* scr = (LAS float*)(F.lds + F.wave * 16384);
    const int gw = F.vcu * NWAVES + F.wave, NGW = F.G * NWAVES, lane = F.lane;
    bf16_t* WIN = (bf16_t*)(F.ws + WS_WIN); bf16_t* WGLA = (bf16_t*)(F.ws + WS_WGLA); bf16_t* WO = (bf16_t*)(F.ws + WS_WO);
    bf16_t* W13 = (bf16_t*)(F.ws + WS_W13); bf16_t* W2 = (bf16_t*)(F.ws + WS_W2); bf16_t* WP = (bf16_t*)(F.ws + WS_WP);
    constexpr int I_IN = 16 * 177, I_SQ = 16 * 32, I_13 = 64 * 256, I_2 = 32 * 256;
    constexpr int NITEMS = I_IN + 2 * I_SQ + I_13 + I_2;
    for (int it = gw + (do_base ? 0 : I_IN + 2 * I_SQ); it < (do_moe ? NITEMS : I_IN + 2 * I_SQ); it += NGW) {
        int r = it;
        if (r < I_IN) { const int kb = r / 177, nb = r % 177; transpose_item(F.in[8], DIN, 64 * kb, 32 * nb, WIN, 1024, 32 * nb, scr, lane, (nb >= 16 && nb < 32) ? 0.08838834764831845f : 1.f); continue; }   r -= I_IN;
        if (r < I_SQ) { const int kb = r / 32, nb = r % 32; transpose_item(F.in[17], 1024, 64 * kb, 32 * nb, WGLA, 1024, 32 * nb, scr, lane); continue; } r -= I_SQ;
        if (r < I_SQ) { const int kb = r / 32, nb = r % 32; transpose_item(F.in[18], 1024, 64 * kb, 32 * nb, WO, 1024, 32 * nb, scr, lane); continue; } r -= I_SQ;
        if (r < I_13) { const int mat = r / 256, e = mat >> 1, which = mat & 1, rr = r % 256, kb = rr / 16, nb = rr % 16, n0 = 32 * nb;
            const float* src = (which ? F.in[24] : F.in[23]) + (size_t)e * 1024 * 512;
            if (MOE_FP8) transpose_item8(src, 512, 64 * kb, n0, (unsigned char*)W13 + (size_t)e * 1024 * 1024, 1024, (n0 / 128) * 256 + ((n0 % 128) / 32) * 64 + which * 32, scr, lane, SC_W13);
            else transpose_item(src, 512, 64 * kb, n0, W13 + (size_t)e * 1024 * 1024, 1024, (n0 / 128) * 256 + ((n0 % 128) / 32) * 64 + which * 32, scr, lane);
            continue; } r -= I_13;
        { const int e = r / 256, rr = r % 256, kb = rr / 32, nb = rr % 32;
            if (MOE2_FP8) transpose_item8(F.in[25] + (size_t)e * 512 * 1024, 1024, 64 * kb, 32 * nb, (unsigned char*)W2 + (size_t)e * 1024 * 512, 512, 32 * nb, scr, lane, SC_W2);
            else transpose_item(F.in[25] + (size_t)e * 512 * 1024, 1024, 64 * kb, 32 * nb, W2 + (size_t)e * 1024 * 512, 512, 32 * nb, scr, lane); }
    }
}

__device__ __forceinline__ void norm_rows(const float* src, bf16_t* dst, int row0, int nrows  , const float* gain, const float* scv, const float* shv, int lane) {
    f32x4 Av[4], Bv[4];
#pragma unroll
    for (int q = 0; q < 4; ++q) { const int c = 8 * lane + 512 * (q >> 1) + 4 * (q & 1); const f32x4 g = *(const f32x4*)(gain + c), sc = *(const f32x4*)(scv + c); Av[q] = g * (sc + 1.f); Bv[q] = *(const f32x4*)(shv + c); }
    f32x4 buf[4][4];
#pragma unroll
    for (int p = 0; p < 4; ++p)
#pragma unroll
        for (int q = 0; q < 4; ++q) buf[p][q] = *(const f32x4*)(src + (size_t)(row0 + p) * D + 8 * lane + 512 * (q >> 1) + 4 * (q & 1));
    for (int r = 0; r < nrows; r += 4) {
#pragma unroll
        for (int p = 0; p < 4; ++p) {
            f32x4 v[4]; float ss = 0.f;
#pragma unroll
            for (int q = 0; q < 4; ++q) v[q] = buf[p][q];
            if (r + 4 + p < nrows) {
#pragma unroll
                for (int q = 0; q < 4; ++q) buf[p][q] = *(const f32x4*)(src + (size_t)(row0 + r + 4 + p) * D + 8 * lane + 512 * (q >> 1) + 4 * (q & 1)); }
#pragma unroll
            for (int q = 0; q < 4; ++q) ss += (v[q][0] * v[q][0] + v[q][1] * v[q][1]) + (v[q][2] * v[q][2] + v[q][3] * v[q][3]);
            const float rstd = 1.f / sqrtf(wave_sum(ss) * (1.f / D) + EPS);
            bf16_t* orow = dst + (size_t)(row0 + r + p) * D;
#pragma unroll
            for (int j = 0; j < 2; ++j) { const f32x4 h0 = v[2 * j] * rstd * Av[2 * j] + Bv[2 * j], h1 = v[2 * j + 1] * rstd * Av[2 * j + 1] + Bv[2 * j + 1]; *(u32x4*)(orow + 8 * lane + 512 * j) = pack8(h0, h1); }
        }
    }
}
#define LDS_BARRIER() asm volatile("s_waitcnt lgkmcnt(0)\n\ts_barrier" ::: "memory")
template <bool LOADN>
__device__ __forceinline__ void norm1_step(const Frame& F, f32x4 (&cur)[4][4], f32x4 (&nxt)[4][4], const float* nsrc, bf16_t* drow, const f32x4 (&Av)[4], const f32x4 (&Bv)[4], const bf16x8 (&wf)[2][4],
                                           float* lrbase, const int lrmul) {
    const int lane = F.lane, wave = F.wave, tid = F.tid;
    constexpr int SROW = 2064;
    LAS unsigned char* stage = F.lds;
    LAS float* part = (LAS float*)(F.lds + 66560);
#pragma unroll
    for (int p = 0; p < 4; ++p) {
        float ss = 0.f;
        if (LOADN) {
#pragma unroll
            for (int q = 0; q < 4; ++q) nxt[p][q] = *(const f32x4*)(nsrc + (size_t)p * D + 8 * lane + 512 * (q >> 1) + 4 * (q & 1)); }
#pragma unroll
        for (int q = 0; q < 4; ++q) ss += (cur[p][q][0] * cur[p][q][0] + cur[p][q][1] * cur[p][q][1]) + (cur[p][q][2] * cur[p][q][2] + cur[p][q][3] * cur[p][q][3]);
        const float rstd = 1.f / sqrtf(wave_sum(ss) * (1.f / D) + EPS);
#pragma unroll
        for (int j = 0; j < 2; ++j) { const f32x4 h0 = cur[p][2 * j] * rstd * Av[2 * j] + Bv[2 * j], h1 = cur[p][2 * j + 1] * rstd * Av[2 * j + 1] + Bv[2 * j + 1]; const u32x4 h = pack8(h0, h1);
            *(u32x4*)(drow + (size_t)p * D + 8 * lane + 512 * j) = h; *(LAS u32x4*)(stage + (4 * wave + p) * SROW + (8 * lane + 512 * j) * 2) = h; }
    }
    LDS_BARRIER();
    f32x4 acc[2][2];
#pragma unroll
    for (int nb = 0; nb < 2; ++nb)
#pragma unroll
        for (int nh = 0; nh < 2; ++nh) acc[nb][nh] = (f32x4){0.f, 0.f, 0.f, 0.f};
#pragma unroll
    for (int nb = 0; nb < 2; ++nb)
#pragma unroll
        for (int ks = 0; ks < 4; ++ks) { const bf16x8 bfr = *(LAS bf16x8*)(stage + (16 * nb + (lane & 15)) * SROW + (128 * wave + 32 * ks + 8 * (lane >> 4)) * 2);
#pragma unroll
            for (int nh = 0; nh < 2; ++nh) acc[nb][nh] = __builtin_amdgcn_mfma_f32_16x16x32_bf16(wf[nh][ks], bfr, acc[nb][nh], 0, 0, 0); }
#pragma unroll
    for (int nb = 0; nb < 2; ++nb)
#pragma unroll
        for (int nh = 0; nh < 2; ++nh) *(LAS f32x4*)(part + ((wave * 4 + nb * 2 + nh) * 64 + lane) * 4) = acc[nb][nh];
    LDS_BARRIER();
    {
        const int q = tid >> 7, ln = (tid & 127) >> 1, ip = tid & 1;
        f32x2 sum = (f32x2){0.f, 0.f};
#pragma unroll
        for (int w8 = 0; w8 < 8; ++w8) sum += *(LAS f32x2*)(part + ((w8 * 4 + q) * 64 + ln) * 4 + 2 * ip);
        const int slot = 16 * (q >> 1) + (ln & 15), n = 16 * (q & 1) + 4 * (ln >> 4) + 2 * ip;
        *(f32x2*)(lrbase + ((size_t)lrmul * (slot >> 2) + (slot & 3)) * 32 + n) = sum; }
}
__device__ __forceinline__ void p_norm1(Frame& F) {
    const int lane = F.lane, wave = F.wave;
    const float* mod = (const float*)(F.ws + WS_MOD); bf16_t* HX = (bf16_t*)(F.ws + WS_HX); float* LR = (float*)(F.ws + WS_LR);
    const bf16_t* WIN = (const bf16_t*)(F.ws + WS_WIN);
    bf16x8 wf[2][4];
#pragma unroll
    for (int nh = 0; nh < 2; ++nh)
#pragma unroll
        for (int ks = 0; ks < 4; ++ks) wf[nh][ks] = *(const bf16x8*)(WIN + (size_t)(5632 + 16 * nh + (lane & 15)) * 1024 + 128 * wave + 32 * ks + 8 * (lane >> 4));
    for (int wv = F.vcu; wv < 256; wv += F.G) {
        const int gw = wv * NWAVES + wave, b = wv >> 3;
        f32x4 Av[4], Bv[4];
#pragma unroll
        for (int q = 0; q < 4; ++q) { const int c = 8 * lane + 512 * (q >> 1) + 4 * (q & 1); const f32x4 g = *(const f32x4*)(F.in[6] + c), sc = *(const f32x4*)(mod + b * 6144 + 1024 + c); Av[q] = g * (sc + 1.f); Bv[q] = *(const f32x4*)(mod + b * 6144 + c); }
        f32x4 bufA[4][4], bufB[4][4];
        const float* xr = F.in[0] + (size_t)32 * gw * D; bf16_t* hr = HX + (size_t)32 * gw * D; float* lr = LR + (size_t)32 * wv * NWAVES * 32;
#pragma unroll
        for (int p = 0; p < 4; ++p)
#pragma unroll
            for (int q = 0; q < 4; ++q) bufA[p][q] = *(const f32x4*)(xr + (size_t)p * D + 8 * lane + 512 * (q >> 1) + 4 * (q & 1));
#pragma unroll 1
        for (int i2 = 0; i2 < 3; ++i2) {
            norm1_step<true>(F, bufA, bufB, xr + (size_t)(8 * i2 + 4) * D, hr + (size_t)(8 * i2) * D, Av, Bv, wf, lr + (size_t)(8 * i2) * 32, 32);
            norm1_step<true>(F, bufB, bufA, xr + (size_t)(8 * i2 + 8) * D, hr + (size_t)(8 * i2 + 4) * D, Av, Bv, wf, lr + (size_t)(8 * i2 + 4) * 32, 32);
        }
        norm1_step<true>(F, bufA, bufB, xr + (size_t)28 * D, hr + (size_t)24 * D, Av, Bv, wf, lr + (size_t)24 * 32, 32);
        norm1_step<true>(F, bufB, bufA, F.in[2] + (size_t)4 * gw * D, hr + (size_t)28 * D, Av, Bv, wf, lr + (size_t)28 * 32, 32);
#pragma unroll
        for (int q = 0; q < 4; ++q) { const int c = 8 * lane + 512 * (q >> 1) + 4 * (q & 1); const f32x4 g = *(const f32x4*)(F.in[6] + c), sc = *(const f32x4*)(mod + 32 * 6144 + 1024 + c); Av[q] = g * (sc + 1.f); Bv[q] = *(const f32x4*)(mod + 32 * 6144 + c); }
        norm1_step<false>(F, bufA, bufB, nullptr, HX + ((size_t)T + 4 * gw) * D, Av, Bv, wf, LR + ((size_t)T + 4 * wv * NWAVES) * 32, 4);
    }
    __syncthreads();
}

struct SchedG1 {
    static constexpr bool GATHER = false;
    const char* HX; const char* WIN; int G, c;
    __device__ __forceinline__ bool next(int i, pg8::Unit& u) const {
        const int L = i * G + c; constexpr int NL = 256 * 22, NC = 32 * 6;
        if (L >= NL + NC) return false;
        int pm, pn, ctx = 0;
        if (L < NL) pg8::static_tile(L, 256, 22, pm, pn);
        else { const int j = L - NL; pm = j & 31; pn = 4 + (j >> 5); ctx = 1; }
        u.pm = pm; u.pn = pn; u.aux = ctx;
        u.A = HX + ((size_t)(ctx ? T : 0) + (size_t)pm * 256) * (D * 2); u.B = WIN + (size_t)pn * 256 * (D * 2);
        pg8::contig_va(u.va, D * 2);
        return true;
    }
};
struct EpiG1 {
    static constexpr int NISS = 16; static constexpr bool IDEM = true; static constexpr bool PERM = true;
    unsigned char* ws;
    __device__ __forceinline__ void operator()(const f32x4 (&acc)[2][2][4][2], const pg8::Unit& u, int wr, int wc, int fr, int fq) const {
        const int pn = u.pn, ctx = u.aux; const int rowg = u.pm * 256 + wr * 64;
        bf16_t* base; int ldc, colt;
        if (ctx) { base = (bf16_t*)(ws + WS_PKVC); ldc = 1536; colt = (pn - 4) * 256; }
        else if (pn < 2) { base = (bf16_t*)(ws + WS_PU); ldc = 512; colt = pn * 256; }
        else if (pn < 10) { base = (bf16_t*)(ws + WS_PQKV); ldc = 2048; colt = (pn - 2) * 256; }
        else if (pn < 14) { base = (bf16_t*)(ws + WS_PG); ldc = 1024; colt = (pn - 10) * 256; }
        else { base = (bf16_t*)(ws + WS_PGATES); ldc = 2048; colt = (pn - 14) * 256; }
        bf16_t* blk = base + (size_t)rowg * ldc + colt + wc * 64;
#pragma unroll
        for (int ai = 0; ai < 2; ++ai)
#pragma unroll
            for (int m = 0; m < 4; ++m)
                st_lines(blk + (size_t)(ai * 128 + m * 16) * ldc, (size_t)ldc, fr, fq, pack8(acc[ai][0][m][0], acc[ai][0][m][1]), pack8(acc[ai][1][m][0], acc[ai][1][m][1]));
    }
};

typedef float f32x16 __attribute__((ext_vector_type(16)));
typedef short s16x4 __attribute__((ext_vector_type(4)));
typedef __bf16 bf16v2_t __attribute__((ext_vector_type(2)));
__device__ __forceinline__ unsigned pkbf(float a, float b) { bf16v2_t v; v[0] = (__bf16)a; v[1] = (__bf16)b; return __builtin_bit_cast(unsigned, v); }
__device__ __forceinline__ unsigned off_b(unsigned row, unsigned ch) { return 256u * row + 16u * (ch ^ (((row & 3u) << 2) | ((row >> 2) & 3u))); }
__device__ __forceinline__ unsigned tr_addr_b(unsigned lane, unsigned c, unsigned ks, unsigned t) {
    const unsigned h = lane >> 5, blk = (lane >> 4) & 1u, q = (lane & 15u) >> 2, pp = lane & 3u;
    return off_b(16u * ks + 8u * h + 4u * t + q, 4u * c + 2u * blk + (pp >> 1)) + 8u * (pp & 1u);
}
constexpr int GL_V = 0, GL_QD = 32768, GL_KI = 49152, GL_KR = 65536, GL_PM = 81920, GL_CUM = 90112, GL_DEC = 122880, GL_OT = 123392;
#define MFMA32(a, b, c) __builtin_amdgcn_mfma_f32_32x32x16_bf16((a), (b), (c), 0, 0, 0)
__device__ __forceinline__ void p_gla_chunk(Frame& F) {
    const int w = F.wave;
    LAS unsigned char* L = F.lds;
    const bf16_t* PQKV = (const bf16_t*)(F.ws + WS_PQKV); const bf16_t* PKVC = (const bf16_t*)(F.ws + WS_PKVC); const float* LR = (const float*)(F.ws + WS_LR);
    LAS float* CUM = (LAS float*)(L + GL_CUM); LAS float* DEC = (LAS float*)(L + GL_DEC);
    const int tid0 = F.tid;
    const int ib = w >> 2, db = w & 3;
    const unsigned A_vw = GL_V + (unsigned)((tid0 & 31) >> 4) * 16384u + off_b((unsigned)(tid0 >> 5), (unsigned)(tid0 & 15));
    const unsigned A_kr = off_b((unsigned)(tid0 >> 4), (unsigned)(tid0 & 15));
    const unsigned A_a0 = off_b((unsigned)(tid0 >> 4), (unsigned)(tid0 & 14)) + 8u * (unsigned)(tid0 & 1);
    unsigned RB, TB, PB, WB;
    { const unsigned lane0 = tid0 & 63, hh0 = lane0 >> 5, l310 = lane0 & 31; const unsigned tq = (lane0 & 15) >> 2, tp = lane0 & 3, tblk = (lane0 >> 4) & 1;
      RB = 256u * l310 + 16u * (((l310 & 3u) << 2) | ((l310 >> 2) & 3u));
      TB = 256u * (8u * hh0 + tq) + 8u * (tp & 1u) + 16u * ((2u * tblk + (tp >> 1)) ^ ((tq << 2) | (2u * hh0)));
      PB = 128u * l310 + 16u * (hh0 ^ ((l310 >> 1) & 7u));
      WB = 128u * l310 + 16u * ((l310 >> 1) & 7u) + 8u * hh0; }
    for (int wgi = blockIdx.x; wgi < 256; wgi += F.G) {
        const int b = wgi >> 3, h = (wgi >> 1) & 3, dir = wgi & 1;
        bf16_t* OD = (bf16_t*)F.out + (size_t)dir * T * D;
        const float* a2 = dir ? F.in[11] : F.in[9]; const float* ab = dir ? F.in[12] : F.in[10];
        float a2r[8];
#pragma unroll
        for (int kk = 0; kk < 8; ++kk) a2r[kk] = a2[(kk + 8 * ((tid0 >> 5) & 1)) * 512 + h * 128 + 32 * db + (tid0 & 31)];
        const float abd2 = -1.44269504089f * ab[h * 128 + 32 * db + (tid0 & 31)];
        unsigned vo = (unsigned)(dir ? 63 - (tid0 >> 5) : (tid0 >> 5)) * 3072u + 16u * (unsigned)(tid0 & 31);
        unsigned ko = (unsigned)(dir ? 63 - (tid0 >> 4) : (tid0 >> 4)) * 3072u + 16u * (unsigned)(tid0 & 15);
        const unsigned lvo = (unsigned)(dir ? 63 - (32 * ib + (tid0 & 31)) : (32 * ib + (tid0 & 31))) * 128u + 32u * (unsigned)((tid0 >> 5) & 1);
        f32x16 S[4];
#pragma unroll
        for (int q = 0; q < 4; ++q)
#pragma unroll
            for (int r = 0; r < 16; ++r) S[q][r] = 0.f;
        f32x4 lv[2]; u32x4 vreg[4], qreg[2], kreg[2];
#define GLA_LOAD(CH) do { const int _ch = (CH); const bool _ic = _ch < 4; const int _ci = _ic ? _ch : _ch - 4, _N = _ic ? CTXL : SEQ; const unsigned _rp2 = _ic ? 3072u : 4096u; \
            if (_ch == 4) { int _t = tid0; asm volatile("" : "+v"(_t)); vo = (unsigned)(dir ? 63 - (_t >> 5) : (_t >> 5)) * 4096u + 16u * (unsigned)(_t & 31); ko = (unsigned)(dir ? 63 - (_t >> 4) : (_t >> 4)) * 4096u + 16u * (unsigned)(_t & 15); } \
            const int _tok0 = dir ? (_N - 64 - 64 * _ci) : 64 * _ci; \
            const char* _gb = (const char*)(_ic ? PKVC + (size_t)b * CTXL * 1536 : PQKV + (size_t)b * SEQ * 2048) + (size_t)_tok0 * _rp2; \
            const int _qc = h * 128, _kc = _ic ? h * 128 : 512 + h * 128, _vc = _ic ? 512 + h * 256 : 1024 + h * 256; \
            const char* _lrb = (const char*)(LR + ((_ic ? (size_t)T + (size_t)b * CTXL : (size_t)b * SEQ) + _tok0) * 32 + dir * 16); \
            lv[0] = *(const f32x4*)(_lrb + (size_t)lvo); lv[1] = *(const f32x4*)(_lrb + 16 + (size_t)lvo); \
            const unsigned _vs = dir ? 0u - 16u * _rp2 : 16u * _rp2, _ks = dir ? 0u - 32u * _rp2 : 32u * _rp2;        \
            _Pragma("unroll") for (int q = 0; q < 4; ++q) vreg[q] = *(const u32x4*)(_gb + _vc * 2 + (size_t)(vo + (unsigned)q * _vs)); \
            _Pragma("unroll") for (int q = 0; q < 2; ++q) { kreg[q] = *(const u32x4*)(_gb + _kc * 2 + (size_t)(ko + (unsigned)q * _ks)); qreg[q] = *(const u32x4*)(_gb + _qc * 2 + (size_t)(ko + (unsigned)q * _ks)); } } while (0)
#define GLA_FLUSH(CI) do { const int _ci = (CI); const int _tok0 = dir ? (SEQ - 64 - 64 * _ci) : 64 * _ci; char* _ob = (char*)(OD + ((size_t)b * SEQ + _tok0) * D + h * 256); \
            const unsigned _fo = (unsigned)(dir ? 63 - (tid >> 5) : (tid >> 5)) * 2048u + 16u * (unsigned)(tid & 31), _fs = dir ? 0u - 16u * 2048u : 16u * 2048u; \
            const unsigned _fl = GL_OT + (unsigned)(tid >> 5) * 528u + (unsigned)(tid & 31) * 16u; \
            _Pragma("unroll") for (int q = 0; q < 4; ++q) *(u32x4*)(_ob + (size_t)(_fo + (unsigned)q * _fs)) = *(const LAS u32x4*)(L + _fl + 8448 * q); } while (0)
        GLA_LOAD(0);
        for (int ch = 0; ch < 36; ++ch) {
            const bool isctx = ch < 4;
            int tid = tid0; asm volatile("" : "+v"(tid), "+v"(RB), "+v"(TB), "+v"(PB), "+v"(WB));
            const int lane0 = tid & 63, hh = lane0 >> 5, l31 = lane0 & 31;
            f32x16 g;
#pragma unroll
            for (int r = 0; r < 16; ++r) g[r] = 0.f;
#pragma unroll
            for (int kk = 0; kk < 8; ++kk) g = __builtin_amdgcn_mfma_f32_32x32x2f32(lv[kk >> 2][kk & 3], a2r[kk], g, 0, 0, 0);
            float cum[16], gs[4], pg[4];
#pragma unroll
            for (int r = 0; r < 16; ++r) { const float a = __builtin_fmaf(g[r], -1.44269504089f, abd2);
                cum[r] = (fmaxf(a, 0.f) + __builtin_amdgcn_logf(1.f + __builtin_amdgcn_exp2f(-fabsf(a)))) * -0.0625f; }
#pragma unroll
            for (int q = 0; q < 4; ++q) { cum[4 * q + 1] += cum[4 * q]; cum[4 * q + 2] += cum[4 * q + 1]; cum[4 * q + 3] += cum[4 * q + 2]; gs[q] = cum[4 * q + 3]; }
#pragma unroll
            for (int q = 0; q < 4; ++q) pg[q] = xchg32(gs[q], lane0);
            { float run = 0.f;
#pragma unroll
                for (int q = 0; q < 4; ++q) { const float offq = run + (hh ? pg[q] : 0.f);
#pragma unroll
                    for (int e = 0; e < 4; ++e) cum[4 * q + e] += offq;
                    run += gs[q] + pg[q]; } }
            __syncthreads();
            if (ch >= 5) GLA_FLUSH(ch - 5);
            { LAS float* cw = (LAS float*)(L + GL_CUM) + (32 * ib + 4 * hh) * 128 + 32 * db + l31;
#pragma unroll
                for (int r = 0; r < 16; ++r) cw[((r & 3) + 8 * (r >> 2)) * 128] = cum[r]; }
#pragma unroll
            for (int q = 0; q < 4; ++q) *(LAS u32x4*)(L + A_vw + 4096 * q) = vreg[q];
            __syncthreads();
            {
                const unsigned A_tb = GL_CUM + 32u * (unsigned)(tid & 15), A_cb = A_tb + (unsigned)(tid >> 4) * 512u;
                const f32x4 t0 = *(const LAS f32x4*)(L + A_tb + 31 * 512), t1 = *(const LAS f32x4*)(L + A_tb + 31 * 512 + 16);
                const f32x4 l0 = *(const LAS f32x4*)(L + A_tb + 63 * 512) + t0, l1 = *(const LAS f32x4*)(L + A_tb + 63 * 512 + 16) + t1;
                float el8[8];
#pragma unroll
                for (int e = 0; e < 4; ++e) { el8[e] = __builtin_amdgcn_exp2f(l0[e]); el8[4 + e] = __builtin_amdgcn_exp2f(l1[e]); }
#pragma unroll
                for (int q = 0; q < 2; ++q) {
                    f32x4 c0 = *(const LAS f32x4*)(L + A_cb + 16384 * q), c1 = *(const LAS f32x4*)(L + A_cb + 16384 * q + 16);
                    if (q == 1) { c0 += t0; c1 += t1; }
                    float kf[8], qf[8], cc[8]; unpack8(kreg[q], kf); unpack8(qreg[q], qf);
#pragma unroll
                    for (int e = 0; e < 4; ++e) { cc[e] = c0[e]; cc[4 + e] = c1[e]; }
                    float kr[8], kiv[8], qd[8];
#pragma unroll
                    for (int e = 0; e < 8; ++e) { const float ex = __builtin_amdgcn_exp2f(cc[e]), inv = __builtin_amdgcn_exp2f(-cc[e]); qd[e] = qf[e] * ex; kiv[e] = kf[e] * inv; kr[e] = kiv[e] * el8[e]; }
                    u32x4 wk; wk.x = pkbf(kr[0], kr[1]); wk.y = pkbf(kr[2], kr[3]); wk.z = pkbf(kr[4], kr[5]); wk.w = pkbf(kr[6], kr[7]);
                    *(LAS u32x4*)(L + GL_KR + 8192 * q + A_kr) = wk;
                    if (!isctx) {
                        *(LAS u32x2*)(L + GL_QD + 8192 * q + A_a0) = (u32x2){pkbf(qd[0], qd[1]), pkbf(qd[2], qd[3])}; *(LAS u32x2*)(L + GL_QD + 8192 * q + (A_a0 ^ 16u)) = (u32x2){pkbf(qd[4], qd[5]), pkbf(qd[6], qd[7])};
                        *(LAS u32x2*)(L + GL_KI + 8192 * q + A_a0) = (u32x2){pkbf(kiv[0], kiv[1]), pkbf(kiv[2], kiv[3])}; *(LAS u32x2*)(L + GL_KI + 8192 * q + (A_a0 ^ 16u)) = (u32x2){pkbf(kiv[4], kiv[5]), pkbf(kiv[6], kiv[7])};
                    }
                }
            }
            if (w < 2) DEC[tid] = __builtin_amdgcn_exp2f(CUM[63 * 128 + tid] + CUM[31 * 128 + tid]);
            if (ch + 1 < 36) GLA_LOAD(ch + 1);
            __syncthreads();
            bf16x8 vb[4];
            { LAS unsigned char* vbase = L + GL_V + (w >> 2) * 16384; const unsigned c4 = (unsigned)(w & 3) << 2;
#pragma unroll
                for (int ks = 0; ks < 4; ++ks) { const s16x4 lo = __builtin_amdgcn_ds_read_tr16_b64_v4i16((LAS s16x4*)(vbase + (TB ^ (c4 << 4)) + 256 * (16 * ks)));
                    const s16x4 hi = __builtin_amdgcn_ds_read_tr16_b64_v4i16((LAS s16x4*)(vbase + (TB ^ ((c4 ^ 1u) << 4)) + 256 * (16 * ks + 4)));
                    vb[ks] = __builtin_shufflevector(lo, hi, 0, 1, 2, 3, 4, 5, 6, 7); } }
            f32x16 o[2];
            if (!isctx) {
                if (w < 3) {
                    const int jb = (w == 2) ? 1 : 0, ibs = (w == 0) ? 0 : 1;
                    f32x16 sc;
#pragma unroll
                    for (int r = 0; r < 16; ++r) sc[r] = 0.f;
                    bf16x8 kf2[2], qf2[2];
                    { const unsigned ro = RB ^ (unsigned)(hh << 4); kf2[0] = *(const LAS bf16x8*)(L + GL_KI + 8192 * jb + ro); qf2[0] = *(const LAS bf16x8*)(L + GL_QD + 8192 * ibs + ro); }
#pragma unroll
                    for (int s8 = 0; s8 < 8; ++s8) {
                        if (s8 + 1 < 8) { const unsigned ro = RB ^ (unsigned)((2 * (s8 + 1) + hh) << 4); kf2[(s8 + 1) & 1] = *(const LAS bf16x8*)(L + GL_KI + 8192 * jb + ro); qf2[(s8 + 1) & 1] = *(const LAS bf16x8*)(L + GL_QD + 8192 * ibs + ro); }
                        __builtin_amdgcn_sched_barrier(0);
                        sc = MFMA32(kf2[s8 & 1], qf2[s8 & 1], sc); }
                    const int mlim = (jb == ibs) ? l31 : 64;
#pragma unroll
                    for (int q = 0; q < 4; ++q) { float pv[4];
#pragma unroll
                        for (int e = 0; e < 4; ++e) { const int jl = e + 8 * q + 4 * hh; pv[e] = (jl > mlim) ? 0.f : sc[4 * q + e]; }
                        *(LAS u32x2*)(L + GL_PM + 4096 * ibs + (WB ^ (unsigned)((4 * jb + q) << 4))) = (u32x2){pkbf(pv[0], pv[1]), pkbf(pv[2], pv[3])}; }
                }
#pragma unroll
                for (int i2 = 0; i2 < 2; ++i2)
#pragma unroll
                    for (int r = 0; r < 16; ++r) o[i2][r] = 0.f;
                { bf16x8 qf[2][2];
                    { const unsigned ro = RB ^ (unsigned)(hh << 4); qf[0][0] = *(const LAS bf16x8*)(L + GL_QD + ro); qf[0][1] = *(const LAS bf16x8*)(L + GL_QD + 8192 + ro); }
#pragma unroll
                    for (int st = 0; st < 8; ++st) { const int q = st >> 1, s2 = st & 1;
                        if (st + 1 < 8) { const unsigned ro = RB ^ (unsigned)((2 * (st + 1) + hh) << 4); qf[(st + 1) & 1][0] = *(const LAS bf16x8*)(L + GL_QD + ro); qf[(st + 1) & 1][1] = *(const LAS bf16x8*)(L + GL_QD + 8192 + ro); }
                        u32x4 pb; pb.x = pkbf(S[q][8 * s2], S[q][8 * s2 + 1]); pb.y = pkbf(S[q][8 * s2 + 2], S[q][8 * s2 + 3]); pb.z = pkbf(S[q][8 * s2 + 4], S[q][8 * s2 + 5]); pb.w = pkbf(S[q][8 * s2 + 6], S[q][8 * s2 + 7]);
                        const bf16x8 sfr = __builtin_bit_cast(bf16x8, pb);
                        __builtin_amdgcn_sched_barrier(0);
                        o[0] = MFMA32(sfr, qf[st & 1][0], o[0]); o[1] = MFMA32(sfr, qf[st & 1][1], o[1]); } }
                __syncthreads();
                { bf16x8 pf[6];
#pragma unroll
                    for (int st = 0; st < 6; ++st) { const int i2 = st < 2 ? 0 : 1, ks = st < 2 ? st : st - 2; pf[st] = *(const LAS bf16x8*)(L + GL_PM + 4096 * i2 + (PB ^ (unsigned)((2 * ks) << 4))); }
                    __builtin_amdgcn_sched_barrier(0);
#pragma unroll
                    for (int st = 0; st < 6; ++st) { const int i2 = st < 2 ? 0 : 1, ks = st < 2 ? st : st - 2; o[i2] = MFMA32(vb[ks], pf[st], o[i2]); } }
            }
            {
#define KR_FRAG(Q, KS) __builtin_shufflevector(__builtin_amdgcn_ds_read_tr16_b64_v4i16((LAS s16x4*)(L + GL_KR + (TB ^ (unsigned)((4 * (Q)) << 4)) + 256 * (16 * (KS)))), \
                                               __builtin_amdgcn_ds_read_tr16_b64_v4i16((LAS s16x4*)(L + GL_KR + (TB ^ (unsigned)(((4 * (Q)) ^ 1) << 4)) + 256 * (16 * (KS) + 4))), 0, 1, 2, 3, 4, 5, 6, 7)
                bf16x8 kf[2]; kf[0] = KR_FRAG(0, 0);
#pragma unroll
                for (int q = 0; q < 4; ++q) {
                    f32x4 dv[4];
#pragma unroll
                    for (int g4 = 0; g4 < 4; ++g4) dv[g4] = *(const LAS f32x4*)(DEC + 32 * q + 8 * g4 + 4 * hh);
#pragma unroll
                    for (int g4 = 0; g4 < 4; ++g4)
#pragma unroll
                        for (int e = 0; e < 4; ++e) S[q][4 * g4 + e] *= dv[g4][e];
#pragma unroll
                    for (int ks = 0; ks < 4; ++ks) { const int st = 4 * q + ks;
                        if (st + 1 < 16) kf[(st + 1) & 1] = KR_FRAG((st + 1) >> 2, (st + 1) & 3);
                        S[q] = MFMA32(kf[st & 1], vb[ks], S[q]); }
                }
#undef KR_FRAG
            }
            if (!isctx) {
                const unsigned A_ot = GL_OT + (unsigned)l31 * 528u + (unsigned)(32 * w + 4 * hh) * 2u;
#pragma unroll
                for (int i2 = 0; i2 < 2; ++i2)
#pragma unroll
                    for (int rq = 0; rq < 4; ++rq) *(LAS u32x2*)(L + A_ot + (32 * i2) * 528 + 16 * rq) = (u32x2){pkbf(o[i2][4 * rq], o[i2][4 * rq + 1]), pkbf(o[i2][4 * rq + 2], o[i2][4 * rq + 3])};
            }
        }
        __syncthreads();
        { const int tid = tid0; GLA_FLUSH(31); }
#undef GLA_FLUSH
#undef GLA_LOAD
    }
    __syncthreads();
}

template <bool LOADN>
__device__ __forceinline__ void og_rows2(const bf16_t* OF, const bf16_t* OB, const bf16_t* PG, bf16_t* OG, const size_t off0, const u32x4 (&cur)[3][2][2], u32x4 (&nxt)[3][2][2], const float (&gn)[8]) {
    if (LOADN) {
#pragma unroll
        for (int rr = 0; rr < 2; ++rr)
#pragma unroll
            for (int j = 0; j < 2; ++j) { const size_t off = off0 + (size_t)(2 + rr) * D + 512 * j; nxt[0][rr][j] = *(const u32x4*)(OF + off); nxt[1][rr][j] = *(const u32x4*)(OB + off); nxt[2][rr][j] = *(const u32x4*)(PG + off); }
    }
#pragma unroll
    for (int rr = 0; rr < 2; ++rr)
#pragma unroll
        for (int j = 0; j < 2; ++j) {
            float o[8], ob[8], g[8]; unpack8(cur[0][rr][j], o); unpack8(cur[1][rr][j], ob); unpack8(cur[2][rr][j], g);
            float ss = 0.f;
#pragma unroll
            for (int e = 0; e < 8; ++e) { o[e] += ob[e]; ss += o[e] * o[e]; }
            ss = row_sum16(ss); ss = swap16_sum(ss, ss);
            const float rstd = __builtin_amdgcn_rsqf(ss * (1.f / 256.f) + EPS);
            float y[8];
#pragma unroll
            for (int e = 0; e < 8; ++e) y[e] = (o[e] * (rstd * gn[e])) * (g[e] * sigmoidf_(g[e]));
            u32x4 wv; wv.x = cvt_pk_bf16(y[0], y[1]); wv.y = cvt_pk_bf16(y[2], y[3]); wv.z = cvt_pk_bf16(y[4], y[5]); wv.w = cvt_pk_bf16(y[6], y[7]);
            *(u32x4*)(OG + off0 + (size_t)rr * D + 512 * j) = wv; }
}
__device__ __forceinline__ void p_prep(Frame& F, const bool do_og, const bool do_pool) {
    const int gw = F.vcu * NWAVES + F.wave, NGW = F.G * NWAVES, lane = F.lane;
    const bf16_t* OF = (const bf16_t*)F.out; const bf16_t* OB = OF + (size_t)T * D; const bf16_t* PG = (const bf16_t*)(F.ws + WS_PG);
    bf16_t* OG = (bf16_t*)(F.ws + WS_HX);
    float gn[8];
    { const f32x4 g0 = *(const f32x4*)(F.in[13] + 8 * (lane & 31)), g1 = *(const f32x4*)(F.in[13] + 8 * (lane & 31) + 4);
#pragma unroll
        for (int e = 0; e < 4; ++e) { gn[e] = g0[e]; gn[4 + e] = g1[e]; } }
    if (do_og)
    for (int w = gw; w < 2048; w += NGW) {
        u32x4 bufA[3][2][2], bufB[3][2][2];
        const size_t base = (size_t)w * 32 * D + 8 * lane;
#pragma unroll
        for (int rr = 0; rr < 2; ++rr)
#pragma unroll
            for (int j = 0; j < 2; ++j) { const size_t off = base + (size_t)rr * D + 512 * j; bufA[0][rr][j] = *(const u32x4*)(OF + off); bufA[1][rr][j] = *(const u32x4*)(OB + off); bufA[2][rr][j] = *(const u32x4*)(PG + off); }
#pragma unroll 1
        for (int r = 0; r < 32; r += 4) {
            og_rows2<true>(OF, OB, PG, OG, base + (size_t)r * D, bufA, bufB, gn);
            if (r + 4 < 32) og_rows2<true>(OF, OB, PG, OG, base + (size_t)(r + 2) * D, bufB, bufA, gn);
            else og_rows2<false>(OF, OB, PG, OG, base + (size_t)(r + 2) * D, bufB, bufA, gn);
        }
    }
    if (!do_pool) return;
    const bf16_t* PU = (const bf16_t*)(F.ws + WS_PU); bf16_t* PO = (bf16_t*)(F.ws + WS_PO);
    LAS unsigned* uL = (LAS unsigned*)F.lds;
    u32x4 upf[8];
    if (F.vcu < T / 64) {
#pragma unroll
        for (int q = 0; q < 8; ++q) upf[q] = *(const u32x4*)(PU + (size_t)F.vcu * 64 * 512 + (size_t)(F.tid + NTHR * q) * 8); }
    for (int tt = F.vcu; tt < T / 64; tt += F.G) {
        __syncthreads();
#pragma unroll
        for (int q = 0; q < 8; ++q) *(LAS u32x4*)(uL + (F.tid + NTHR * q) * 4) = upf[q];
        if (tt + F.G < T / 64) {
#pragma unroll
            for (int q = 0; q < 8; ++q) upf[q] = *(const u32x4*)(PU + (size_t)(tt + F.G) * 64 * 512 + (size_t)(F.tid + NTHR * q) * 8); }
        __syncthreads();
        const int cp = F.tid & 255, half = F.tid >> 8, gi = cp >> 6, hw = 1 << gi;
        const int p0 = half * 32;
        float s0 = 0.f, s1 = 0.f;
        { const int lo = (p0 - hw) < 0 ? 0 : (p0 - hw), hi = p0 + hw;
            for (int q = lo; q < hi; ++q) { const unsigned wv = uL[q * 256 + cp]; s0 += bf_lo(wv); s1 += bf_hi(wv); } }
        bf16_t* po = PO + ((size_t)tt * 64 + p0) * 512 + 2 * cp;
#pragma unroll 8
        for (int i = 0; i < 32; ++i) {
            const int p = p0 + i; const int lo = (p - hw) < 0 ? 0 : (p - hw), hi = (p + hw) > 64 ? 64 : (p + hw);
            const unsigned self = uL[p * 256 + cp]; const float inv = 1.f / (float)(hi - lo);
            *(unsigned*)(po + (size_t)i * 512) = cvt_pk_bf16(s0 * inv - bf_lo(self), s1 * inv - bf_hi(self));
            const int qa = p + hw, qd = p - hw;
            const unsigned wa = uL[(qa < 64 ? qa : 63) * 256 + cp], wd = uL[(qd >= 0 ? qd : 0) * 256 + cp];
            const float fa = qa < 64 ? 1.f : 0.f, fd = qd >= 0 ? 1.f : 0.f;
            s0 += fa * bf_lo(wa) - fd * bf_lo(wd); s1 += fa * bf_hi(wa) - fd * bf_hi(wd);
        }
    }
    __syncthreads();
}

struct SchedSq {
    static constexpr bool GATHER = false;
    const char* A; const char* B; unsigned lda; int K, G, c;
    __device__ __forceinline__ bool next(int i, pg8::Unit& u) const {
        const int L = i * G + c; if (L >= 1024) return false;
        int pm, pn; pg8::static_tile(L, 256, 4, pm, pn); u.pm = pm; u.pn = pn; u.aux = 0;
        u.A = A + (size_t)pm * 256 * lda; u.B = B + (size_t)pn * 256 * (K * 2); pg8::contig_va(u.va, lda); return true;
    }
};
struct EpiPool {
    static constexpr int NISS = 32; static constexpr bool IDEM = true; static constexpr bool PERM = true;
    const bf16_t* GATES; bf16_t* Z;
    __device__ __forceinline__ void operator()(const f32x4 (&acc)[2][2][4][2], const pg8::Unit& u, int wr, int wc, int fr, int fq) const {
        const size_t rowg = (size_t)u.pm * 256 + wr * 64; const int colb = u.pn * 256 + wc * 64;
        u32x4 gq[2][4][2];
#pragma unroll
        for (int ai = 0; ai < 2; ++ai)
#pragma unroll
            for (int m = 0; m < 4; ++m) ld_lines(GATES + (rowg + ai * 128 + m * 16) * 2048 + colb, 2048, fr, fq, gq[ai][m][0], gq[ai][m][1]);
        asm volatile("" ::: "memory");
#pragma unroll
        for (int ai = 0; ai < 2; ++ai)
#pragma unroll
            for (int m = 0; m < 4; ++m) { const size_t rg = rowg + ai * 128 + m * 16; u32x4 wv[2];
#pragma unroll
                for (int bj = 0; bj < 2; ++bj) { float g[8]; unpack8(gq[ai][m][bj], g); const f32x4 a0 = acc[ai][bj][m][0], a1 = acc[ai][bj][m][1]; f32x4 z0, z1;
#pragma unroll
                    for (int e = 0; e < 4; ++e) { z0[e] = a0[e] * sigmoidf_(g[e]); z1[e] = a1[e] * sigmoidf_(g[4 + e]); }
                    wv[bj] = pack8(z0, z1); }
                st_lines(Z + rg * 1024 + colb, 1024, fr, fq, wv[0], wv[1]); }
    }
};
struct EpiGla {
    static constexpr int NISS = 48; static constexpr bool IDEM = false; static constexpr bool PERM = true;
    const bf16_t* GATES; bf16_t* Z;
    __device__ __forceinline__ void operator()(const f32x4 (&acc)[2][2][4][2], const pg8::Unit& u, int wr, int wc, int fr, int fq) const {
        const size_t rowg = (size_t)u.pm * 256 + wr * 64; const int colb = u.pn * 256 + wc * 64;
#pragma unroll
        for (int ai = 0; ai < 2; ++ai) {
            u32x4 gq[4][2], zq[4][2];
#pragma unroll
            for (int m = 0; m < 4; ++m) { const size_t rg = rowg + ai * 128 + m * 16; ld_lines(GATES + rg * 2048 + 1024 + colb, 2048, fr, fq, gq[m][0], gq[m][1]); ld_lines(Z + rg * 1024 + colb, 1024, fr, fq, zq[m][0], zq[m][1]); }
            asm volatile("" ::: "memory");
#pragma unroll
            for (int m = 0; m < 4; ++m) { const size_t rg = rowg + ai * 128 + m * 16; u32x4 wv[2];
#pragma unroll
                for (int bj = 0; bj < 2; ++bj) { float g[8], zp[8]; unpack8(gq[m][bj], g); unpack8(zq[m][bj], zp); const f32x4 a0 = acc[ai][bj][m][0], a1 = acc[ai][bj][m][1]; f32x4 z0, z1;
#pragma unroll
                    for (int e = 0; e < 4; ++e) { z0[e] = zp[e] + a0[e] * sigmoidf_(g[e]); z1[e] = zp[4 + e] + a1[e] * sigmoidf_(g[4 + e]); }
                    wv[bj] = pack8(z0, z1); }
                st_lines(Z + rg * 1024 + colb, 1024, fr, fq, wv[0], wv[1]); }
        }
    }
};
struct EpiWo {
    static constexpr int NISS = 52; static constexpr bool IDEM = true; static constexpr bool PERM = true;
    const float* X; const float* MOD; bf16_t* X1;
    __device__ __forceinline__ void operator()(const f32x4 (&acc)[2][2][4][2], const pg8::Unit& u, int wr, int wc, int fr, int fq) const {
        const size_t rowg = (size_t)u.pm * 256 + wr * 64; const int colb = u.pn * 256 + wc * 64, col0 = colb + 8 * fq; const int b = u.pm >> 3;
        f32x4 gv[2][2];
#pragma unroll
        for (int bj = 0; bj < 2; ++bj)
#pragma unroll
            for (int n = 0; n < 2; ++n) gv[bj][n] = *(const f32x4*)(MOD + b * 6144 + 2048 + col0 + bj * 32 + n * 4);
#pragma unroll
        for (int ai = 0; ai < 2; ++ai) {
            f32x4 xq[4][2][2];
#pragma unroll
            for (int m = 0; m < 4; ++m) { const float* xr = X + (rowg + ai * 128 + m * 16 + fr) * D + col0;
#pragma unroll
                for (int bj = 0; bj < 2; ++bj) { xq[m][bj][0] = *(const f32x4*)(xr + bj * 32); xq[m][bj][1] = *(const f32x4*)(xr + bj * 32 + 4); } }
            asm volatile("" ::: "memory");
#pragma unroll
            for (int m = 0; m < 4; ++m) { const size_t rg = rowg + ai * 128 + m * 16; u32x4 wv[2];
#pragma unroll
                for (int bj = 0; bj < 2; ++bj) wv[bj] = pack8(xq[m][bj][0] + gv[bj][0] * acc[ai][bj][m][0], xq[m][bj][1] + gv[bj][1] * acc[ai][bj][m][1]);
                st_lines(X1 + rg * D + colb, D, fr, fq, wv[0], wv[1]); }
        }
    }
};

__device__ __forceinline__ float reduce4_rows(float p0, float p1, float p2, float p3) { return row_sum16(swap16_sum(swap32_sum(p0, p2), swap32_sum(p1, p3))); }
__device__ __forceinline__ float reduce8_groups(const float (&p)[8]) {
    const float t0 = swap16_sum(swap32_sum(p[0], p[4]), swap32_sum(p[2], p[6]));
    const float t1 = swap16_sum(swap32_sum(p[1], p[5]), swap32_sum(p[3], p[7]));
    int u = __builtin_bit_cast(int, 0.f);
    const float s0 = t0 + __builtin_bit_cast(float, __builtin_amdgcn_update_dpp(0, __builtin_bit_cast(int, t0), 0x128, 0xf, 0xf, false));
    const float s1 = t1 + __builtin_bit_cast(float, __builtin_amdgcn_update_dpp(0, __builtin_bit_cast(int, t1), 0x128, 0xf, 0xf, false));
    u = __builtin_amdgcn_update_dpp(u, __builtin_bit_cast(int, s0), 0xE4, 0xf, 0x3, false);
    u = __builtin_amdgcn_update_dpp(u, __builtin_bit_cast(int, s1), 0xE4, 0xf, 0xC, false);
    float v = __builtin_bit_cast(float, u);
    v += dpp_mov<0x141>(v); v += dpp_mov<0xB1>(v); v += dpp_mov<0x4E>(v);
    return v;
}
__device__ __forceinline__ float dot16(const f32x4 (&h)[4], const LAS float* wl) {
    f32x2 acc = (f32x2){0.f, 0.f};
#pragma unroll
    for (int q = 0; q < 4; ++q) { const f32x4 wv = *(const LAS f32x4*)(wl + 512 * (q >> 1) + 4 * (q & 1)); acc += (f32x2){h[q][0], h[q][1]} * (f32x2){wv[0], wv[1]}; acc += (f32x2){h[q][2], h[q][3]} * (f32x2){wv[2], wv[3]}; }
    return acc[0] + acc[1];
}
template <bool DRY>
__device__ __forceinline__ void p_norm2_router(Frame& F) {
    const int tid = F.tid, lane = F.lane;
    constexpr int WS = 1028;
    LAS float* WR = (LAS float*)F.lds;
    LAS float* LGT = WR + 36 * WS;
    LAS unsigned* hist = (LAS unsigned*)(LGT + 256 * 12);
    LAS unsigned* baseL = hist + 32;
    LAS float* rebL = (LAS float*)(baseL + 32);
    LAS unsigned char* eidL = (LAS unsigned char*)(rebL + 32);
    LAS unsigned short* rankL = (LAS unsigned short*)(eidL + 512);
    const float* rgw = F.in[19]; const float* rew = F.in[21];
    for (int i = tid; i < 1024 * 4; i += NTHR) WR[(i & 3) * WS + (i >> 2)] = rgw[i];
    for (int i = tid; i < 1024 * 32; i += NTHR) WR[(4 + (i & 31)) * WS + (i >> 5)] = rew[i];
    if (tid < 32) rebL[tid] = F.in[22][tid];
    const float rgbl = F.in[20][lane >> 4];
    const float* mod = (const float*)(F.ws + WS_MOD); const bf16_t* X1 = (const bf16_t*)(F.ws + WS_X1); bf16_t* H2 = (bf16_t*)(F.ws + WS_HX);
    int* EID = (int*)(F.ws + WS_EID); float* EW = (float*)(F.ws + WS_EW); int* SLOT = (int*)(F.ws + WS_POS); int* IDXE = (int*)(F.ws + WS_IDXE);
    for (int blk = F.vcu; blk < T / 256; blk += F.G) {
        __syncthreads();
        if (tid < 32) hist[tid] = 0u;
        __syncthreads();
        const int b = blk >> 3; const size_t row0 = (size_t)blk * 256 + F.wave * 32;
        f32x4 Av[4], Bv[4];
#pragma unroll
        for (int q = 0; q < 4; ++q) { const int c = 8 * lane + 512 * (q >> 1) + 4 * (q & 1); const f32x4 g = *(const f32x4*)(F.in[7] + c), sc = *(const f32x4*)(mod + b * 6144 + 4 * 1024 + c); Av[q] = g * (sc + 1.f); Bv[q] = *(const f32x4*)(mod + b * 6144 + 3 * 1024 + c); }
        u32x4 nxb[4][2];
#pragma unroll
        for (int p = 0; p < 4; ++p)
#pragma unroll
            for (int j = 0; j < 2; ++j) nxb[p][j] = *(const u32x4*)(X1 + (row0 + p) * D + 8 * lane + 512 * j);
        for (int r4 = 0; r4 < 32; r4 += 4)
#pragma unroll
        for (int p = 0; p < 4; ++p) {
            const int r = r4 + p, rl = F.wave * 32 + r;
            const size_t row = row0 + r; f32x4 v[4]; float ss = 0.f;
#pragma unroll
            for (int j = 0; j < 2; ++j) { float f[8]; unpack8(nxb[p][j], f); v[2 * j] = (f32x4){f[0], f[1], f[2], f[3]}; v[2 * j + 1] = (f32x4){f[4], f[5], f[6], f[7]}; }
            if (r + 4 < 32) {
#pragma unroll
                for (int j = 0; j < 2; ++j) nxb[p][j] = *(const u32x4*)(X1 + (row + 4) * D + 8 * lane + 512 * j); }
#pragma unroll
            for (int q = 0; q < 4; ++q) ss += (v[q][0] * v[q][0] + v[q][1] * v[q][1]) + (v[q][2] * v[q][2] + v[q][3] * v[q][3]);
            const float rstd = __builtin_amdgcn_rsqf(wave_sum(ss) * (1.f / D) + EPS);
#pragma unroll
            for (int q = 0; q < 4; ++q) v[q] = v[q] * rstd * Av[q] + Bv[q];
#pragma unroll
            for (int j = 0; j < 2; ++j) {
                if (MOE_FP8) { u32x2 w8; w8.x = pk4_fp8(v[2 * j][0], v[2 * j][1], v[2 * j][2], v[2 * j][3]); w8.y = pk4_fp8(v[2 * j + 1][0], v[2 * j + 1][1], v[2 * j + 1][2], v[2 * j + 1][3]);
                    *(u32x2*)((unsigned char*)H2 + row * D + 8 * lane + 512 * j) = w8; }
                else { u32x4 wv; wv.x = cvt_pk_bf16(v[2 * j][0], v[2 * j][1]); wv.y = cvt_pk_bf16(v[2 * j][2], v[2 * j][3]); wv.z = cvt_pk_bf16(v[2 * j + 1][0], v[2 * j + 1][1]); wv.w = cvt_pk_bf16(v[2 * j + 1][2], v[2 * j + 1][3]);
                    *(u32x4*)(H2 + row * D + 8 * lane + 512 * j) = wv; } }
            const float gx = reduce4_rows(dot16(v, WR + 0 * WS + 8 * lane), dot16(v, WR + 1 * WS + 8 * lane), dot16(v, WR + 2 * WS + 8 * lane), dot16(v, WR + 3 * WS + 8 * lane)) + rgbl;
            if ((lane & 15) == 0) LGT[rl * 12 + (lane >> 4)] = gx;
            const float gmx = swap32_max(swap16_max(gx));
            const unsigned long long gmask = __builtin_amdgcn_ballot_w64(gx == gmx);
            const int gsel = gmask ? (int)(__builtin_ctzll(gmask) >> 4) : 0;
            if (lane == 0) eidL[rl * 2] = (unsigned char)gsel;
            float ep[8];
            { const LAS float* wg = WR + (4 + gsel * 8) * WS + 8 * lane;
#pragma unroll
                for (int o = 0; o < 8; ++o) ep[o] = dot16(v, wg + o * WS); }
            const float ex = reduce8_groups(ep);
            if ((lane & 7) == 0) LGT[rl * 12 + 4 + (lane >> 3)] = ex;
        }
        if (lane < 32) {
            const int rl = F.wave * 32 + lane; const size_t row = row0 + lane;
            const f32x4 gl = *(const LAS f32x4*)(LGT + rl * 12), e0 = *(const LAS f32x4*)(LGT + rl * 12 + 4), e1 = *(const LAS f32x4*)(LGT + rl * 12 + 8);
            const int gsel = eidL[rl * 2];
            const float gmax = fmaxf(fmaxf(gl[0], gl[1]), fmaxf(gl[2], gl[3]));
            const float pgrp = 1.f / (expf(gl[0] - gmax) + expf(gl[1] - gmax) + expf(gl[2] - gmax) + expf(gl[3] - gmax));
            const f32x4 b0 = *(const LAS f32x4*)(rebL + gsel * 8), b1 = *(const LAS f32x4*)(rebL + gsel * 8 + 4);
            float el[8];
#pragma unroll
            for (int o = 0; o < 4; ++o) { el[o] = e0[o] + b0[o]; el[4 + o] = e1[o] + b1[o]; }
            int i0 = 0; float m0 = el[0];
#pragma unroll
            for (int o = 1; o < 8; ++o) if (el[o] > m0) { m0 = el[o]; i0 = o; }
            int i1 = -1; float m1 = -3.0e38f;
#pragma unroll
            for (int o = 0; o < 8; ++o) if (o != i0 && el[o] > m1) { m1 = el[o]; i1 = o; }
            if (i1 < 0) { i1 = (i0 + 1) & 7; m1 = el[0];
#pragma unroll
                for (int o = 1; o < 8; ++o) if (o == i1) m1 = el[o]; }
            const float e1x = expf(m1 - m0), w0 = pgrp / (1.f + e1x), w1 = pgrp * e1x / (1.f + e1x);
            const int x0 = gsel * 8 + i0, x1 = gsel * 8 + i1;
            *(u32x2*)(EID + row * 2) = (u32x2){(unsigned)x0, (unsigned)x1}; *(f32x2*)(EW + row * 2) = (f32x2){w0, w1};
            eidL[rl * 2] = (unsigned char)x0; eidL[rl * 2 + 1] = (unsigned char)x1;
            rankL[rl * 2] = (unsigned short)atomicAdd((unsigned*)&hist[x0], 1u); rankL[rl * 2 + 1] = (unsigned short)atomicAdd((unsigned*)&hist[x1], 1u);
        }
        __syncthreads();
        if (!DRY) {
        if (tid < 32) baseL[tid] = hist[tid] ? __hip_atomic_fetch_add(F.ctl + CW_CNT + tid, hist[tid], __ATOMIC_RELAXED, __HIP_MEMORY_SCOPE_AGENT) : 0u;
        __syncthreads();
        { const int e = eidL[tid]; const unsigned slot = baseL[e] + rankL[tid]; const int token = blk * 256 + (tid >> 1);
            IDXE[(size_t)e * 65536 + slot] = token; SLOT[token * 2 + (tid & 1)] = (int)slot; }
        }
    }
    __syncthreads();
}
__device__ __forceinline__ void moe_tables(Frame& F) {
    volatile LAS unsigned* M = (volatile LAS unsigned*)(F.lds + MISC_OFF);
    __syncthreads();
    if (F.tid == 0) { unsigned o = 0; for (int e = 0; e < 32; ++e) { const unsigned c = __hip_atomic_load(F.ctl + CW_CNT + e, __ATOMIC_RELAXED, __HIP_MEMORY_SCOPE_AGENT); M[64 + e] = c; M[16 + e] = o; o += (c + 255u) & ~255u; } M[48] = o; }
    __syncthreads();
}

struct SchedMoe1 {
    static constexpr bool GATHER = true;
    const char* H2; const char* W13; const int* IDXE; const volatile LAS unsigned* M; int nunits, G, c;
    __device__ __forceinline__ bool next(int i, pg8::Unit& u) const {
        const int L = i * G + c; if (L >= nunits) return false;
        const int tile = L >> 2, pn = L & 3; const unsigned base = (unsigned)tile * 256u; int e = 0;
        for (int q = 1; q < 32; ++q) e += (M[16 + q] <= base) ? 1 : 0;
        e = __builtin_amdgcn_readfirstlane(e);
        const unsigned lb = base - M[16 + e], cnt = M[64 + e];
        u.pm = tile; u.pn = pn; u.aux = e; u.A = H2; u.B = W13 + ((size_t)e * 1024 + (size_t)pn * 256) * (MOE_FP8 ? 1024 : 2048);
        const int tid = threadIdx.x; const int* ie = IDXE + (size_t)e * 65536;
#pragma unroll
        for (int k = 0; k < 2; ++k) { int R, C; pg8::stage_rc(tid * 16 + k * 8192, R, C);
            const unsigned s0 = lb + R, s1 = lb + 128 + R; const int t0 = s0 < cnt ? ie[s0] : 0, t1 = s1 < cnt ? ie[s1] : 0;
            u.va[0][k] = (unsigned)t0 * (MOE_FP8 ? 1024u : 2048u) + (unsigned)C * 2u; u.va[1][k] = (unsigned)t1 * (MOE_FP8 ? 1024u : 2048u) + (unsigned)C * 2u; }
        return true;
    }
};
struct EpiMoe1 {
    static constexpr int NISS = 8; static constexpr bool IDEM = true; static constexpr bool PERM = true;
    bf16_t* HID;
    __device__ __forceinline__ void operator()(const f32x4 (&acc)[2][2][4][2], const pg8::Unit& u, int wr, int wc, int fr, int fq) const {
        const int row0 = u.pm * 256 + wr * 64 + fr, col0 = u.pn * 128 + wc * 32 + 8 * fq;
#pragma unroll
        for (int ai = 0; ai < 2; ++ai)
#pragma unroll
            for (int m = 0; m < 4; ++m) { const size_t row = row0 + ai * 128 + m * 16; float hv[8];
#pragma unroll
                for (int n = 0; n < 2; ++n)
#pragma unroll
                    for (int e = 0; e < 4; ++e) { const float a = acc[ai][0][m][n][e] * (MOE_FP8 ? 1.f / SC_W13 : 1.f), bq = acc[ai][1][m][n][e] * (MOE_FP8 ? (MOE2_FP8 ? SC_HID : 1.f) / SC_W13 : 1.f); hv[4 * n + e] = a * sigmoidf_(a) * bq; }
                if (MOE2_FP8) { u32x2 w8; w8.x = pk4_fp8(hv[0], hv[1], hv[2], hv[3]); w8.y = pk4_fp8(hv[4], hv[5], hv[6], hv[7]); *(u32x2*)((unsigned char*)HID + row * 512 + col0) = w8; }
                else { u32x4 w; w.x = cvt_pk_bf16(hv[0], hv[1]); w.y = cvt_pk_bf16(hv[2], hv[3]); w.z = cvt_pk_bf16(hv[4], hv[5]); w.w = cvt_pk_bf16(hv[6], hv[7]);
                    *(u32x4*)(HID + row * 512 + col0) = w; } }
    }
};
struct SchedMoe2 {
    static constexpr bool GATHER = false;
    const char* HID; const char* W2; const volatile LAS unsigned* M; int nunits, G, c;
    __device__ __forceinline__ bool next(int i, pg8::Unit& u) const {
        const int L = i * G + c; if (L >= nunits) return false;
        const int tile = L >> 2, pn = L & 3; const unsigned base = (unsigned)tile * 256u; int e = 0;
        for (int q = 1; q < 32; ++q) e += (M[16 + q] <= base) ? 1 : 0;
        e = __builtin_amdgcn_readfirstlane(e);
        u.pm = tile; u.pn = pn; u.aux = e; u.A = HID + (size_t)tile * 256 * (MOE2_FP8 ? 512 : 1024); u.B = W2 + ((size_t)e * 1024 + (size_t)pn * 256) * (MOE2_FP8 ? 512 : 1024);
        pg8::contig_va(u.va, MOE2_FP8 ? 512 : 1024); return true;
    }
};
struct EpiMoe2 {
    static constexpr int NISS = 16; static constexpr bool IDEM = true; static constexpr bool PERM = true;
    bf16_t* Y;
    __device__ __forceinline__ void operator()(const f32x4 (&acc)[2][2][4][2], const pg8::Unit& u, int wr, int wc, int fr, int fq) const {
        if (YOUT_FP8) {
            unsigned char* blk8 = (unsigned char*)Y + ((size_t)u.pm * 256 + wr * 64 + fr) * 1024 + u.pn * 256 + wc * 64 + 8 * fq; constexpr float sy = MOE2_FP8 ? 64.f / (SC_HID * SC_W2) : 64.f;
#pragma unroll
            for (int ai = 0; ai < 2; ++ai)
#pragma unroll
                for (int m = 0; m < 4; ++m)
#pragma unroll
                    for (int bj = 0; bj < 2; ++bj) { f32x4 v0 = acc[ai][bj][m][0], v1 = acc[ai][bj][m][1]; if constexpr (sy != 1.f) { v0 = v0 * sy; v1 = v1 * sy; }
                        *(u32x2*)(blk8 + (size_t)(ai * 128 + m * 16) * 1024 + 32 * bj) = (u32x2){pk4_fp8(v0[0], v0[1], v0[2], v0[3]), pk4_fp8(v1[0], v1[1], v1[2], v1[3])}; }
            return;
        }
        bf16_t* blk = Y + ((size_t)u.pm * 256 + wr * 64) * 1024 + u.pn * 256 + wc * 64;
#pragma unroll
        for (int ai = 0; ai < 2; ++ai)
#pragma unroll
            for (int m = 0; m < 4; ++m) st_lines(blk + (size_t)(ai * 128 + m * 16) * 1024, 1024, fr, fq, pack8(acc[ai][0][m][0], acc[ai][0][m][1]), pack8(acc[ai][1][m][0], acc[ai][1][m][1]));
    }
};

__device__ __forceinline__ void p_final(Frame& F) {
    const int gw = F.vcu * NWAVES + F.wave, NGW = F.G * NWAVES, lane = F.lane;
    const float* mod = (const float*)(F.ws + WS_MOD); const bf16_t* Y = (const bf16_t*)(F.ws + WS_Y); const bf16_t* X1 = (const bf16_t*)(F.ws + WS_X1);
    const int* EID = (const int*)(F.ws + WS_EID); const int* SLOT = (const int*)(F.ws + WS_POS); const float* EW = (const float*)(F.ws + WS_EW);
    const volatile LAS unsigned* M = (const volatile LAS unsigned*)(F.lds + MISC_OFF);
    for (int w = gw; w < 2048; w += NGW) {
        const int b = w >> 6; f32x4 g2[4], fg[4];
#pragma unroll
        for (int j = 0; j < 2; ++j)
#pragma unroll
            for (int hf = 0; hf < 2; ++hf) { const int c = 8 * lane + 512 * j + 4 * hf; g2[2 * j + hf] = *(const f32x4*)(mod + b * 6144 + 5 * 1024 + c); fg[2 * j + hf] = *(const f32x4*)(F.in[26] + c); }
        const size_t prow = (size_t)w * 32 + (lane & 31);
        const int p0v = (int)M[16 + EID[prow * 2]] + SLOT[prow * 2], p1v = (int)M[16 + EID[prow * 2 + 1]] + SLOT[prow * 2 + 1]; const float ysc = YOUT_FP8 ? 1.f / 64.f : (MOE2_FP8 ? 1.f / (SC_HID * SC_W2) : 1.f); const float w0v = EW[prow * 2] * ysc, w1v = EW[prow * 2 + 1] * ysc;
        u32x4 nxb[4][2]; u32x4 ny0b[4][2], ny1b[4][2];
#define P12_LOAD(pp, rr) do { const int _p0 = __builtin_amdgcn_readlane(p0v, (rr)), _p1 = __builtin_amdgcn_readlane(p1v, (rr)); const bf16_t* _xr = X1 + ((size_t)w * 32 + (rr)) * D; \
            _Pragma("unroll") for (int j = 0; j < 2; ++j) { const int c = 8 * lane + 512 * j; nxb[pp][j] = *(const u32x4*)(_xr + c); \
                if (YOUT_FP8) { const u32x2 _a = *(const u32x2*)((const unsigned char*)Y + (size_t)_p0 * 1024 + c), _b = *(const u32x2*)((const unsigned char*)Y + (size_t)_p1 * 1024 + c); ny0b[pp][j].x = _a.x; ny0b[pp][j].y = _a.y; ny1b[pp][j].x = _b.x; ny1b[pp][j].y = _b.y; } \
                else { ny0b[pp][j] = *(const u32x4*)(Y + (size_t)_p0 * 1024 + c); ny1b[pp][j] = *(const u32x4*)(Y + (size_t)_p1 * 1024 + c); } } } while (0)
        P12_LOAD(0, 0); P12_LOAD(1, 1); P12_LOAD(2, 2); P12_LOAD(3, 3);
        for (int r4 = 0; r4 < 32; r4 += 4)
#pragma unroll
        for (int p = 0; p < 4; ++p) {
            const int r = r4 + p;
            u32x4 xq[2], y0[2], y1[2];
#pragma unroll
            for (int j = 0; j < 2; ++j) { xq[j] = nxb[p][j]; y0[j] = ny0b[p][j]; y1[j] = ny1b[p][j]; }
            const float w0 = __builtin_bit_cast(float, __builtin_amdgcn_readlane(__builtin_bit_cast(int, w0v), r)), w1 = __builtin_bit_cast(float, __builtin_amdgcn_readlane(__builtin_bit_cast(int, w1v), r));
            if (r + 4 < 32) P12_LOAD(p, r + 4);
            float ss = 0.f; f32x4 v[4];
#pragma unroll
            for (int j = 0; j < 2; ++j) { float a[8], bq[8], xf[8]; unpack8(xq[j], xf);
                if (YOUT_FP8) { float t4[4]; unpack4_fp8(y0[j].x, t4); a[0] = t4[0]; a[1] = t4[1]; a[2] = t4[2]; a[3] = t4[3]; unpack4_fp8(y0[j].y, t4); a[4] = t4[0]; a[5] = t4[1]; a[6] = t4[2]; a[7] = t4[3];
                    unpack4_fp8(y1[j].x, t4); bq[0] = t4[0]; bq[1] = t4[1]; bq[2] = t4[2]; bq[3] = t4[3]; unpack4_fp8(y1[j].y, t4); bq[4] = t4[0]; bq[5] = t4[1]; bq[6] = t4[2]; bq[7] = t4[3]; }
                else { unpack8(y0[j], a); unpack8(y1[j], bq); }
#pragma unroll
                for (int hf = 0; hf < 2; ++hf) { f32x4 t;
#pragma unroll
                    for (int e = 0; e < 4; ++e) t[e] = xf[4 * hf + e] + g2[2 * j + hf][e] * (w0 * a[4 * hf + e] + w1 * bq[4 * hf + e]);
                    v[2 * j + hf] = t; ss += (t[0] * t[0] + t[1] * t[1]) + (t[2] * t[2] + t[3] * t[3]); } }
            const float rstd = 1.f / sqrtf(wave_sum(ss) * (1.f / D) + EPS);
            float* xo = F.out + ((size_t)w * 32 + r) * D;
#pragma unroll
            for (int j = 0; j < 2; ++j) { const int c = 8 * lane + 512 * j; *(f32x4*)(xo + c) = v[2 * j] * rstd * fg[2 * j]; *(f32x4*)(xo + c + 4) = v[2 * j + 1] * rstd * fg[2 * j + 1]; }
        }
#undef P12_LOAD
    }
}

__global__ void __launch_bounds__(NTHR, 2) fwd_kernel(Args args) {
    extern __shared__ __attribute__((aligned(16))) unsigned char lds_raw[];
    Frame F;
    F.lds = (LAS unsigned char*)lds_raw;
    F.tid = threadIdx.x; F.lane = F.tid & 63; F.wave = __builtin_amdgcn_readfirstlane(F.tid >> 6);
    F.G = gridDim.x; { const int bx = blockIdx.x; F.vcu = (F.G % 8 == 0) ? (bx % 8) * (F.G / 8) + bx / 8 : bx; }
    F.ws = args.ws; F.out = args.out; F.ctl = (unsigned*)(args.ws + WS_CTL);
#pragma unroll
    for (int i = 0; i < 27; ++i) F.in[i] = args.in[i];
    volatile LAS unsigned* MISC = (volatile LAS unsigned*)(F.lds + MISC_OFF);
    if (F.tid < 128) MISC[F.tid] = 0u;
    __syncthreads();
    XcdBarrier bar; bar.bar = F.ctl + CW_BAR; bar.x = 0; bar.st = nullptr;
    if (N_LAUNCHES != PER_PHASE) bar = xcd_barrier_post(F.ctl + CW_BAR, MISC + 8);
#define GRID_BAR() do { if (N_LAUNCHES != PER_PHASE) xcd_barrier(bar); } while (0)
#ifdef PROBE_A
    unsigned long long t_a0 = 0, t_a1 = 0, t_b0 = 0, t_b1 = 0;
#define STAMP(k) do { const unsigned long long _t = wall_clock64(); if ((k) == PROBE_A) t_a0 = _t; if ((k) == PROBE_A + 1) t_a1 = _t; if ((k) == PROBE_B) t_b0 = _t; if ((k) == PROBE_B + 1) t_b1 = _t; } while (0)
#else
#define STAMP(k) do {} while (0)
#endif
    const int lo = args.ph_lo, hi = args.ph_hi;
#define IN(k) (lo <= (k) && (k) < hi)
#define BOTH(k) (IN(k) && IN((k) + 1))
#define REP(k) for (int _r = 0; _r < ((k) == PROBE_REP ? 2 : 1); ++_r)
    unsigned char* ws = F.ws;

    STAMP(0);
    if (IN(0)) { REP(0) { p_adaln(F); for (int bq = (int)blockIdx.x - 192; bq >= 0 && bq < 32; bq += 64) p_wpeff_block(F, bq); if (F.G < 224 && blockIdx.x == 0) for (int bq = 0; bq < 32; ++bq) p_wpeff_block(F, bq); p_convert(F, true, CONV_OVERLAP == 0); } if (BOTH(0)) GRID_BAR(); }
    STAMP(1);
    if (IN(1)) { REP(1) p_norm1(F); if (BOTH(1)) GRID_BAR(); }
    STAMP(2);
    if (IN(2)) {
        SchedG1 S{(const char*)(ws + WS_HX), (const char*)(ws + WS_WIN), F.G, (int)blockIdx.x}; EpiG1 E{ws};
        const bool par = ((blockIdx.x >> 3) & 1) != 0;
        if (CONV_OVERLAP && par) { p_convert(F, false, true); __syncthreads(); }
        REP(2) pg8::gemm_phase<EpiG1, SchedG1, true>(F.lds, 1024, S, E);
        if (CONV_OVERLAP && !par) { __syncthreads(); p_convert(F, false, true); }
        if (BOTH(2)) GRID_BAR();
    }
    STAMP(3);
    if (IN(3)) {
        const bool par = ((blockIdx.x >> 3) & 1) != 0;
        if (POOL_OVERLAP && par) p_prep(F, false, true);
        REP(3) p_gla_chunk(F);
        if (POOL_OVERLAP && !par) p_prep(F, false, true);
        if (BOTH(3)) GRID_BAR();
    }
    STAMP(4);
    if (IN(4) && !(OG_OVERLAP && POOL_OVERLAP)) { REP(4) p_prep(F, OG_OVERLAP == 0, POOL_OVERLAP == 0); if (BOTH(4)) GRID_BAR(); }
    STAMP(5);
    if (IN(5)) {
        SchedSq S{(const char*)(ws + WS_PO), (const char*)(ws + WS_WP), 1024u, 512, F.G, (int)blockIdx.x}; EpiPool E{(const bf16_t*)(ws + WS_PGATES), (bf16_t*)(ws + WS_Z)};
        if (OG_OVERLAP && ((blockIdx.x >> 3) & 1)) p_prep(F, true, false);
        REP(5) pg8::gemm_phase<EpiPool, SchedSq, true>(F.lds, 512, S, E);
        if (OG_OVERLAP && !((blockIdx.x >> 3) & 1)) p_prep(F, true, false);
        asm volatile("s_waitcnt vmcnt(0)" ::: "memory"); __syncthreads();
        if (OG_OVERLAP && BOTH(5)) GRID_BAR();
    }
    STAMP(6);
    if (IN(6)) {
        SchedSq S{(const char*)(ws + WS_HX), (const char*)(ws + WS_WGLA), 2048u, 1024, F.G, (int)blockIdx.x}; EpiGla E{(const bf16_t*)(ws + WS_PGATES), (bf16_t*)(ws + WS_Z)};
        pg8::gemm_phase<EpiGla, SchedSq, true>(F.lds, 1024, S, E);
        if (BOTH(6)) GRID_BAR();
    }
    STAMP(7);
    if (IN(7)) {
        SchedSq S{(const char*)(ws + WS_Z), (const char*)(ws + WS_WO), 2048u, 1024, F.G, (int)blockIdx.x}; EpiWo E{F.in[0], (const float*)(ws + WS_MOD), (bf16_t*)(ws + WS_X1)};
        REP(7) pg8::gemm_phase<EpiWo, SchedSq, true>(F.lds, 1024, S, E);
        if (BOTH(7)) GRID_BAR();
    }
    STAMP(8);
    if (IN(8)) { if (PROBE_REP == 8) p_norm2_router<true>(F); p_norm2_router<false>(F); if (BOTH(8)) GRID_BAR(); }
    STAMP(9);
    if (IN(9)) {
        moe_tables(F);
        const volatile LAS unsigned* M = (const volatile LAS unsigned*)(F.lds + MISC_OFF); const int nt = (int)(M[48] >> 8);
        SchedMoe1 S{(const char*)(ws + WS_HX), (const char*)(ws + WS_W13), (const int*)(ws + WS_IDXE), M, nt * 4, F.G, F.vcu}; EpiMoe1 E{(bf16_t*)(ws + WS_HID)};
        REP(9) pg8::gemm_phase<EpiMoe1, SchedMoe1, true, MOE_FP8 != 0>(F.lds, MOE_FP8 ? 512 : 1024, S, E);
        if (BOTH(9)) GRID_BAR();
    }
    STAMP(10);
    if (IN(10)) {
        moe_tables(F);
        const volatile LAS unsigned* M = (const volatile LAS unsigned*)(F.lds + MISC_OFF); const int nt = (int)(M[48] >> 8);
        SchedMoe2 S{(const char*)(ws + WS_HID), (const char*)(ws + WS_W2), M, nt * 4, F.G, F.vcu}; EpiMoe2 E{(bf16_t*)(ws + WS_Y)};
        REP(10) pg8::gemm_phase<EpiMoe2, SchedMoe2, true, MOE2_FP8 != 0>(F.lds, MOE2_FP8 ? 256 : 512, S, E);
        if (BOTH(10)) GRID_BAR();
    }
    STAMP(11);
    if (IN(11)) { moe_tables(F); REP(11) p_final(F); }
    STAMP(12);
#ifdef PROBE_A
    {
        if (blockIdx.x == 0 && F.tid == 0) { float* pr = (float*)(F.ws + WS_TILEE + 4096); pr[0] = (float)(t_a1 - t_a0) * 0.01f; pr[1] = (float)(t_b1 - t_b0) * 0.01f; }
        GRID_BAR();
        const float* pr = (const float*)(F.ws + WS_TILEE + 4096); const float va = sqrtf(__hip_atomic_load(pr, __ATOMIC_RELAXED, __HIP_MEMORY_SCOPE_AGENT)), vb = __hip_atomic_load(pr + 1, __ATOMIC_RELAXED, __HIP_MEMORY_SCOPE_AGENT);
        for (size_t i = (size_t)blockIdx.x * NTHR + F.tid; i < (size_t)T * D; i += (size_t)F.G * NTHR) F.out[i] = (i == 0) ? vb : va;
    }
#endif
#undef IN
#undef BOTH
#undef GRID_BAR
}

extern "C" void kernel_launch(void* const* d_in, const int* in_sizes, int n_in, void* d_out, int out_size, void* d_ws, size_t ws_size, hipStream_t stream) {
    static int grid = 0;
    if (grid == 0) {
        if (n_in != 27 || in_sizes[0] != T * D || out_size != T * D || ws_size < WS_END) { fprintf(stderr, "kernel_launch: unexpected shapes: n_in %d in0 %d out %d ws %zu (need %zu); nothing launched\n", n_in, n_in > 0 ? in_sizes[0] : -1, out_size, ws_size, (size_t)WS_END); grid = -1; return; }
        int dev = 0, cus = 0, per_cu = 0;
        if (hipGetDevice(&dev) != hipSuccess || hipDeviceGetAttribute(&cus, hipDeviceAttributeMultiprocessorCount, dev) != hipSuccess) { grid = -1; return; }
        if (hipFuncSetAttribute((const void*)fwd_kernel, hipFuncAttributeMaxDynamicSharedMemorySize, LDS_BYTES) != hipSuccess) { fprintf(stderr, "kernel_launch: hipFuncSetAttribute failed\n"); grid = -1; return; }
        if (hipOccupancyMaxActiveBlocksPerMultiprocessor(&per_cu, (const void*)fwd_kernel, NTHR, LDS_BYTES) != hipSuccess || per_cu < 1) fprintf(stderr, "kernel_launch: occupancy query reports %d\n", per_cu);
        (void)hipGetLastError();
        grid = cus;
    }
    if (grid < 0) return;
    if (hipMemsetAsync((char*)d_ws + WS_CTL, 0, CTL_ZERO_BYTES, stream) != hipSuccess) return;
    Args a{};
    for (int i = 0; i < 27; ++i) a.in[i] = (const float*)d_in[i];
    a.out = (float*)d_out; a.ws = (unsigned char*)d_ws;
    if (N_LAUNCHES == 1) { a.ph_lo = 0; a.ph_hi = PER_PHASE; hipLaunchKernelGGL(fwd_kernel, dim3(grid), dim3(NTHR), LDS_BYTES, stream, a); }
    else for (int p = 0; p < PER_PHASE; ++p) { a.ph_lo = p; a.ph_hi = p + 1; hipLaunchKernelGGL(fwd_kernel, dim3(grid), dim3(NTHR), LDS_BYTES, stream, a); }
}
```
